# Optimizing an MI355X kernel written in HIP

```python
import math
import jax
import jax.numpy as jnp
from jax import lax
import numpy as np

D_MODEL = 1024
BATCH = 8
SEQ = 2048
DEPTH = 4
DEC_BATCH = 32
DEC_SEQ = 1
PAST_LEN = 16384
PAGE_SIZE = 128

F32 = jnp.float32
N_META = 16
N_MIXERS = 3
N_LRU = (DEPTH + 2) // 3
N_DN = (DEPTH + 1) // 3
N_MLA = DEPTH // 3
RMS_EPS = 1e-6
CONV_W = 4
LRU_WIDTH = D_MODEL
LRU_BLOCKS = 4
LRU_BW = LRU_WIDTH // LRU_BLOCKS
LRU_C = 8.0
DN_HEADS = 8
DN_DK = 128
DN_DV = 128
DN_QKV = DN_HEADS * (2 * DN_DK + DN_DV)
DN_CHUNK = 64
MLA_HEADS = 8
MLA_Q_RANK = 512
MLA_KV_RANK = 256
MLA_NOPE = 128
MLA_ROPE = 64
MLA_V = 128
MLA_SCALE = (MLA_NOPE + MLA_ROPE) ** -0.5
ROPE_THETA = 10000.0
Q_BLOCK = 128
D_FF = ((8 * D_MODEL // 3 + 255) // 256) * 256

kernel_name = 'hybrid_rglru_deltanet_mla_decoder_step'


def rmsnorm(x, g):
    xf = x.astype(F32)
    y = xf * lax.rsqrt(jnp.mean(xf * xf, axis=-1, keepdims=True) + RMS_EPS)
    return (y * g.astype(F32)).astype(x.dtype)


def l2norm(x):
    return x * lax.rsqrt(jnp.sum(x * x, axis=-1, keepdims=True) + 1e-6)


def causal_dwconv(x, buf, w):
    L = x.shape[1]
    xx = jnp.concatenate([buf.astype(x.dtype), x], axis=1)
    y = xx[:, 0:L] * w[0]
    for j in range(1, CONV_W):
        y = y + xx[:, j:j + L] * w[j]
    return y, xx[:, L:]


def rope(x, pos):
    half = MLA_ROPE // 2
    freqs = ROPE_THETA ** (-jnp.arange(half, dtype=F32) / half)
    ang = pos.astype(F32)[:, None] * freqs
    ang = ang.reshape((1, pos.shape[0]) + (1,) * (x.ndim - 3) + (half,))
    c, s = jnp.cos(ang), jnp.sin(ang)
    xf = x.astype(F32)
    x1, x2 = xf[..., :half], xf[..., half:]
    return jnp.concatenate([x1 * c - x2 * s, x1 * s + x2 * c], axis=-1).astype(x.dtype)


def lru_mixer(h, h0, buf, w_in, conv_w, conv_b, w_a, b_a, w_i, b_i, lam, w_out):
    B, L, _ = h.shape
    gx = h @ w_in
    gate = jax.nn.gelu(gx[..., :LRU_WIDTH])
    xc, new_buf = causal_dwconv(gx[..., LRU_WIDTH:], buf, conv_w)
    xc = xc + conv_b
    xb = xc.reshape(B, L, LRU_BLOCKS, LRU_BW)
    r = jax.nn.sigmoid(jnp.einsum('blnc,ncd->blnd', xb, w_a).reshape(B, L, LRU_WIDTH) + b_a)
    i = jax.nn.sigmoid(jnp.einsum('blnc,ncd->blnd', xb, w_i).reshape(B, L, LRU_WIDTH) + b_i)
    log_a = (-LRU_C * jax.nn.softplus(-lam.astype(F32))) * r.astype(F32)
    a = jnp.exp(log_a)
    u = jnp.sqrt(-jnp.expm1(2.0 * log_a)) * (i * xc).astype(F32)
    u = u.at[:, 0].add(a[:, 0] * h0.astype(F32))

    def comb(left, right):
        return (left[0] * right[0], right[0] * left[1] + right[1])

    _, hs = lax.associative_scan(comb, (a, u), axis=1)
    y = (hs.astype(h.dtype) * gate) @ w_out
    return y, hs[:, -1].astype(h.dtype), new_buf


def gated_delta_rule(q, k, v, g, beta, S0, chunk):
    B, L, H, DK = q.shape
    DV = v.shape[-1]
    N, C = L // chunk, chunk

    def blk(t):
        t = t.reshape((B, N, C, H) + t.shape[3:])
        return jnp.moveaxis(t, (1, 3), (0, 2))

    qc = blk(q) * (DK ** -0.5)
    kc, vc, gc, bc = blk(k), blk(v), blk(g), blk(beta)
    G = jnp.cumsum(gc, axis=-1)
    tril = jnp.tril(jnp.ones((C, C), bool))
    strict = jnp.tril(jnp.ones((C, C), bool), -1)
    decay = jnp.exp(jnp.where(tril, G[..., :, None] - G[..., None, :], -jnp.inf))
    kk = jnp.einsum('nbhcd,nbhsd->nbhcs', kc, kc)
    A = jnp.where(strict, bc[..., :, None] * kk * decay, 0.0) + jnp.eye(C, dtype=F32)
    rhs = jnp.concatenate([vc * bc[..., None], kc * (bc * jnp.exp(G))[..., None]], axis=-1)
    sol = lax.linalg.triangular_solve(A, rhs, left_side=True, lower=True, unit_diagonal=True)
    u, w = sol[..., :DV], sol[..., DV:]
    attn = jnp.einsum('nbhcd,nbhsd->nbhcs', qc, kc) * decay
    q_dec = qc * jnp.exp(G)[..., None]
    k_dec = kc * jnp.exp(G[..., -1:] - G)[..., None]
    g_last = G[..., -1]

    def step(S, xs):
        u_n, w_n, qd, kd, at, gl = xs
        delta = u_n - jnp.einsum('bhcd,bhdv->bhcv', w_n, S)
        o = jnp.einsum('bhcd,bhdv->bhcv', qd, S) + jnp.einsum('bhcs,bhsv->bhcv', at, delta)
        S = S * jnp.exp(gl)[..., None, None] + jnp.einsum('bhcd,bhcv->bhdv', kd, delta)
        return S, o

    S, o = lax.scan(step, S0, (u, w, q_dec, k_dec, attn, g_last))
    o = jnp.moveaxis(o, (0, 2), (1, 3)).reshape(B, L, H, DV)
    return S, o


def deltanet_mixer(h, S0, buf, lead, w_in, conv_w, a_log, dt_bias, norm_g, w_out):
    B, L, _ = h.shape
    HV = DN_HEADS * DN_DV
    proj = h @ w_in
    qkv, new_buf = causal_dwconv(proj[..., :DN_QKV], buf, conv_w)
    qkv = jax.nn.silu(qkv).astype(F32)
    z = proj[..., DN_QKV:DN_QKV + HV].reshape(B, L, DN_HEADS, DN_DV).astype(F32)
    b = proj[..., DN_QKV + HV:DN_QKV + HV + DN_HEADS].astype(F32)
    a = proj[..., DN_QKV + HV + DN_HEADS:].astype(F32)
    q = l2norm(qkv[..., :DN_HEADS * DN_DK].reshape(B, L, DN_HEADS, DN_DK))
    k = l2norm(qkv[..., DN_HEADS * DN_DK:2 * DN_HEADS * DN_DK].reshape(B, L, DN_HEADS, DN_DK))
    v = qkv[..., 2 * DN_HEADS * DN_DK:].reshape(B, L, DN_HEADS, DN_DV)
    beta = jax.nn.sigmoid(b)
    g = -jnp.exp(a_log.astype(F32)) * jax.nn.softplus(a + dt_bias.astype(F32))
    S0 = S0.astype(F32)
    if lead > 0:
        S1, o1 = gated_delta_rule(q[:, :lead], k[:, :lead], v[:, :lead], g[:, :lead], beta[:, :lead], S0, lead)
        S, o2 = gated_delta_rule(q[:, lead:], k[:, lead:], v[:, lead:], g[:, lead:], beta[:, lead:], S1, DN_CHUNK)
        o = jnp.concatenate([o1, o2], axis=1)
    else:
        S, o = gated_delta_rule(q, k, v, g, beta, S0, L)
    o = rmsnorm(o, norm_g) * jax.nn.silu(z)
    y = o.reshape(B, L, HV).astype(h.dtype) @ w_out
    return y, S.astype(h.dtype), new_buf


def mla_attend_prompt(q_lat, q_pe, ckv, kpe):
    B, L, H, _ = q_lat.shape
    nblk = -(-L // Q_BLOCK)
    Lp = nblk * Q_BLOCK

    def blocks(t):
        t = jnp.pad(t, ((0, 0), (0, Lp - L), (0, 0), (0, 0)))
        return jnp.swapaxes(t.reshape((B, nblk, Q_BLOCK) + t.shape[2:]), 0, 1)

    kpos = jnp.arange(L)

    def one_block(args):
        ql, qp, start = args
        s = (jnp.einsum('bqhc,bkc->bhqk', ql, ckv) + jnp.einsum('bqhr,bkr->bhqk', qp, kpe)).astype(F32) * MLA_SCALE
        qpos = start + jnp.arange(Q_BLOCK)
        s = jnp.where(kpos[None, :] <= qpos[:, None], s, -jnp.inf)
        p = jax.nn.softmax(s, axis=-1).astype(ckv.dtype)
        return jnp.einsum('bhqk,bkc->bqhc', p, ckv)

    out = lax.map(one_block, (blocks(q_lat), blocks(q_pe), jnp.arange(nblk) * Q_BLOCK))
    return jnp.swapaxes(out, 0, 1).reshape(B, Lp, H, MLA_KV_RANK)[:, :L]


def mla_attend_sample(q_lat, q_pe, ckv, kpe, pool_ckv, pool_kpe, page_table):
    DB, S = q_lat.shape[:2]
    ckv_past = pool_ckv[page_table].reshape(DB, -1, MLA_KV_RANK)
    kpe_past = pool_kpe[page_table].reshape(DB, -1, MLA_ROPE)
    P = ckv_past.shape[1]
    s_past = (jnp.einsum('bqhc,bkc->bhqk', q_lat, ckv_past) + jnp.einsum('bqhr,bkr->bhqk', q_pe, kpe_past)).astype(F32) * MLA_SCALE
    s_new = (jnp.einsum('bqhc,bkc->bhqk', q_lat, ckv) + jnp.einsum('bqhr,bkr->bhqk', q_pe, kpe)).astype(F32) * MLA_SCALE
    s_new = jnp.where(jnp.tril(jnp.ones((S, S), bool)), s_new, -jnp.inf)
    p = jax.nn.softmax(jnp.concatenate([s_past, s_new], axis=-1), axis=-1).astype(ckv.dtype)
    return jnp.einsum('bhqk,bkc->bqhc', p[..., :P], ckv_past) + jnp.einsum('bhqk,bkc->bqhc', p[..., P:], ckv)


def mla_mixer(h, pos0, pool_ckv, pool_kpe, page_table, w_dq, q_norm, w_uq, w_dkv, kv_norm, w_uk, w_uv, w_o):
    B, L, _ = h.shape
    pos = pos0 + jnp.arange(L, dtype=jnp.int32)
    cq = rmsnorm(h @ w_dq, q_norm)
    q = (cq @ w_uq).reshape(B, L, MLA_HEADS, MLA_NOPE + MLA_ROPE)
    q_nope, q_pe = q[..., :MLA_NOPE], rope(q[..., MLA_NOPE:], pos)
    kv = h @ w_dkv
    ckv = rmsnorm(kv[..., :MLA_KV_RANK], kv_norm)
    kpe = rope(kv[..., MLA_KV_RANK:], pos)
    q_lat = jnp.einsum('blhn,chn->blhc', q_nope, w_uk)
    if pool_ckv is None:
        out_lat = mla_attend_prompt(q_lat, q_pe, ckv, kpe)
    else:
        out_lat = mla_attend_sample(q_lat, q_pe, ckv, kpe, pool_ckv, pool_kpe, page_table)
    o = jnp.einsum('blhc,chv->blhv', out_lat, w_uv).reshape(B, L, MLA_HEADS * MLA_V)
    return o @ w_o, ckv, kpe


def swiglu(h, w_gu, w_down):
    gu = h @ w_gu
    return (jax.nn.silu(gu[..., :D_FF]) * gu[..., D_FF:]) @ w_down


def trunk(x, pos0, lead, lru_h, lru_conv, dn_S, dn_conv, pool_ckv, pool_kpe, page_table, P):
    names = ('lru_h', 'lru_conv', 'dn_S', 'dn_conv', 'ckv', 'kpe')
    new = {n: [] for n in names}
    for i in range(DEPTH):
        kind, j = i % N_MIXERS, i // N_MIXERS
        h = rmsnorm(x, P['norm_mix'][i])
        if kind == 0:
            y, hN, cb = lru_mixer(h, lru_h[j], lru_conv[j], P['lru_w_in'][j], P['lru_conv_w'][j], P['lru_conv_b'][j],
                                  P['lru_w_a'][j], P['lru_b_a'][j], P['lru_w_i'][j], P['lru_b_i'][j],
                                  P['lru_lambda'][j], P['lru_w_out'][j])
            new['lru_h'].append(hN)
            new['lru_conv'].append(cb)
        elif kind == 1:
            y, SN, cb = deltanet_mixer(h, dn_S[j], dn_conv[j], lead, P['dn_w_in'][j], P['dn_conv_w'][j],
                                       P['dn_a_log'][j], P['dn_dt_bias'][j], P['dn_norm'][j], P['dn_w_out'][j])
            new['dn_S'].append(SN)
            new['dn_conv'].append(cb)
        else:
            pc = None if pool_ckv is None else pool_ckv[j]
            pk = None if pool_kpe is None else pool_kpe[j]
            y, ckv, kpe = mla_mixer(h, pos0, pc, pk, page_table, P['mla_w_dq'][j], P['mla_q_norm'][j],
                                    P['mla_w_uq'][j], P['mla_w_dkv'][j], P['mla_kv_norm'][j],
                                    P['mla_w_uk'][j], P['mla_w_uv'][j], P['mla_w_o'][j])
            new['ckv'].append(ckv)
            new['kpe'].append(kpe)
        x = x + y
        x = x + swiglu(rmsnorm(x, P['norm_ffn'][i]), P['ffn_w_gu'][i], P['ffn_w_down'][i])
    return rmsnorm(x, P['norm_final']), {n: jnp.stack(new[n]) for n in names}


def setup_inputs(seed: int = 0) -> dict:
    key = jax.random.key(seed)
    keys = jax.random.split(key, 64)
    ctr = [0]

    def nk():
        ctr[0] += 1
        return keys[ctr[0] - 1]

    def nrm(shape, scale=1.0):
        return jax.random.normal(nk(), shape, F32) * scale

    def unif(shape, lo, hi):
        return jax.random.uniform(nk(), shape, F32, lo, hi)

    def gain(shape):
        return 1.0 + nrm(shape, 0.02)

    n_pages = PAST_LEN // PAGE_SIZE
    n_used = DEC_BATCH * n_pages
    n_pool = n_used + n_used // 4
    perm = jax.random.permutation(nk(), n_pool)
    page_table = perm[:n_used].reshape(DEC_BATCH, n_pages).astype(jnp.int32)

    s = unif((N_LRU, LRU_WIDTH), 0.9, 0.999) ** (1.0 / LRU_C)
    lru_lambda = jnp.log(s) - jnp.log1p(-s)
    dt = jnp.exp(unif((N_DN, DN_HEADS), math.log(1e-3), math.log(1e-1)))
    dn_dt_bias = dt + jnp.log(-jnp.expm1(-dt))
    dn_a_log = jnp.log(unif((N_DN, DN_HEADS), 1.0, 16.0))
    D = D_MODEL
    return {
        'x_prompt': nrm((BATCH, SEQ, D)),
        'x_sample': nrm((DEC_BATCH, DEC_SEQ, D)),
        'state_lru_h': nrm((N_LRU, DEC_BATCH, LRU_WIDTH), 0.5),
        'state_lru_conv': nrm((N_LRU, DEC_BATCH, CONV_W - 1, LRU_WIDTH)),
        'state_dn_S': nrm((N_DN, DEC_BATCH, DN_HEADS, DN_DK, DN_DV), DN_DK ** -0.5),
        'state_dn_conv': nrm((N_DN, DEC_BATCH, CONV_W - 1, DN_QKV)),
        'cache_mla_ckv': nrm((N_MLA, n_pool, PAGE_SIZE, MLA_KV_RANK)),
        'cache_mla_kpe': nrm((N_MLA, n_pool, PAGE_SIZE, MLA_ROPE)),
        'page_table': page_table,
        'meta_tokens': nrm((N_META, D)),
        'norm_mix': gain((DEPTH, D)),
        'norm_ffn': gain((DEPTH, D)),
        'norm_final': gain((D,)),
        'lru_w_in': nrm((N_LRU, D, 2 * LRU_WIDTH), D ** -0.5),
        'lru_conv_w': nrm((N_LRU, CONV_W, LRU_WIDTH), CONV_W ** -0.5),
        'lru_conv_b': nrm((N_LRU, LRU_WIDTH), 0.01),
        'lru_w_a': nrm((N_LRU, LRU_BLOCKS, LRU_BW, LRU_BW), LRU_BW ** -0.5),
        'lru_b_a': nrm((N_LRU, LRU_WIDTH), 0.1),
        'lru_w_i': nrm((N_LRU, LRU_BLOCKS, LRU_BW, LRU_BW), LRU_BW ** -0.5),
        'lru_b_i': nrm((N_LRU, LRU_WIDTH), 0.1),
        'lru_lambda': lru_lambda,
        'lru_w_out': nrm((N_LRU, LRU_WIDTH, D), LRU_WIDTH ** -0.5),
        'dn_w_in': nrm((N_DN, D, DN_QKV + DN_HEADS * DN_DV + 2 * DN_HEADS), D ** -0.5),
        'dn_conv_w': nrm((N_DN, CONV_W, DN_QKV), CONV_W ** -0.5),
        'dn_a_log': dn_a_log,
        'dn_dt_bias': dn_dt_bias,
        'dn_norm': gain((N_DN, DN_DV)),
        'dn_w_out': nrm((N_DN, DN_HEADS * DN_DV, D), (DN_HEADS * DN_DV) ** -0.5),
        'mla_w_dq': nrm((N_MLA, D, MLA_Q_RANK), D ** -0.5),
        'mla_q_norm': gain((N_MLA, MLA_Q_RANK)),
        'mla_w_uq': nrm((N_MLA, MLA_Q_RANK, MLA_HEADS * (MLA_NOPE + MLA_ROPE)), MLA_Q_RANK ** -0.5),
        'mla_w_dkv': nrm((N_MLA, D, MLA_KV_RANK + MLA_ROPE), D ** -0.5),
        'mla_kv_norm': gain((N_MLA, MLA_KV_RANK)),
        'mla_w_uk': nrm((N_MLA, MLA_KV_RANK, MLA_HEADS, MLA_NOPE), MLA_KV_RANK ** -0.5),
        'mla_w_uv': nrm((N_MLA, MLA_KV_RANK, MLA_HEADS, MLA_V), MLA_KV_RANK ** -0.5),
        'mla_w_o': nrm((N_MLA, MLA_HEADS * MLA_V, D), (MLA_HEADS * MLA_V) ** -0.5),
        'ffn_w_gu': nrm((DEPTH, D, 2 * D_FF), D ** -0.5),
        'ffn_w_down': nrm((DEPTH, D_FF, D), D_FF ** -0.5),
    }


def reference(x_prompt, x_sample, state_lru_h, state_lru_conv, state_dn_S, state_dn_conv,
              cache_mla_ckv, cache_mla_kpe, page_table, meta_tokens, norm_mix, norm_ffn, norm_final,
              lru_w_in, lru_conv_w, lru_conv_b, lru_w_a, lru_b_a, lru_w_i, lru_b_i, lru_lambda, lru_w_out,
              dn_w_in, dn_conv_w, dn_a_log, dn_dt_bias, dn_norm, dn_w_out,
              mla_w_dq, mla_q_norm, mla_w_uq, mla_w_dkv, mla_kv_norm, mla_w_uk, mla_w_uv, mla_w_o,
              ffn_w_gu, ffn_w_down):
    P = {
        'norm_mix': norm_mix, 'norm_ffn': norm_ffn, 'norm_final': norm_final,
        'lru_w_in': lru_w_in, 'lru_conv_w': lru_conv_w, 'lru_conv_b': lru_conv_b,
        'lru_w_a': lru_w_a, 'lru_b_a': lru_b_a, 'lru_w_i': lru_w_i, 'lru_b_i': lru_b_i,
        'lru_lambda': lru_lambda, 'lru_w_out': lru_w_out,
        'dn_w_in': dn_w_in, 'dn_conv_w': dn_conv_w, 'dn_a_log': dn_a_log, 'dn_dt_bias': dn_dt_bias,
        'dn_norm': dn_norm, 'dn_w_out': dn_w_out,
        'mla_w_dq': mla_w_dq, 'mla_q_norm': mla_q_norm, 'mla_w_uq': mla_w_uq, 'mla_w_dkv': mla_w_dkv,
        'mla_kv_norm': mla_kv_norm, 'mla_w_uk': mla_w_uk, 'mla_w_uv': mla_w_uv, 'mla_w_o': mla_w_o,
        'ffn_w_gu': ffn_w_gu, 'ffn_w_down': ffn_w_down,
    }
    dt = x_prompt.dtype
    B = x_prompt.shape[0]
    meta = jnp.broadcast_to(meta_tokens.astype(dt)[None], (B, N_META, D_MODEL))
    x_full = jnp.concatenate([meta, x_prompt], axis=1)
    z_h = jnp.zeros((N_LRU, B, LRU_WIDTH), dt)
    z_c = jnp.zeros((N_LRU, B, CONV_W - 1, LRU_WIDTH), dt)
    z_S = jnp.zeros((N_DN, B, DN_HEADS, DN_DK, DN_DV), dt)
    z_dc = jnp.zeros((N_DN, B, CONV_W - 1, DN_QKV), dt)
    y_full, pn = trunk(x_full, 0, N_META, z_h, z_c, z_S, z_dc, None, None, None, P)
    y_prompt = y_full[:, N_META:]
    past_len = page_table.shape[1] * cache_mla_ckv.shape[2]
    y_sample, sn = trunk(x_sample, past_len, 0, state_lru_h, state_lru_conv, state_dn_S, state_dn_conv,
                         cache_mla_ckv, cache_mla_kpe, page_table, P)
    return (y_prompt, y_sample,
            pn['lru_h'], pn['lru_conv'], pn['dn_S'], pn['dn_conv'], pn['ckv'], pn['kpe'],
            sn['lru_h'], sn['lru_conv'], sn['dn_S'], sn['dn_conv'], sn['ckv'], sn['kpe'])
```

```cpp
#include <hip/hip_runtime.h>
#include <stdint.h>
#include <stdio.h>
#include <type_traits>


#define LAS __attribute__((address_space(3)))
typedef unsigned short bf16_t;
typedef short bf16x8 __attribute__((ext_vector_type(8)));
typedef short s16x4 __attribute__((ext_vector_type(4)));
typedef float f32x4 __attribute__((ext_vector_type(4)));
typedef unsigned u32x2 __attribute__((ext_vector_type(2)));
typedef unsigned u32x4 __attribute__((ext_vector_type(4)));

constexpr int D = 1024, NB = 8, NMETA = 16, LP = 2064, NTOK = NB * LP  , NS = 32, MP = 16640, NPANEL = 65;
constexpr int DFF = 2816, DNQKV = 3072, DNPROJ = 4112, DNPROJP = 4352;
constexpr int NCHUNK = 33;
constexpr int SCH = 64, SCL = 32;
constexpr int NTHREADS = 512;
constexpr int MMAIN = 16384;
constexpr int LDS_BYTES = 135168;
constexpr float RMS_EPS = 1e-6f;
constexpr float LOG2E = 1.4426950408889634f;
constexpr float MLA_SCALE = 0.07216878364870322f;

constexpr size_t O_YP = 0, O_YS = 16777216, O_PLH = O_YS + 32768, O_PLC = O_PLH + 16384, O_PDS = O_PLC + 49152, O_PDC = O_PDS + 1048576,
                 O_PCKV = O_PDC + 73728, O_PKPE = O_PCKV + 4227072, O_SLH = O_PKPE + 1056768, O_SLC = O_SLH + 65536, O_SDS = O_SLC + 196608,
                 O_SDC = O_SDS + 4194304, O_SCKV = O_SDC + 294912, O_SKPE = O_SCKV + 8192;

struct P {
    const float* in[38];
    float* out;
    unsigned* bar;
    float* X; bf16_t* H; float* SS;
    bf16_t *G1, *XC, *RI, *HG; float *CP, *CH; float* BCAT;
    bf16_t* PROJ; float *BA, *BG; bf16_t* QKVN; bf16_t *DW, *DUt, *DQD, *DKDt, *DATT; float* DGL; float* ORAW; bf16_t* ON;
    float* DQKV; bf16_t *CQ, *CKVb, *KPEb, *Q, *KV, *AO; float *QLAT, *QPE, *PART, *ML;
    bf16_t* HF;
    bf16_t *Wlru_in, *Wlru_gate, *Wlru_out, *Wdn_in, *Wdn_out, *Wmla_d, *Wmla_uq, *Wmla_kvup, *Wmla_o, *Wgu, *Wdown;
};

#define GASP __attribute__((address_space(1)))
struct PG {
    GASP const float* in[38];
    GASP float* out;
    GASP unsigned* bar;
    GASP float* X; GASP bf16_t* H; GASP float* SS;
    GASP bf16_t *G1, *XC, *RI, *HG; GASP float *CP, *CH; GASP float* BCAT;
    GASP bf16_t* PROJ; GASP float *BA, *BG; GASP bf16_t* QKVN; GASP bf16_t *DW, *DUt, *DQD, *DKDt, *DATT; GASP float* DGL; GASP float* ORAW; GASP bf16_t* ON;
    GASP float* DQKV; GASP bf16_t *CQ, *CKVb, *KPEb, *Q, *KV, *AO; GASP float *QLAT, *QPE, *PART, *ML;
    GASP bf16_t* HF;
    GASP bf16_t *Wlru_in, *Wlru_gate, *Wlru_out, *Wdn_in, *Wdn_out, *Wmla_d, *Wmla_uq, *Wmla_kvup, *Wmla_o, *Wgu, *Wdown;
};
static_assert(sizeof(PG) == sizeof(P), "PG layout");
__device__ __forceinline__ P glob(const LAS PG* gp) {
    const LAS PG& g = *gp; P q;
#pragma unroll
    for (int i = 0; i < 38; ++i) q.in[i] = (const float*)g.in[i];
    q.out = (decltype(q.out))g.out;
    q.bar = (decltype(q.bar))g.bar;
    q.X = (decltype(q.X))g.X;
    q.H = (decltype(q.H))g.H;
    q.SS = (decltype(q.SS))g.SS;
    q.G1 = (decltype(q.G1))g.G1;
    q.XC = (decltype(q.XC))g.XC;
    q.RI = (decltype(q.RI))g.RI;
    q.HG = (decltype(q.HG))g.HG;
    q.CP = (decltype(q.CP))g.CP;
    q.CH = (decltype(q.CH))g.CH;
    q.BCAT = (decltype(q.BCAT))g.BCAT;
    q.PROJ = (decltype(q.PROJ))g.PROJ;
    q.BA = (decltype(q.BA))g.BA;
    q.BG = (decltype(q.BG))g.BG;
    q.QKVN = (decltype(q.QKVN))g.QKVN;
    q.DW = (decltype(q.DW))g.DW;
    q.DUt = (decltype(q.DUt))g.DUt;
    q.DQD = (decltype(q.DQD))g.DQD;
    q.DKDt = (decltype(q.DKDt))g.DKDt;
    q.DATT = (decltype(q.DATT))g.DATT;
    q.DGL = (decltype(q.DGL))g.DGL;
    q.ORAW = (decltype(q.ORAW))g.ORAW;
    q.ON = (decltype(q.ON))g.ON;
    q.DQKV = (decltype(q.DQKV))g.DQKV;
    q.CQ = (decltype(q.CQ))g.CQ;
    q.CKVb = (decltype(q.CKVb))g.CKVb;
    q.KPEb = (decltype(q.KPEb))g.KPEb;
    q.Q = (decltype(q.Q))g.Q;
    q.KV = (decltype(q.KV))g.KV;
    q.AO = (decltype(q.AO))g.AO;
    q.QLAT = (decltype(q.QLAT))g.QLAT;
    q.QPE = (decltype(q.QPE))g.QPE;
    q.PART = (decltype(q.PART))g.PART;
    q.ML = (decltype(q.ML))g.ML;
    q.HF = (decltype(q.HF))g.HF;
    q.Wlru_in = (decltype(q.Wlru_in))g.Wlru_in;
    q.Wlru_gate = (decltype(q.Wlru_gate))g.Wlru_gate;
    q.Wlru_out = (decltype(q.Wlru_out))g.Wlru_out;
    q.Wdn_in = (decltype(q.Wdn_in))g.Wdn_in;
    q.Wdn_out = (decltype(q.Wdn_out))g.Wdn_out;
    q.Wmla_d = (decltype(q.Wmla_d))g.Wmla_d;
    q.Wmla_uq = (decltype(q.Wmla_uq))g.Wmla_uq;
    q.Wmla_kvup = (decltype(q.Wmla_kvup))g.Wmla_kvup;
    q.Wmla_o = (decltype(q.Wmla_o))g.Wmla_o;
    q.Wgu = (decltype(q.Wgu))g.Wgu;
    q.Wdown = (decltype(q.Wdown))g.Wdown;
    return q;
}
typedef float f32x2c __attribute__((ext_vector_type(2)));
typedef __bf16 bf16x2c __attribute__((ext_vector_type(2)));
__device__ __forceinline__ unsigned cvt_pk(float lo, float hi) { const f32x2c v = {lo, hi}; return __builtin_bit_cast(unsigned, __builtin_convertvector(v, bf16x2c)); }
__device__ __forceinline__ float bf2f(unsigned short h) { return __uint_as_float(((unsigned)h) << 16); }
__device__ __forceinline__ float bflo(unsigned w) { return __uint_as_float(w << 16); }
__device__ __forceinline__ float bfhi(unsigned w) { return __uint_as_float(w & 0xffff0000u); }
__device__ __forceinline__ float sigmoidf_(float x) { return __builtin_amdgcn_rcpf(1.0f + __builtin_amdgcn_exp2f(-1.4426950408889634f * x)); }
__device__ __forceinline__ float siluf_(float x) { return x * sigmoidf_(x); }
__device__ __forceinline__ float softplusf_(float x) { return x > 20.f ? x : log1pf(__expf(x)); }
__device__ __forceinline__ float gelu_tanh(float x) { const float y = 0.7978845608028654f * (x + 0.044715f * x * x * x); const float t = 1.0f - 2.0f * __builtin_amdgcn_rcpf(__builtin_amdgcn_exp2f(2.885390081777927f * y) + 1.0f); return 0.5f * x * (1.0f + t); }
__device__ __forceinline__ void swap32(float& a, float& b) { const auto r = __builtin_amdgcn_permlane32_swap(__float_as_uint(a), __float_as_uint(b), false, false); a = __uint_as_float(r[0]); b = __uint_as_float(r[1]); }
__device__ __forceinline__ void swap16(float& a, float& b) { const auto r = __builtin_amdgcn_permlane16_swap(__float_as_uint(a), __float_as_uint(b), false, false); a = __uint_as_float(r[0]); b = __uint_as_float(r[1]); }
__device__ __forceinline__ float sum_x32(float x) { float a = x, b = x; swap32(a, b); return a + b; }
__device__ __forceinline__ float sum_x16(float x) { float a = x, b = x; swap16(a, b); return a + b; }
__device__ __forceinline__ float max_x32(float x) { float a = x, b = x; swap32(a, b); return fmaxf(a, b); }
__device__ __forceinline__ float max_x16(float x) { float a = x, b = x; swap16(a, b); return fmaxf(a, b); }
__device__ __forceinline__ float wave_sum(float v) { v = sum_x32(v); v = sum_x16(v); v += __shfl_xor(v, 8); v += __shfl_xor(v, 4); v += __shfl_xor(v, 2); v += __shfl_xor(v, 1); return v; }
__device__ __forceinline__ int ltid() { int t = threadIdx.x; asm volatile("" : "+v"(t)); return t; }
template <class T> __device__ __forceinline__ T* uni(T* p) {
    const unsigned long long v = (unsigned long long)p; const unsigned lo = __builtin_amdgcn_readfirstlane((unsigned)v), hi = __builtin_amdgcn_readfirstlane((unsigned)(v >> 32));
    return (T*)(__attribute__((address_space(1))) T*)(((unsigned long long)hi << 32) | lo); }
__device__ __forceinline__ f32x4 mfma16(bf16x8 a, bf16x8 b, f32x4 c) { return __builtin_amdgcn_mfma_f32_16x16x32_bf16(a, b, c, 0, 0, 0); }

#define XB_TMO      128
#define XB_XCNT(j)  (256  + 64 * (j))
#define XB_XSUB(j)  (1280 + 64 * (j))
#define XB_XGEN(j)  (2304 + 64 * (j))
#define XB_TOP      3328
#define XB_TOPGEN   3392
#define XCD_BAR_WORDS 3456
#define XB_SPIN_CAP (1u << 18)
__device__ __forceinline__ unsigned xb_ld(unsigned* p)              { return __hip_atomic_load(p, __ATOMIC_RELAXED, __HIP_MEMORY_SCOPE_AGENT); }
__device__ __forceinline__ unsigned xb_add(unsigned* p, unsigned v) { return __hip_atomic_fetch_add(p, v, __ATOMIC_RELAXED, __HIP_MEMORY_SCOPE_AGENT); }
__device__ __forceinline__ unsigned xb_xcc_id() { return (unsigned)__builtin_amdgcn_s_getreg((3 << 11) | 20) & 0xFu; }
#define XB_SPIN(cond, bar) do { unsigned _sp = 0; while (cond) { __builtin_amdgcn_s_sleep(1); \
    if ((++_sp & 255u) == 0u) { if (xb_ld(&(bar)[XB_TMO])) break; if (_sp > XB_SPIN_CAP) { atomicAdd(&(bar)[XB_TMO], 1u); break; } } } } while (0)
struct XcdBarrier { unsigned* bar; unsigned x; volatile LAS unsigned* st; };
__device__ __forceinline__ XcdBarrier xcd_barrier_post(unsigned* bar, volatile LAS unsigned* st) {
    XcdBarrier b; b.bar = bar; b.x = xb_xcc_id(); b.st = st;
    if (threadIdx.x == 0) (void)xb_add(&bar[XB_XCNT(b.x)], 1u);
    return b;
}
__device__ __forceinline__ void xcd_barrier_complete(unsigned* bar, unsigned x, unsigned& nloc, unsigned& nx) {
    const unsigned G = gridDim.x * gridDim.y * gridDim.z;
    unsigned sum, cnt, mine, sp = 0u;
    for (;;) {
        sum = 0u; cnt = 0u; mine = 0u;
#pragma unroll
        for (unsigned j = 0; j < 16; ++j) { const unsigned c = xb_ld(&bar[XB_XCNT(j)]); sum += c; cnt += (c > 0u) ? 1u : 0u; mine = (j == x) ? c : mine; }
        if (sum == G) break;
        __builtin_amdgcn_s_sleep(1);
        if ((++sp & 255u) == 0u) { if (xb_ld(&bar[XB_TMO])) break; if (sp > XB_SPIN_CAP) { atomicAdd(&bar[XB_TMO], 1u); break; } }
    }
    nloc = mine > 0u ? mine : 1u; nx = cnt > 0u ? cnt : 1u;
}
__device__ __forceinline__ void xcd_barrier(const XcdBarrier& b) {
    asm volatile("s_waitcnt vmcnt(0)" ::: "memory");
    __syncthreads();
    if (threadIdx.x == 0) {
        unsigned* bar = b.bar;
        __builtin_amdgcn_s_waitcnt(0);
        unsigned nloc = b.st[0], nx = b.st[1];
        if (nloc == 0u) { xcd_barrier_complete(bar, b.x, nloc, nx); b.st[0] = nloc; b.st[1] = nx; }
        const unsigned old = xb_add(&bar[XB_XSUB(b.x)], 1u);
        const unsigned gen = old / nloc;
        if (old + 1u == (gen + 1u) * nloc) {
            __builtin_amdgcn_fence(__ATOMIC_RELEASE, "agent");
            asm volatile("s_waitcnt vmcnt(0)" ::: "memory");
            const unsigned og = xb_add(&bar[XB_TOP], 1u);
            const unsigned tg = og / nx;
            if (og + 1u == (tg + 1u) * nx) xb_add(&bar[XB_TOPGEN], 1u);
            else XB_SPIN(xb_ld(&bar[XB_TOPGEN]) == tg, bar);
            __builtin_amdgcn_fence(__ATOMIC_ACQUIRE, "agent");
            xb_add(&bar[XB_XGEN(b.x)], 1u);
            asm volatile("s_waitcnt vmcnt(0)" ::: "memory");
        } else {
            XB_SPIN(xb_ld(&bar[XB_XGEN(b.x)]) == gen, bar);
            __builtin_amdgcn_fence(__ATOMIC_ACQUIRE, "agent");
            asm volatile("s_waitcnt vmcnt(0)" ::: "memory");
        }
    }
    __syncthreads();
}

struct Job { const float* src; int ld, K; bf16_t* dst; int nrows, nvalid, mode; const float* gain; };
__device__ __forceinline__ Job get_job(const P& p, int idx) {
    Job j; j.mode = 0; j.gain = nullptr;
    if (idx < 2)        { j.src = p.in[13] + (size_t)idx * 1024 * 2048; j.ld = 2048; j.K = 1024; j.dst = p.Wlru_in + (size_t)idx * 2048 * 1024; j.nrows = 2048; j.nvalid = 2048; j.gain = p.in[10] + (idx == 0 ? 0 : 3) * D; }
    else if (idx < 18)  { const int r = idx - 2, l = r >> 3, q = r & 7, blk = q >> 1, isI = q & 1;
                          j.src = (isI ? p.in[18] : p.in[16]) + (size_t)(l * 4 + blk) * 65536; j.ld = 256; j.K = 256;
                          j.dst = p.Wlru_gate + (size_t)l * 2048 * 256 + (size_t)(blk * 512 + isI * 256) * 256; j.nrows = 256; j.nvalid = 256; }
    else if (idx < 20)  { const int l = idx - 18; j.src = p.in[21] + (size_t)l * 1048576; j.ld = 1024; j.K = 1024; j.dst = p.Wlru_out + (size_t)l * 1048576; j.nrows = 1024; j.nvalid = 1024; }
    else if (idx == 20) { j.src = p.in[22]; j.ld = DNPROJ; j.K = 1024; j.dst = p.Wdn_in; j.nrows = DNPROJP; j.nvalid = DNPROJ; j.gain = p.in[10] + 1 * D; }
    else if (idx == 21) { j.src = p.in[27]; j.ld = 1024; j.K = 1024; j.dst = p.Wdn_out; j.nrows = 1024; j.nvalid = 1024; }
    else if (idx == 22) { j.src = p.in[28]; j.ld = 512; j.K = 1024; j.dst = p.Wmla_d; j.nrows = 512; j.nvalid = 512; j.gain = p.in[10] + 2 * D; }
    else if (idx == 23) { j.src = p.in[31]; j.ld = 320; j.K = 1024; j.dst = p.Wmla_d + (size_t)512 * 1024; j.nrows = 512; j.nvalid = 320; j.gain = p.in[10] + 2 * D; }
    else if (idx == 24) { j.src = p.in[30]; j.ld = 1536; j.K = 512; j.dst = p.Wmla_uq; j.nrows = 1536; j.nvalid = 1536; }
    else if (idx == 25) { j.src = p.in[33]; j.ld = 1024; j.K = 256; j.dst = p.Wmla_kvup; j.nrows = 1024; j.nvalid = 1024; }
    else if (idx == 26) { j.src = p.in[34]; j.ld = 1024; j.K = 256; j.dst = p.Wmla_kvup + (size_t)1024 * 256; j.nrows = 1024; j.nvalid = 1024; }
    else if (idx == 27) { j.src = p.in[35]; j.ld = 1024; j.K = 1024; j.dst = p.Wmla_o; j.nrows = 1024; j.nvalid = 1024; }
    else if (idx < 32)  { const int l = idx - 28; j.src = p.in[36] + (size_t)l * 1024 * 5632; j.ld = 5632; j.K = 1024; j.dst = p.Wgu + (size_t)l * 5632 * 1024; j.nrows = 5632; j.nvalid = 5632; j.mode = 1; j.gain = p.in[11] + l * D; }
    else                { const int l = idx - 32; j.src = p.in[37] + (size_t)l * DFF * 1024; j.ld = 1024; j.K = DFF; j.dst = p.Wdown + (size_t)l * 1024 * DFF; j.nrows = 1024; j.nvalid = 1024; }
    return j;
}
constexpr int NJOBS = 36;
__device__ __forceinline__ void ph_init(const P& p, LAS char* smem) {
    const int tid = ltid();
    {
        const float4* meta = (const float4*)p.in[9]; const float4* xp = (const float4*)p.in[0]; const float4* xs = (const float4*)p.in[1];
        const int lane = tid & 63, wid = tid >> 6;
        for (int row = blockIdx.x * 8 + wid; row < MP; row += gridDim.x * 8) {
            const float4* src = nullptr;
            if (row < NTOK) { const int b = row / LP, t = row - b * LP; src = (t < NMETA) ? meta + t * 256 : xp + (size_t)(b * 2048 + t - NMETA) * 256; }
            else if (row < NTOK + NS) src = xs + (row - NTOK) * 256;
            float ss = 0.f;
#pragma unroll
            for (int i = 0; i < 4; ++i) { const float4 v = src ? src[lane + 64 * i] : make_float4(0.f, 0.f, 0.f, 0.f);
                ((float4*)(p.X + (size_t)row * D))[lane + 64 * i] = v; ss += v.x * v.x + v.y * v.y + v.z * v.z + v.w * v.w;
                *(u32x2*)(p.H + (size_t)row * D + 4 * (lane + 64 * i)) = (u32x2){cvt_pk(v.x, v.y), cvt_pk(v.z, v.w)}; }
            ss = wave_sum(ss);
            if (lane < 16) p.SS[(size_t)row * 16 + lane] = (lane == 0) ? ss : 0.f;
        }
        for (int i = blockIdx.x * NTHREADS + tid; i < 2 * 2048; i += gridDim.x * NTHREADS) { const int l = i >> 11, col = i & 2047, blk = col >> 9, isI = (col >> 8) & 1, c = col & 255;
            p.BCAT[i] = (isI ? p.in[19] : p.in[17])[l * 1024 + blk * 256 + c]; }
        const int npad = (MP - NTOK - NS) * 1024 / 8;
        for (int i = blockIdx.x * NTHREADS + tid; i < npad; i += gridDim.x * NTHREADS) {
            const size_t off = (size_t)(NTOK + NS) * 1024 + (size_t)i * 8; const u32x4 z = {0u, 0u, 0u, 0u};
            *(u32x4*)(p.HG + off) = z; *(u32x4*)(p.ON + off) = z; *(u32x4*)(p.AO + off) = z;
            { const int e = i * 8, prow = e >> 10, c = e & 1023; *(u32x4*)(p.XC + ((size_t)(c >> 8) * MP + (NTOK + NS) + prow) * 256 + (c & 255)) = z; }
        }
    }
    LAS int* jstart = (LAS int*)smem;
    LAS float* tile = (LAS float*)(smem + 256);
    if (tid == 0) { int acc = 0; for (int j = 0; j < NJOBS; ++j) { jstart[j] = acc; const Job jb = get_job(p, j); acc += (jb.nrows >> 6) * (jb.K >> 8); } jstart[NJOBS] = acc; }
    __syncthreads();
    const int total = jstart[NJOBS];
    struct TileRef { const float* src; bf16_t* dst; int ld, K, k0, n0; bool valid; const float* gain; };
    auto locate = [&](int t, TileRef& r, int& col) {
        int ji = 0; while (jstart[ji + 1] <= t) ++ji;
        const Job jb = get_job(p, ji);
        const int lt = t - jstart[ji], nkt = jb.K >> 8, tn = lt / nkt, tk = lt - tn * nkt;
        r.src = jb.src; r.dst = jb.dst; r.ld = jb.ld; r.K = jb.K; r.k0 = tk << 8; r.n0 = tn << 6; r.gain = jb.gain;
        const int nq = (tid & 15) * 4, n = r.n0 + nq; col = n; r.valid = n < jb.nvalid;
        if (jb.mode == 1) { const int q = n >> 5, sgu = (n >> 4) & 1, e = n & 15; col = sgu * DFF + q * 16 + e; } };
    auto fetch = [&](const TileRef& r, int col, float4 (&v)[8]) {
#pragma unroll
        for (int i = 0; i < 8; ++i) { const int kl = (tid >> 4) + 32 * i;
            v[i] = r.valid ? *(const float4*)(r.src + (size_t)(r.k0 + kl) * r.ld + col) : make_float4(0.f, 0.f, 0.f, 0.f);
            if (r.gain) { const float gk = r.gain[r.k0 + kl]; v[i].x *= gk; v[i].y *= gk; v[i].z *= gk; v[i].w *= gk; } } };
    TileRef cur, nxt; int ccol = 0, ncol = 0; float4 cv[8], nv[8];
    int t = blockIdx.x;
    if (t < total) { locate(t, cur, ccol); fetch(cur, ccol, cv); }
    for (; t < total; t += gridDim.x) {
        const bool has_next = t + (int)gridDim.x < total;
        if (has_next) { locate(t + gridDim.x, nxt, ncol); fetch(nxt, ncol, nv); }
        {   const int nq = (tid & 15) * 4;
#pragma unroll
            for (int i = 0; i < 8; ++i) { const int kl = (tid >> 4) + 32 * i;
                tile[kl * 65 + nq] = cv[i].x; tile[kl * 65 + nq + 1] = cv[i].y; tile[kl * 65 + nq + 2] = cv[i].z; tile[kl * 65 + nq + 3] = cv[i].w; }
        }
        __syncthreads();
        {
            const int j = tid & 7, nl = tid >> 3;
#pragma unroll
            for (int q = 0; q < 4; ++q) { float v[8];
#pragma unroll
                for (int e = 0; e < 8; ++e) v[e] = tile[(64 * q + 8 * j + e) * 65 + nl];
                u32x4 w; w.x = cvt_pk(v[0], v[1]); w.y = cvt_pk(v[2], v[3]); w.z = cvt_pk(v[4], v[5]); w.w = cvt_pk(v[6], v[7]);
                *(u32x4*)(cur.dst + (size_t)(cur.n0 + nl) * cur.K + cur.k0 + 64 * q + 8 * j) = w; }
        }
        __syncthreads();
        if (has_next) { cur = nxt; ccol = ncol;
#pragma unroll
            for (int i = 0; i < 8; ++i) cv[i] = nv[i]; }
    }
}

__device__ __forceinline__ void ph_norm(const float* X, const float* g, bf16_t* H) {
    const int tid = ltid(), lane = tid & 63, wid = tid >> 6;
    for (int row = blockIdx.x * 8 + wid; row < MP; row += gridDim.x * 8) {
        const float4* xr = (const float4*)(X + (size_t)row * D); float4 v[4]; float ss = 0.f;
#pragma unroll
        for (int i = 0; i < 4; ++i) { v[i] = xr[lane + 64 * i]; ss += v[i].x * v[i].x + v[i].y * v[i].y + v[i].z * v[i].z + v[i].w * v[i].w; }
        ss = wave_sum(ss); const float r = rsqrtf(ss * (1.0f / D) + RMS_EPS);
#pragma unroll
        for (int i = 0; i < 4; ++i) { const int c = 4 * (lane + 64 * i); const float4 gv = *(const float4*)(g + c);
            u32x2 w; w.x = cvt_pk(v[i].x * r * gv.x, v[i].y * r * gv.y); w.y = cvt_pk(v[i].z * r * gv.z, v[i].w * r * gv.w);
            *(u32x2*)(H + (size_t)row * D + c) = w; }
    }
}
__device__ __forceinline__ void ph_final_norm(const P& p) {
    const int tid = ltid(), lane = tid & 63, wid = tid >> 6; const float* g = p.in[12];
    for (int row = blockIdx.x * 8 + wid; row < NTOK + NS; row += gridDim.x * 8) {
        float* dst;
        if (row < NTOK) { const int b = row / LP, t = row - b * LP; if (t < NMETA) continue; dst = p.out + O_YP + (size_t)(b * 2048 + t - NMETA) * D; }
        else dst = p.out + O_YS + (size_t)(row - NTOK) * D;
        const float4* xr = (const float4*)(p.X + (size_t)row * D); float4 v[4]; float ss = 0.f;
#pragma unroll
        for (int i = 0; i < 4; ++i) { v[i] = xr[lane + 64 * i]; ss += v[i].x * v[i].x + v[i].y * v[i].y + v[i].z * v[i].z + v[i].w * v[i].w; }
        ss = wave_sum(ss); const float r = rsqrtf(ss * (1.0f / D) + RMS_EPS);
#pragma unroll
        for (int i = 0; i < 4; ++i) { const int c = 4 * (lane + 64 * i); const float4 gv = *(const float4*)(g + c);
            *(float4*)(dst + c) = make_float4(v[i].x * r * gv.x, v[i].y * r * gv.y, v[i].z * r * gv.z, v[i].w * r * gv.w); }
    }
}

struct GemmDesc { const bf16_t* A; int lda; const bf16_t* Bt; int K, N, ablk, pm0, npm; };
struct EpiLruIn { static constexpr bool GU = false; bf16_t* G1;
    __device__ __forceinline__ void st(int row, int col, f32x4 v) const {
        u32x2 w; if (col < 1024) { w.x = cvt_pk(gelu_tanh(v[0]), gelu_tanh(v[1])); w.y = cvt_pk(gelu_tanh(v[2]), gelu_tanh(v[3])); } else { w.x = cvt_pk(v[0], v[1]); w.y = cvt_pk(v[2], v[3]); }
        *(u32x2*)(G1 + (size_t)row * 2048 + col) = w; } };
struct EpiGate { static constexpr bool GU = false; bf16_t* RI; const float* bc;
    __device__ __forceinline__ void st(int row, int col, f32x4 v) const {
        const float4 bv = *(const float4*)(bc + col);
        *(u32x2*)(RI + (size_t)row * 2048 + col) = (u32x2){cvt_pk(sigmoidf_(v[0] + bv.x), sigmoidf_(v[1] + bv.y)), cvt_pk(sigmoidf_(v[2] + bv.z), sigmoidf_(v[3] + bv.w))}; } };
struct EpiResid { static constexpr bool GU = false; float* X;
    __device__ __forceinline__ void st(int row, int col, f32x4 v) const {
        float4* px = (float4*)(X + (size_t)row * D + col); float4 x = *px; x.x += v[0]; x.y += v[1]; x.z += v[2]; x.w += v[3]; *px = x; } };
struct EpiBf16 { static constexpr bool GU = false; bf16_t* O; int ld;
    __device__ __forceinline__ void st(int row, int col, f32x4 v) const { u32x2 w; w.x = cvt_pk(v[0], v[1]); w.y = cvt_pk(v[2], v[3]); *(u32x2*)(O + (size_t)row * ld + col) = w; } };
struct EpiDnIn { static constexpr bool GU = false; bf16_t* PROJ; float* BA;
    __device__ __forceinline__ void st(int row, int col, f32x4 v) const {
        u32x2 w; w.x = cvt_pk(v[0], v[1]); w.y = cvt_pk(v[2], v[3]); *(u32x2*)(PROJ + (size_t)row * DNPROJP + col) = w;
        if (col >= 4096 && col < DNPROJ) *(float4*)(BA + (size_t)row * 16 + (col - 4096)) = make_float4(v[0], v[1], v[2], v[3]); } };
struct EpiF32 { static constexpr bool GU = false; float* O; int ld;
    __device__ __forceinline__ void st(int row, int col, f32x4 v) const { *(float4*)(O + (size_t)row * ld + col) = make_float4(v[0], v[1], v[2], v[3]); } };
template <class E> struct EpiScaled { static constexpr bool GU = E::GU; E e; const float* ss;
    __device__ __forceinline__ float rs(int row) const {
        const __attribute__((address_space(1))) f32x4* q = (const __attribute__((address_space(1))) f32x4*)(ss + (size_t)row * 16); const f32x4 a = q[0], b = q[1], c = q[2], d = q[3];
        const float t = ((a[0] + a[1]) + (a[2] + a[3])) + ((b[0] + b[1]) + (b[2] + b[3])) + ((c[0] + c[1]) + (c[2] + c[3])) + ((d[0] + d[1]) + (d[2] + d[3]));
        return rsqrtf(t * (1.0f / D) + RMS_EPS); }
    __device__ __forceinline__ void st(int row, int col, f32x4 v) const { e.st(row, col, v * rs(row)); }
    __device__ __forceinline__ void st2(int row, int colg, f32x4 g, f32x4 u) const { const float r = rs(row); e.st2(row, colg, g * r, u * r); } };
struct EpiGU { static constexpr bool GU = true; bf16_t* HF;
    __device__ __forceinline__ void st2(int row, int colg, f32x4 g, f32x4 u) const {
        const int ff = (colg >> 5) * 16 + (colg & 15);
        u32x2 w; w.x = cvt_pk(siluf_(g[0]) * u[0], siluf_(g[1]) * u[1]); w.y = cvt_pk(siluf_(g[2]) * u[2], siluf_(g[3]) * u[3]);
        *(u32x2*)(HF + (size_t)row * DFF + ff) = w; } };

template <class Epi>
__device__ __forceinline__ void gemm_phase(const GemmDesc g, const Epi& epi, LAS char* smem) {
    constexpr int AP = 72;
    LAS bf16_t* As = (LAS bf16_t*)smem;
    LAS bf16_t* Bs = (LAS bf16_t*)(smem + 2 * 256 * AP * 2);
    int tid_ = threadIdx.x; asm volatile("" : "+v"(tid_));
    const int tid = tid_, lane = tid & 63, wid = tid >> 6, wm = wid >> 1, wn = wid & 1, li = lane & 15, lg = lane >> 4;
    const int nN = g.N >> 7, nU = (g.npm - g.pm0) * nN, nk = g.K >> 6;
    const int lrow = tid >> 3, lkc = (tid & 7) * 8;
    for (int u = blockIdx.x; u < nU; u += gridDim.x) {
        const int pq = u / nN, pn = u - pq * nN, pm = pq + g.pm0, m0 = pm << 8, n0 = pn << 7;
        const bf16_t* Ab = g.A + (size_t)m0 * g.lda + (g.ablk ? (n0 / g.ablk) * g.K : 0) + (size_t)lrow * g.lda + lkc;
        const bf16_t* Bb = g.Bt + (size_t)n0 * g.K + (size_t)lrow * g.K + lkc;
        f32x4 acc[4][4];
#pragma unroll
        for (int a = 0; a < 4; ++a)
#pragma unroll
            for (int b = 0; b < 4; ++b) acc[a][b] = (f32x4){0.f, 0.f, 0.f, 0.f};
        u32x4 ra[4], rb[2];
#pragma unroll
        for (int i = 0; i < 4; ++i) ra[i] = *(const u32x4*)(Ab + (size_t)(64 * i) * g.lda);
#pragma unroll
        for (int i = 0; i < 2; ++i) rb[i] = *(const u32x4*)(Bb + (size_t)(64 * i) * g.K);
#pragma unroll
        for (int i = 0; i < 4; ++i) *(LAS u32x4*)(As + (lrow + 64 * i) * AP + lkc) = ra[i];
#pragma unroll
        for (int i = 0; i < 2; ++i) *(LAS u32x4*)(Bs + (lrow + 64 * i) * AP + lkc) = rb[i];
        __syncthreads();
#pragma unroll 1
        for (int ks = 0; ks < nk; ++ks) {
            const int st = ks & 1;
            if (ks + 1 < nk) {
#pragma unroll
                for (int i = 0; i < 4; ++i) ra[i] = *(const u32x4*)(Ab + (size_t)(64 * i) * g.lda + (ks + 1) * 64);
#pragma unroll
                for (int i = 0; i < 2; ++i) rb[i] = *(const u32x4*)(Bb + (size_t)(64 * i) * g.K + (ks + 1) * 64);
            }
            const LAS bf16_t* as = As + st * 256 * AP + (wm * 64 + li) * AP + lg * 8;
            const LAS bf16_t* bs = Bs + st * 128 * AP + (wn * 64 + li) * AP + lg * 8;
#pragma unroll
            for (int kk = 0; kk < 2; ++kk) {
                bf16x8 xf[4], wf[4];
#pragma unroll
                for (int t = 0; t < 4; ++t) { xf[t] = *(const LAS bf16x8*)(as + t * 16 * AP + kk * 32); wf[t] = *(const LAS bf16x8*)(bs + t * 16 * AP + kk * 32); }
#pragma unroll
                for (int nt = 0; nt < 4; ++nt)
#pragma unroll
                    for (int mt = 0; mt < 4; ++mt) acc[nt][mt] = mfma16(wf[nt], xf[mt], acc[nt][mt]);
            }
            if (ks + 1 < nk) {
#pragma unroll
                for (int i = 0; i < 4; ++i) *(LAS u32x4*)(As + (st ^ 1) * 256 * AP + (lrow + 64 * i) * AP + lkc) = ra[i];
#pragma unroll
                for (int i = 0; i < 2; ++i) *(LAS u32x4*)(Bs + (st ^ 1) * 128 * AP + (lrow + 64 * i) * AP + lkc) = rb[i];
            }
            __syncthreads();
        }
        {   const int rowbase = m0 + wm * 64, colbase = n0 + wn * 64;
#pragma unroll
            for (int mt = 0; mt < 4; ++mt) { const int row = rowbase + 16 * mt + li;
                if constexpr (Epi::GU) {
#pragma unroll
                    for (int qq = 0; qq < 2; ++qq) epi.st2(row, colbase + 32 * qq + 4 * lg, acc[2 * qq][mt], acc[2 * qq + 1][mt]);
                } else {
#pragma unroll
                    for (int nt = 0; nt < 4; ++nt) epi.st(row, colbase + 16 * nt + 4 * lg, acc[nt][mt]);
                } } }
    }
}

namespace pg8 {
#define PG8_LAS __attribute__((address_space(3)))
constexpr int BM = 256, BK = 64, HALF = 128, HTB = HALF * BK * 2  , STAGE_BYTES = 8 * HTB, NXCD = 8, WGM = 8;

__host__ __device__ __forceinline__ int lds_byte(int r, int c) { const int st = (r >> 4) * 2 + (c >> 5), rr = r & 15, cc = c & 31, ob = rr * 64 + cc * 2; return st * 1024 + (ob ^ (((ob >> 9) & 1) << 5)); }
__host__ __device__ __forceinline__ void stage_rc(int b, int& R, int& C) { const int st = b / 1024, sb = b % 1024, swz = sb ^ (((sb >> 9) & 1) << 5); R = (st >> 1) * 16 + swz / 64; C = (st & 1) * 32 + (swz % 64) / 2; }
__host__ __device__ __forceinline__ int perm32(int rho) { const int n = rho >> 4, i = rho & 15; return 8 * (i >> 2) + 4 * n + (i & 3); }

struct Unit { int pm, pn; };
struct Gemm { const bf16_t* A; const bf16_t* Bt; int M, N, K; int lda = 0, ablk = 0; };

struct StaticOrder {
    int nM, nN, nwg, G, c;
    __host__ __device__ void init(int M, int N, int G_, int c_) { nM = M / BM; nN = N / BM; nwg = nM * nN; G = G_; c = c_; }
    __host__ __device__ bool next(int i, Unit& u) const {
        const long L = (long)i * G + c; if (L >= nwg) return false;
        int wgid = (int)L; { const int q = nwg / NXCD, r = nwg % NXCD, xcd = wgid % NXCD, off = wgid / NXCD; wgid = (xcd < r ? xcd * (q + 1) : r * (q + 1) + (xcd - r) * q) + off; }
        const int nig = WGM * nN, gid = wgid / nig, fm = gid * WGM, gsz = (nM - fm) < WGM ? (nM - fm) : WGM;
        u.pm = fm + ((wgid % nig) % gsz); u.pn = (wgid % nig) / gsz; return true;
    }
    __device__ __forceinline__ void a_ready(const Unit&) const {}
    __device__ __forceinline__ void done(const Unit&) const {}
};
template <class Epi, class Sched, bool ALIGN_EPI = false, bool SP2 = false, int LDA = 0, int ABLK = 0>
__device__ __forceinline__ void gemm_phase(PG8_LAS unsigned char* lds, const Gemm g, const Sched& S, const Epi& E) {
    int tid_ = threadIdx.x; asm volatile("" : "+v"(tid_));
    const int tid = tid_, wid = __builtin_amdgcn_readfirstlane(tid >> 6), lane = tid & 63, wr = wid >> 2, wc = wid & 3, fr = lane & 15, fq = lane >> 4;
    const int K = g.K, nt = K / BK, lda = LDA ? LDA : g.K;
    unsigned voffA[2], voffB[2];
#pragma unroll
    for (int i = 0; i < 2; ++i) { int R, C; stage_rc(tid * 16 + i * 8192, R, C); const int Rb = Epi::PERM ? ((R & ~31) + perm32(R & 31)) : R;
        voffA[i] = (unsigned)(R * lda + C) * 2u; voffB[i] = (unsigned)(Rb * K + C) * 2u; }
    const size_t kstep = (size_t)(BK * 2);
    const size_t hstep = (size_t)HALF * K * 2;
    const size_t tstep = 2 * hstep;
    const size_t hstepA = (size_t)HALF * lda * 2, tstepA = 2 * hstepA;
    auto akoff = [&](int pn) -> size_t { if constexpr (ABLK > 0) return (size_t)((pn * BM) / ABLK) * K * 2; else return (size_t)0; };
    const unsigned ldsw = (unsigned)wid * 1024u;
    const int aoff = lds_byte(wr * 64 + fr, fq * 8), boff = lds_byte(wc * 32 + fr, fq * 8);
#define PG8_SA(b, h) (((b) * 2 + (h)) * HTB)
#define PG8_SB(b, h) ((4 + (b) * 2 + (h)) * HTB)
#define PG8_STAGE(bufoff, gbase, voff) do { _Pragma("unroll") for (int _i = 0; _i < 2; ++_i) \
        __builtin_amdgcn_global_load_lds((const __attribute__((address_space(1))) unsigned*)((const char*)(gbase) + (voff)[_i]), (PG8_LAS unsigned*)(lds + (bufoff) + ldsw + _i * 8192), 16, 0, 0); } while (0)
#define PG8_LDA(dst, b, h) do { _Pragma("unroll") for (int m = 0; m < 4; ++m) _Pragma("unroll") for (int k = 0; k < 2; ++k) dst[m][k] = *(const PG8_LAS bf16x8*)(lds + PG8_SA(b, h) + aoff + m * 2048 + k * 1024); } while (0)
#define PG8_LDB(dst, b, h) do { _Pragma("unroll") for (int n = 0; n < 2; ++n) _Pragma("unroll") for (int k = 0; k < 2; ++k) dst[n][k] = *(const PG8_LAS bf16x8*)(lds + PG8_SB(b, h) + boff + n * 2048 + k * 1024); } while (0)
#define PG8_MMA(ai, bj, At, Bt) do { __builtin_amdgcn_s_setprio(1); _Pragma("unroll") for (int m = 0; m < 4; ++m) _Pragma("unroll") for (int n = 0; n < 2; ++n) _Pragma("unroll") for (int k = 0; k < 2; ++k) \
        acc[ai][bj][m][n] = __builtin_amdgcn_mfma_f32_16x16x32_bf16(Bt[n][k], At[m][k], acc[ai][bj][m][n], 0, 0, 0); __builtin_amdgcn_s_setprio(0); } while (0)
#define PG8_WAIT_V(n) asm volatile("s_waitcnt vmcnt(" #n ")" ::: "memory")
#define PG8_WAIT_L(n) asm volatile("s_waitcnt lgkmcnt(" #n ")" ::: "memory")
#define PG8_BAR __builtin_amdgcn_s_barrier()
#define PG8_SCHED __builtin_amdgcn_sched_barrier(0)
    Unit cur, nxt; int ui = 0;
    if (!S.next(0, cur)) return;
    f32x4 acc[2][2][4][2];
#pragma unroll
    for (int a = 0; a < 2; ++a)
#pragma unroll
        for (int b = 0; b < 2; ++b)
#pragma unroll
            for (int m = 0; m < 4; ++m)
#pragma unroll
                for (int n = 0; n < 2; ++n) acc[a][b][m][n] = (f32x4){0.f, 0.f, 0.f, 0.f};
    bf16x8 At[4][2], B0[2][2], B1[2][2];
    const char* cA = (const char*)g.A + (size_t)cur.pm * tstepA + akoff(cur.pn); const char* cB = (const char*)g.Bt + (size_t)cur.pn * tstep;
    S.a_ready(cur);
    if constexpr (SP2) {
        PG8_STAGE(PG8_SB(0, 0), cB, voffB); PG8_STAGE(PG8_SB(0, 1), cB + hstep, voffB); PG8_STAGE(PG8_SA(0, 0), cA, voffA); PG8_STAGE(PG8_SA(0, 1), cA + hstepA, voffA);
        if (wr == 1) PG8_BAR;
        PG8_WAIT_V(2); PG8_BAR;
        PG8_STAGE(PG8_SB(1, 0), cB + kstep, voffB); PG8_STAGE(PG8_SA(1, 0), cA + kstep, voffA); PG8_STAGE(PG8_SB(1, 1), cB + hstep + kstep, voffB);
        PG8_WAIT_V(6); PG8_BAR;
    } else {
        PG8_STAGE(PG8_SB(0, 0), cB, voffB); PG8_STAGE(PG8_SA(0, 0), cA, voffA); PG8_STAGE(PG8_SB(0, 1), cB + hstep, voffB); PG8_STAGE(PG8_SA(0, 1), cA + hstepA, voffA);
        if (wr == 1) PG8_BAR;
        PG8_WAIT_V(4); PG8_BAR;
        PG8_STAGE(PG8_SB(1, 0), cB + kstep, voffB); PG8_STAGE(PG8_SA(1, 0), cA + kstep, voffA); PG8_STAGE(PG8_SB(1, 1), cB + hstep + kstep, voffB);
        PG8_WAIT_V(6); PG8_BAR;
    }
    for (;;) {
        const bool has_next = S.next(ui + 1, nxt);
        const char* nA = has_next ? (const char*)g.A + (size_t)nxt.pm * tstepA + akoff(nxt.pn) : cA; const char* nB = has_next ? (const char*)g.Bt + (size_t)nxt.pn * tstep : cB;
#pragma unroll 1
        for (int t = 0; t < nt; t += 2) {
            const bool last = (t == nt - 2);
            const char* a1 = cA + (size_t)(t + 1) * kstep;
            const char* a2 = last ? nA : cA + (size_t)(t + 2) * kstep; const char* b2 = last ? nB : cB + (size_t)(t + 2) * kstep;
            const char* a3 = a2 + kstep; const char* b3 = b2 + kstep;
            if (last && has_next) S.a_ready(nxt);
            if constexpr (SP2) {
            PG8_LDB(B0, 0, 0); PG8_LDB(B1, 0, 1); PG8_SCHED; PG8_LDA(At, 0, 0); PG8_STAGE(PG8_SA(1, 1), a1 + hstepA, voffA);
            PG8_WAIT_V(8); PG8_WAIT_L(0); PG8_BAR; PG8_MMA(0, 0, At, B0); PG8_MMA(0, 1, At, B1); PG8_BAR; PG8_SCHED;
            PG8_LDA(At, 0, 1); PG8_STAGE(PG8_SB(0, 0), b2, voffB); PG8_STAGE(PG8_SB(0, 1), b2 + hstep, voffB); PG8_STAGE(PG8_SA(0, 0), a2, voffA);
            PG8_WAIT_V(8); PG8_WAIT_L(0); PG8_BAR; PG8_MMA(1, 0, At, B0); PG8_MMA(1, 1, At, B1); PG8_BAR; PG8_SCHED;
            PG8_LDB(B0, 1, 0); PG8_LDB(B1, 1, 1); PG8_SCHED; PG8_LDA(At, 1, 0); PG8_STAGE(PG8_SA(0, 1), a2 + hstepA, voffA);
            PG8_WAIT_V(8); PG8_WAIT_L(0); PG8_BAR; PG8_MMA(0, 0, At, B0); PG8_MMA(0, 1, At, B1); PG8_BAR; PG8_SCHED;
            PG8_LDA(At, 1, 1); PG8_STAGE(PG8_SB(1, 0), b3, voffB); PG8_STAGE(PG8_SB(1, 1), b3 + hstep, voffB); PG8_STAGE(PG8_SA(1, 0), a3, voffA);
            PG8_WAIT_V(8); PG8_WAIT_L(0); PG8_BAR; PG8_MMA(1, 0, At, B0); PG8_MMA(1, 1, At, B1); PG8_BAR; PG8_SCHED;
            } else {
            PG8_LDB(B0, 0, 0); PG8_SCHED; PG8_LDA(At, 0, 0); PG8_STAGE(PG8_SA(1, 1), a1 + hstepA, voffA);
            PG8_WAIT_L(8); PG8_BAR; PG8_WAIT_L(0); PG8_MMA(0, 0, At, B0); PG8_BAR; PG8_SCHED;
            PG8_LDB(B1, 0, 1); PG8_STAGE(PG8_SB(0, 0), b2, voffB);
            PG8_BAR; PG8_WAIT_L(0); PG8_MMA(0, 1, At, B1); PG8_BAR;
            PG8_LDA(At, 0, 1); PG8_STAGE(PG8_SA(0, 0), a2, voffA);
            PG8_BAR; PG8_WAIT_L(0); PG8_MMA(1, 0, At, B0); PG8_BAR; PG8_SCHED;
            PG8_STAGE(PG8_SB(0, 1), b2 + hstep, voffB);
            PG8_WAIT_V(6); PG8_BAR; PG8_MMA(1, 1, At, B1); PG8_BAR;
            PG8_LDB(B0, 1, 0); PG8_SCHED; PG8_LDA(At, 1, 0); PG8_STAGE(PG8_SA(0, 1), a2 + hstepA, voffA);
            PG8_WAIT_L(8); PG8_BAR; PG8_WAIT_L(0); PG8_MMA(0, 0, At, B0); PG8_BAR; PG8_SCHED;
            PG8_LDB(B1, 1, 1); PG8_STAGE(PG8_SB(1, 0), b3, voffB);
            PG8_BAR; PG8_WAIT_L(0); PG8_MMA(0, 1, At, B1); PG8_BAR;
            PG8_LDA(At, 1, 1); PG8_STAGE(PG8_SA(1, 0), a3, voffA);
            PG8_BAR; PG8_WAIT_L(0); PG8_MMA(1, 0, At, B0); PG8_BAR; PG8_SCHED;
            PG8_STAGE(PG8_SB(1, 1), b3 + hstep, voffB);
            PG8_WAIT_V(6); PG8_BAR; PG8_MMA(1, 1, At, B1); PG8_BAR;
            }
        }
        if constexpr (ALIGN_EPI) { if (wr == 0) PG8_BAR; }
        if constexpr (!Epi::AFTER_DRAIN) { E(acc, cur, wr, wc, fr, fq); S.done(cur); }
        if (!has_next) break;
#pragma unroll
        for (int a = 0; a < 2; ++a)
#pragma unroll
            for (int b = 0; b < 2; ++b)
#pragma unroll
                for (int m = 0; m < 4; ++m)
#pragma unroll
                    for (int n = 0; n < 2; ++n) acc[a][b][m][n] = (f32x4){0.f, 0.f, 0.f, 0.f};
        cur = nxt; cA = nA; cB = nB; ++ui;
        if constexpr (ALIGN_EPI) { if (wr == 1) PG8_BAR; }
    }
    PG8_WAIT_V(0);
    if constexpr (!ALIGN_EPI) { if (wr == 0) PG8_BAR; }
    PG8_BAR;
    if constexpr (Epi::AFTER_DRAIN) { E.fused(acc, cur, wr, wc, fr, fq, lds, wid, lane); S.done(cur); }
#undef PG8_SA
#undef PG8_SB
#undef PG8_STAGE
#undef PG8_LDA
#undef PG8_LDB
#undef PG8_MMA
#undef PG8_WAIT_V
#undef PG8_WAIT_L
#undef PG8_BAR
#undef PG8_SCHED
}
}


struct EpiResidAt { static constexpr bool GU = false; float* X;
    __device__ __forceinline__ void st(int row, int col, f32x4 v) const { float* px = X + (size_t)row * D + col;
        unsafeAtomicAdd(px, v[0]); unsafeAtomicAdd(px + 1, v[1]); unsafeAtomicAdd(px + 2, v[2]); unsafeAtomicAdd(px + 3, v[3]); } };
template <bool XN, class Epi>
__device__ __forceinline__ void gemm_small(const bf16_t* A, int lda, const bf16_t* Bt, int K, int N, int row0, int nrt, int S, const Epi& epi, LAS char* smem, const float* Xf = nullptr, int ablk = 0) {
    constexpr int AP = 72;
    LAS bf16_t* As = (LAS bf16_t*)smem;
    LAS bf16_t* Bs = (LAS bf16_t*)(smem + 2 * 64 * AP * 2);
    LAS float* rsS = (LAS float*)(smem + 2 * 64 * AP * 2 + 2 * 128 * AP * 2);
    int tid_ = threadIdx.x; asm volatile("" : "+v"(tid_));
    const int tid = tid_, lane = tid & 63, wid = tid >> 6, wm = wid >> 2, wn = wid & 3, li = lane & 15, lg = lane >> 4;
    const int nN = N >> 7, kper = (K >> 6) / S, nU = nrt * nN * S;
    const int lrow = tid >> 3, lkc = (tid & 7) * 8;
    const int G = (int)gridDim.x, nmain = (MMAIN / 256) * (N >> 8), first = nmain % G;
    for (int u = ((int)blockIdx.x - first + G) % G; u < nU; u += G) {
        const int ksp = u % S, t = u / S, pn = t % nN, rt = t / nN, m0 = row0 + rt * 64, n0 = pn << 7, k0 = ksp * kper * 64;
        const bf16_t* Ab = A + (ablk ? (size_t)(n0 / ablk) * MP * K : (size_t)0) + (size_t)(m0 + lrow) * lda + k0 + lkc;
        const bf16_t* Bb = Bt + (size_t)(n0 + lrow) * K + k0 + lkc;
        f32x4 acc[2][2];
#pragma unroll
        for (int a = 0; a < 2; ++a)
#pragma unroll
            for (int b = 0; b < 2; ++b) acc[a][b] = (f32x4){0.f, 0.f, 0.f, 0.f};
        u32x4 ra, rb[2];
        const float* Xb = XN ? Xf + (size_t)(m0 + lrow) * D + k0 + lkc : nullptr;
        auto loadA = [&](int ks) { if constexpr (XN) { const float4 a = *(const float4*)(Xb + ks * 64), c = *(const float4*)(Xb + ks * 64 + 4); ra = (u32x4){cvt_pk(a.x, a.y), cvt_pk(a.z, a.w), cvt_pk(c.x, c.y), cvt_pk(c.z, c.w)}; } else ra = *(const u32x4*)(Ab + ks * 64); };
        if constexpr (XN) {
#pragma unroll
            for (int r = 0; r < 8; ++r) { const float4* xr = (const float4*)(Xf + (size_t)(m0 + wid * 8 + r) * D); float ss = 0.f;
#pragma unroll
                for (int i = 0; i < 4; ++i) { const float4 v = xr[lane + 64 * i]; ss += v.x * v.x + v.y * v.y + v.z * v.z + v.w * v.w; }
                ss = wave_sum(ss); if (lane == 0) rsS[wid * 8 + r] = rsqrtf(ss * (1.0f / D) + RMS_EPS); }
        }
        loadA(0);
#pragma unroll
        for (int i = 0; i < 2; ++i) rb[i] = *(const u32x4*)(Bb + (size_t)(64 * i) * K);
        *(LAS u32x4*)(As + lrow * AP + lkc) = ra;
#pragma unroll
        for (int i = 0; i < 2; ++i) *(LAS u32x4*)(Bs + (lrow + 64 * i) * AP + lkc) = rb[i];
        __syncthreads();
#pragma unroll 1
        for (int ks = 0; ks < kper; ++ks) {
            const int st = ks & 1;
            if (ks + 1 < kper) { loadA(ks + 1);
#pragma unroll
                for (int i = 0; i < 2; ++i) rb[i] = *(const u32x4*)(Bb + (size_t)(64 * i) * K + (ks + 1) * 64); }
            const LAS bf16_t* as = As + st * 64 * AP + (wm * 32 + li) * AP + lg * 8;
            const LAS bf16_t* bs = Bs + st * 128 * AP + (wn * 32 + li) * AP + lg * 8;
#pragma unroll
            for (int kk = 0; kk < 2; ++kk) {
                bf16x8 xf[2], wf[2];
#pragma unroll
                for (int t2 = 0; t2 < 2; ++t2) { xf[t2] = *(const LAS bf16x8*)(as + t2 * 16 * AP + kk * 32); wf[t2] = *(const LAS bf16x8*)(bs + t2 * 16 * AP + kk * 32); }
#pragma unroll
                for (int nt = 0; nt < 2; ++nt)
#pragma unroll
                    for (int mt = 0; mt < 2; ++mt) acc[nt][mt] = mfma16(wf[nt], xf[mt], acc[nt][mt]);
            }
            if (ks + 1 < kper) { *(LAS u32x4*)(As + (st ^ 1) * 64 * AP + lrow * AP + lkc) = ra;
#pragma unroll
                for (int i = 0; i < 2; ++i) *(LAS u32x4*)(Bs + (st ^ 1) * 128 * AP + (lrow + 64 * i) * AP + lkc) = rb[i]; }
            __syncthreads();
        }
#pragma unroll
        for (int mt = 0; mt < 2; ++mt) { const int row = m0 + wm * 32 + 16 * mt + li, colb = n0 + wn * 32 + 4 * lg;
            if constexpr (XN) { const float r = rsS[wm * 32 + 16 * mt + li]; acc[0][mt] *= r; acc[1][mt] *= r; }
            if constexpr (Epi::GU) epi.st2(row, colb, acc[0][mt], acc[1][mt]);
            else { epi.st(row, colb, acc[0][mt]); epi.st(row, colb + 16, acc[1][mt]); } }
        if constexpr (XN) __syncthreads();
    }
}

template <class T> struct is_scaled : std::false_type {};
template <class E> struct is_scaled<EpiScaled<E>> : std::true_type {};
template <class E> struct PgEpi {
    static constexpr bool PERM = false, AFTER_DRAIN = false; E e;
    __device__ __forceinline__ void operator()(const f32x4 (&acc)[2][2][4][2], const pg8::Unit& u, int wr, int wc, int fr, int fq) const {
#pragma unroll
        for (int ai = 0; ai < 2; ++ai)
#pragma unroll
            for (int m = 0; m < 4; ++m) { const int row = u.pm * 256 + ai * 128 + wr * 64 + m * 16 + fr; float r = 1.f;
                if constexpr (is_scaled<E>::value) r = e.rs(row);
#pragma unroll
                for (int bj = 0; bj < 2; ++bj) { const int colb = u.pn * 256 + bj * 128 + wc * 32 + 4 * fq;
                    if constexpr (is_scaled<E>::value) {
                        if constexpr (E::GU) e.e.st2(row, colb, acc[ai][bj][m][0] * r, acc[ai][bj][m][1] * r);
                        else { e.e.st(row, colb, acc[ai][bj][m][0] * r); e.e.st(row, colb + 16, acc[ai][bj][m][1] * r); } }
                    else {
                        if constexpr (E::GU) e.st2(row, colb, acc[ai][bj][m][0], acc[ai][bj][m][1]);
                        else { e.st(row, colb, acc[ai][bj][m][0]); e.st(row, colb + 16, acc[ai][bj][m][1]); } } }
                asm volatile("" ::: "memory"); }
    }
};
struct GateOrder { int G, c;
    __device__ __forceinline__ bool next(int i, pg8::Unit& u) const { const int L = i * G + c; if (L >= 512) return false;
        const int half = L & 1, pm = (L >> 1) & 63, blk = L >> 7; u.pm = blk * NPANEL + pm; u.pn = 2 * blk + half; return true; }
    __device__ __forceinline__ void a_ready(const pg8::Unit&) const {}
    __device__ __forceinline__ void done(const pg8::Unit&) const {} };
struct PgEpiGate { static constexpr bool PERM = false, AFTER_DRAIN = false; EpiGate e;
    __device__ __forceinline__ void operator()(const f32x4 (&acc)[2][2][4][2], const pg8::Unit& u, int wr, int wc, int fr, int fq) const {
        const int pm = u.pm % NPANEL;
#pragma unroll
        for (int ai = 0; ai < 2; ++ai)
#pragma unroll
            for (int m = 0; m < 4; ++m) { const int row = pm * 256 + ai * 128 + wr * 64 + m * 16 + fr;
#pragma unroll
                for (int bj = 0; bj < 2; ++bj) { const int colb = u.pn * 256 + bj * 128 + wc * 32 + 4 * fq; e.st(row, colb, acc[ai][bj][m][0]); e.st(row, colb + 16, acc[ai][bj][m][1]); asm volatile("" ::: "memory"); } }
    } };
template <class E>
__device__ __forceinline__ void big_gemm(const bf16_t* A, const bf16_t* Bt, int N, int K, const E& e, LAS char* smem) {
    A = uni(A); Bt = uni(Bt);
    pg8::Gemm g{A, Bt, MMAIN, N, K}; pg8::StaticOrder S; S.init(MMAIN, N, (int)gridDim.x, (int)blockIdx.x);
    PgEpi<E> pe{e};
    pg8::gemm_phase<PgEpi<E>, pg8::StaticOrder, true, true>((LAS unsigned char*)smem, g, S, pe);
    __syncthreads();
    gemm_small<false>(A, K, Bt, K, N, MMAIN, 3, 1, e, smem);
}
template <class E>
__device__ __forceinline__ void norm_gemm(const P& p, const bf16_t* Bt, int N, int site, const E& e, LAS char* smem) {
    const bf16_t* A = uni((const bf16_t*)p.H); Bt = uni(Bt); const float* ss = uni((const float*)p.SS) + (size_t)site * MP * 16;
    pg8::Gemm g{A, Bt, MMAIN, N, D}; pg8::StaticOrder S; S.init(MMAIN, N, (int)gridDim.x, (int)blockIdx.x);
    PgEpi<EpiScaled<E>> pe{EpiScaled<E>{e, ss}};
    pg8::gemm_phase<PgEpi<EpiScaled<E>>, pg8::StaticOrder, true, true>((LAS unsigned char*)smem, g, S, pe);
    __syncthreads();
    gemm_small<true>(A, D, Bt, D, N, MMAIN, 3, 1, e, smem, uni((const float*)p.X));
}
struct PgEpiResidN { static constexpr bool PERM = false, AFTER_DRAIN = false; float* X; bf16_t* XB; float* SSo;
    __device__ __forceinline__ void operator()(const f32x4 (&acc)[2][2][4][2], const pg8::Unit& u, int wr, int wc, int fr, int fq) const {
#pragma unroll
        for (int ai = 0; ai < 2; ++ai)
#pragma unroll
            for (int m = 0; m < 4; ++m) { const int row = u.pm * 256 + ai * 128 + wr * 64 + m * 16 + fr; float ssum = 0.f;
#pragma unroll
                for (int bj = 0; bj < 2; ++bj)
#pragma unroll
                    for (int n = 0; n < 2; ++n) { const int col = u.pn * 256 + bj * 128 + wc * 32 + 16 * n + 4 * fq; const f32x4 v = acc[ai][bj][m][n];
                        float4* px = (float4*)(X + (size_t)row * D + col); float4 x = *px; x.x += v[0]; x.y += v[1]; x.z += v[2]; x.w += v[3]; *px = x;
                        if (SSo) { *(u32x2*)(XB + (size_t)row * D + col) = (u32x2){cvt_pk(x.x, x.y), cvt_pk(x.z, x.w)}; ssum += x.x * x.x + x.y * x.y + x.z * x.z + x.w * x.w; } }
                if (SSo) { ssum = sum_x32(sum_x16(ssum)); if (fq == 0) SSo[(size_t)row * 16 + u.pn * 4 + wc] = ssum; } }
    }
};
__device__ __forceinline__ void resid_gemm(const P& p, const bf16_t* A, const bf16_t* Bt, int K, int site_out, LAS char* smem) {
    A = uni(A); Bt = uni(Bt); float* X = uni(p.X);
    pg8::Gemm g{A, Bt, MMAIN, D, K}; pg8::StaticOrder S; S.init(MMAIN, D, (int)gridDim.x, (int)blockIdx.x);
    PgEpiResidN pe{X, uni(p.H), site_out >= 0 ? uni(p.SS) + (size_t)site_out * MP * 16 : nullptr};
    pg8::gemm_phase<PgEpiResidN, pg8::StaticOrder, true, true>((LAS unsigned char*)smem, g, S, pe);
    __syncthreads();
    gemm_small<false>(A, K, Bt, K, D, MMAIN, 3, (K == DFF) ? 11 : 8, EpiResidAt{X}, smem);
}

template <int J>
__device__ __forceinline__ void ph_lru_conv(const P& p) {
    const float* cw = p.in[14] + J * 4 * 1024; const float* cb = p.in[15] + J * 1024;
    const float* sbuf = p.in[3] + (size_t)J * NS * 3 * 1024;
    float* pconv = p.out + O_PLC + (size_t)J * NB * 3 * 1024; float* sconv = p.out + O_SLC + (size_t)J * NS * 3 * 1024;
    const int gt = blockIdx.x * NTHREADS + ltid(), nth = gridDim.x * NTHREADS;
    constexpr int RUN = 16, RPS = LP / RUN;
    for (int it = gt; it < NB * RPS * 128; it += nth) {
        const int run = it >> 7, c0 = (it & 127) * 8, b = run / RPS, t0 = (run - b * RPS) * RUN;
        float w[4][8], bias[8];
#pragma unroll
        for (int e = 0; e < 8; ++e) { bias[e] = cb[c0 + e];
#pragma unroll
            for (int j = 0; j < 4; ++j) w[j][e] = cw[j * 1024 + c0 + e]; }
        const bf16_t* src = p.G1 + ((size_t)b * LP + t0) * 2048 + 1024 + c0;
        float x[4][8];
#pragma unroll
        for (int j = 0; j < 3; ++j) { const int back = 3 - j;
            if (t0 >= back) { const u32x4 q = *(const u32x4*)(src - (size_t)back * 2048);
#pragma unroll
                for (int e = 0; e < 4; ++e) { x[j][2 * e] = bflo(q[e]); x[j][2 * e + 1] = bfhi(q[e]); } }
            else {
#pragma unroll
                for (int e = 0; e < 8; ++e) x[j][e] = 0.f; } }
        bf16_t* dst = p.XC + ((size_t)(c0 >> 8) * MP + (size_t)b * LP + t0) * 256 + (c0 & 255);
#pragma unroll 4
        for (int r = 0; r < RUN; ++r) {
            const u32x4 q = *(const u32x4*)(src + (size_t)r * 2048);
#pragma unroll
            for (int e = 0; e < 4; ++e) { x[3][2 * e] = bflo(q[e]); x[3][2 * e + 1] = bfhi(q[e]); }
            float y[8];
#pragma unroll
            for (int e = 0; e < 8; ++e) y[e] = bias[e] + x[0][e] * w[0][e] + x[1][e] * w[1][e] + x[2][e] * w[2][e] + x[3][e] * w[3][e];
            *(u32x4*)(dst + (size_t)r * 256) = (u32x4){cvt_pk(y[0], y[1]), cvt_pk(y[2], y[3]), cvt_pk(y[4], y[5]), cvt_pk(y[6], y[7])};
            const int t = t0 + r;
            if (t >= LP - 3) { float* d = pconv + (size_t)(b * 3 + (t - (LP - 3))) * 1024 + c0;
                *(float4*)d = make_float4(x[3][0], x[3][1], x[3][2], x[3][3]); *(float4*)(d + 4) = make_float4(x[3][4], x[3][5], x[3][6], x[3][7]); }
#pragma unroll
            for (int e = 0; e < 8; ++e) { x[0][e] = x[1][e]; x[1][e] = x[2][e]; x[2][e] = x[3][e]; }
        }
    }
    for (int it = gt; it < NS * 128; it += nth) {
        const int s = it >> 7, c0 = (it & 127) * 8; const size_t row = (size_t)NTOK + s;
        float x[4][8];
        { const u32x4 q = *(const u32x4*)(p.G1 + row * 2048 + 1024 + c0);
#pragma unroll
          for (int e = 0; e < 4; ++e) { x[3][2 * e] = bflo(q[e]); x[3][2 * e + 1] = bfhi(q[e]); } }
#pragma unroll
        for (int j = 0; j < 3; ++j) { const float* bsrc = sbuf + (size_t)(s * 3 + j) * 1024 + c0; const float4 a = *(const float4*)bsrc, bq = *(const float4*)(bsrc + 4);
            x[j][0] = a.x; x[j][1] = a.y; x[j][2] = a.z; x[j][3] = a.w; x[j][4] = bq.x; x[j][5] = bq.y; x[j][6] = bq.z; x[j][7] = bq.w; }
#pragma unroll
        for (int j = 0; j < 3; ++j) { float* d = sconv + (size_t)(s * 3 + j) * 1024 + c0;
            *(float4*)d = make_float4(x[j + 1][0], x[j + 1][1], x[j + 1][2], x[j + 1][3]); *(float4*)(d + 4) = make_float4(x[j + 1][4], x[j + 1][5], x[j + 1][6], x[j + 1][7]); }
        float y[8];
#pragma unroll
        for (int e = 0; e < 8; ++e) { y[e] = cb[c0 + e];
#pragma unroll
            for (int j = 0; j < 4; ++j) y[e] += x[j][e] * cw[j * 1024 + c0 + e]; }
        *(u32x4*)(p.XC + ((size_t)(c0 >> 8) * MP + row) * 256 + (c0 & 255)) = (u32x4){cvt_pk(y[0], y[1]), cvt_pk(y[2], y[3]), cvt_pk(y[4], y[5]), cvt_pk(y[6], y[7])};
    }
}

__device__ __forceinline__ void lru_au(float cla, float r, float ig, float xc, float& a, float& u) {
    const float la = cla * r, x2 = 2.0f * la; a = __builtin_amdgcn_exp2f(1.4426950408889634f * la);
    const float om = (x2 > -0.02f) ? -x2 * (1.0f + x2 * (0.5f + x2 * (1.0f / 6.0f))) : 1.0f - a * a;
    u = __builtin_amdgcn_sqrtf(om) * (ig * xc);
}
template <int J>
__device__ __forceinline__ void ph_scan1(const P& p) {
    const float* lam = p.in[20] + J * 1024;
    const int tid = ltid(), sub = tid >> 8, ch = (tid & 255) * 4, blk = ch >> 8, cc = ch & 255;
    float cla[4];
#pragma unroll
    for (int e = 0; e < 4; ++e) cla[e] = -8.0f * softplusf_(-lam[ch + e]);
    for (int u = blockIdx.x; u < NB * SCH / 2; u += gridDim.x) {
        const int pr_ = 2 * u + sub, b = pr_ / SCH, ci = pr_ - b * SCH;
        const size_t row0 = (size_t)b * LP + ci * SCL; const int len = (ci == SCH - 1) ? LP - (SCH - 1) * SCL : SCL;
        const bf16_t* pr = p.RI + row0 * 2048 + blk * 512 + cc; const bf16_t* px = p.XC + ((size_t)blk * MP + row0) * 256 + cc;
        float Pp[4] = {1.f, 1.f, 1.f, 1.f}, h[4] = {0.f, 0.f, 0.f, 0.f};
#pragma unroll 8
        for (int t = 0; t < len; ++t) {
            const u32x2 rw = *(const u32x2*)(pr + (size_t)t * 2048), iw = *(const u32x2*)(pr + (size_t)t * 2048 + 256), xw = *(const u32x2*)(px + (size_t)t * 256);
            const float r[4] = {bflo(rw.x), bfhi(rw.x), bflo(rw.y), bfhi(rw.y)}, ig[4] = {bflo(iw.x), bfhi(iw.x), bflo(iw.y), bfhi(iw.y)}, xc[4] = {bflo(xw.x), bfhi(xw.x), bflo(xw.y), bfhi(xw.y)};
#pragma unroll
            for (int e = 0; e < 4; ++e) { float a, uu; lru_au(cla[e], r[e], ig[e], xc[e], a, uu); h[e] = a * h[e] + uu; Pp[e] *= a; }
        }
        *(float4*)(p.CP + (size_t)(b * SCH + ci) * 1024 + ch) = make_float4(Pp[0], Pp[1], Pp[2], Pp[3]);
        *(float4*)(p.CH + (size_t)(b * SCH + ci) * 1024 + ch) = make_float4(h[0], h[1], h[2], h[3]);
    }
}
template <int J>
__device__ __forceinline__ void ph_scan2(const P& p) {
    const float* lam = p.in[20] + J * 1024;
    const int tid = ltid(), sub = tid >> 8, ch = (tid & 255) * 4, blk = ch >> 8, cc = ch & 255;
    float cla[4];
#pragma unroll
    for (int e = 0; e < 4; ++e) cla[e] = -8.0f * softplusf_(-lam[ch + e]);
    for (int u = blockIdx.x; u < NB * SCH / 2 + NS / 2; u += gridDim.x) {
        if (u < NB * SCH / 2) {
            const int pr_ = 2 * u + sub, b = pr_ / SCH, ci = pr_ - b * SCH;
            float h[4] = {0.f, 0.f, 0.f, 0.f};
            for (int cj = 0; cj < ci; ++cj) { const float4 cp = *(const float4*)(p.CP + (size_t)(b * SCH + cj) * 1024 + ch), chv = *(const float4*)(p.CH + (size_t)(b * SCH + cj) * 1024 + ch);
                h[0] = cp.x * h[0] + chv.x; h[1] = cp.y * h[1] + chv.y; h[2] = cp.z * h[2] + chv.z; h[3] = cp.w * h[3] + chv.w; }
            const size_t row0 = (size_t)b * LP + ci * SCL; const int len = (ci == SCH - 1) ? LP - (SCH - 1) * SCL : SCL;
            const bf16_t* pr = p.RI + row0 * 2048 + blk * 512 + cc; const bf16_t* px = p.XC + ((size_t)blk * MP + row0) * 256 + cc; const bf16_t* pg = p.G1 + row0 * 2048 + ch;
            bf16_t* po = p.HG + row0 * 1024 + ch;
#pragma unroll 8
            for (int t = 0; t < len; ++t) {
                const u32x2 rw = *(const u32x2*)(pr + (size_t)t * 2048), iw = *(const u32x2*)(pr + (size_t)t * 2048 + 256), xw = *(const u32x2*)(px + (size_t)t * 256), gw = *(const u32x2*)(pg + (size_t)t * 2048);
                const float r[4] = {bflo(rw.x), bfhi(rw.x), bflo(rw.y), bfhi(rw.y)}, ig[4] = {bflo(iw.x), bfhi(iw.x), bflo(iw.y), bfhi(iw.y)}, xc[4] = {bflo(xw.x), bfhi(xw.x), bflo(xw.y), bfhi(xw.y)};
                const float gt[4] = {bflo(gw.x), bfhi(gw.x), bflo(gw.y), bfhi(gw.y)};
#pragma unroll
                for (int e = 0; e < 4; ++e) { float a, uu; lru_au(cla[e], r[e], ig[e], xc[e], a, uu); h[e] = a * h[e] + uu; }
                *(u32x2*)(po + (size_t)t * 1024) = (u32x2){cvt_pk(h[0] * gt[0], h[1] * gt[1]), cvt_pk(h[2] * gt[2], h[3] * gt[3])};
            }
            if (ci == SCH - 1) *(float4*)(p.out + O_PLH + (size_t)(J * NB + b) * 1024 + ch) = make_float4(h[0], h[1], h[2], h[3]);
        } else {
            const int s = 2 * (u - NB * SCH / 2) + sub; const size_t row = (size_t)NTOK + s;
            const u32x2 rw = *(const u32x2*)(p.RI + row * 2048 + blk * 512 + cc), iw = *(const u32x2*)(p.RI + row * 2048 + blk * 512 + 256 + cc), xw = *(const u32x2*)(p.XC + ((size_t)blk * MP + row) * 256 + cc), gw = *(const u32x2*)(p.G1 + row * 2048 + ch);
            const float r[4] = {bflo(rw.x), bfhi(rw.x), bflo(rw.y), bfhi(rw.y)}, ig[4] = {bflo(iw.x), bfhi(iw.x), bflo(iw.y), bfhi(iw.y)}, xc[4] = {bflo(xw.x), bfhi(xw.x), bflo(xw.y), bfhi(xw.y)};
            const float gt[4] = {bflo(gw.x), bfhi(gw.x), bflo(gw.y), bfhi(gw.y)};
            const float4 h0 = *(const float4*)(p.in[2] + (size_t)(J * NS + s) * 1024 + ch); const float h0v[4] = {h0.x, h0.y, h0.z, h0.w}; float h[4];
#pragma unroll
            for (int e = 0; e < 4; ++e) { float a, uu; lru_au(cla[e], r[e], ig[e], xc[e], a, uu); h[e] = a * h0v[e] + uu; }
            *(float4*)(p.out + O_SLH + (size_t)(J * NS + s) * 1024 + ch) = make_float4(h[0], h[1], h[2], h[3]);
            *(u32x2*)(p.HG + row * 1024 + ch) = (u32x2){cvt_pk(h[0] * gt[0], h[1] * gt[1]), cvt_pk(h[2] * gt[2], h[3] * gt[3])};
        }
    }
}

__device__ __forceinline__ void ph_dn_conv(const P& p) {
    const float* cw = p.in[23]; const float* sbuf = p.in[5];
    const int gt = blockIdx.x * NTHREADS + ltid(), nth = gridDim.x * NTHREADS;
    constexpr int RUN = 16, RPS = LP / RUN, NCG = DNQKV / 8;
    for (int it = gt; it < NB * RPS * NCG; it += nth) {
        const int run = it / NCG, cg = it - run * NCG, c0 = cg * 8, b = run / RPS, t0 = (run - b * RPS) * RUN; const bool nrm = c0 < 2048;
        float w[4][8];
#pragma unroll
        for (int e = 0; e < 8; ++e)
#pragma unroll
            for (int j = 0; j < 4; ++j) w[j][e] = cw[j * DNQKV + c0 + e];
        const bf16_t* src = p.PROJ + ((size_t)b * LP + t0) * DNPROJP + c0;
        float x[4][8];
#pragma unroll
        for (int j = 0; j < 3; ++j) { const int back = 3 - j;
            if (t0 >= back) { const u32x4 q = *(const u32x4*)(src - (size_t)back * DNPROJP);
#pragma unroll
                for (int e = 0; e < 4; ++e) { x[j][2 * e] = bflo(q[e]); x[j][2 * e + 1] = bfhi(q[e]); } }
            else {
#pragma unroll
                for (int e = 0; e < 8; ++e) x[j][e] = 0.f; } }
        bf16_t* dst = p.QKVN + ((size_t)b * LP + t0) * DNQKV + c0;
#pragma unroll 4
        for (int r = 0; r < RUN; ++r) {
            const u32x4 q = *(const u32x4*)(src + (size_t)r * DNPROJP);
#pragma unroll
            for (int e = 0; e < 4; ++e) { x[3][2 * e] = bflo(q[e]); x[3][2 * e + 1] = bfhi(q[e]); }
            float y[8]; float ss = 0.f;
#pragma unroll
            for (int e = 0; e < 8; ++e) { y[e] = siluf_(x[0][e] * w[0][e] + x[1][e] * w[1][e] + x[2][e] * w[2][e] + x[3][e] * w[3][e]); ss += y[e] * y[e]; }
            ss += __shfl_xor(ss, 1); ss += __shfl_xor(ss, 2); ss += __shfl_xor(ss, 4); ss += __shfl_xor(ss, 8);
            const float rn = nrm ? rsqrtf(ss + 1e-6f) : 1.0f;
            *(u32x4*)(dst + (size_t)r * DNQKV) = (u32x4){cvt_pk(y[0] * rn, y[1] * rn), cvt_pk(y[2] * rn, y[3] * rn), cvt_pk(y[4] * rn, y[5] * rn), cvt_pk(y[6] * rn, y[7] * rn)};
            const int t = t0 + r;
            if (t >= LP - 3) { float* d = p.out + O_PDC + (size_t)(b * 3 + (t - (LP - 3))) * DNQKV + c0;
                *(float4*)d = make_float4(x[3][0], x[3][1], x[3][2], x[3][3]); *(float4*)(d + 4) = make_float4(x[3][4], x[3][5], x[3][6], x[3][7]); }
#pragma unroll
            for (int e = 0; e < 8; ++e) { x[0][e] = x[1][e]; x[1][e] = x[2][e]; x[2][e] = x[3][e]; }
        }
    }
    for (int it = gt; it < NS * NCG; it += nth) {
        const int s = it / NCG, cg = it - s * NCG, c0 = cg * 8; const size_t row = (size_t)NTOK + s;
        float x[4][8];
        { const u32x4 q = *(const u32x4*)(p.PROJ + row * DNPROJP + c0);
#pragma unroll
          for (int e = 0; e < 4; ++e) { x[3][2 * e] = bflo(q[e]); x[3][2 * e + 1] = bfhi(q[e]); } }
#pragma unroll
        for (int j = 0; j < 3; ++j) { const float* bsrc = sbuf + (size_t)(s * 3 + j) * DNQKV + c0; const float4 a = *(const float4*)bsrc, bq = *(const float4*)(bsrc + 4);
            x[j][0] = a.x; x[j][1] = a.y; x[j][2] = a.z; x[j][3] = a.w; x[j][4] = bq.x; x[j][5] = bq.y; x[j][6] = bq.z; x[j][7] = bq.w; }
#pragma unroll
        for (int j = 0; j < 3; ++j) { float* d = p.out + O_SDC + (size_t)(s * 3 + j) * DNQKV + c0;
            *(float4*)d = make_float4(x[j + 1][0], x[j + 1][1], x[j + 1][2], x[j + 1][3]); *(float4*)(d + 4) = make_float4(x[j + 1][4], x[j + 1][5], x[j + 1][6], x[j + 1][7]); }
        float y[8]; float ss = 0.f;
#pragma unroll
        for (int e = 0; e < 8; ++e) { float a = 0.f;
#pragma unroll
            for (int j = 0; j < 4; ++j) a += x[j][e] * cw[j * DNQKV + c0 + e];
            y[e] = siluf_(a); ss += y[e] * y[e]; }
        ss += __shfl_xor(ss, 1); ss += __shfl_xor(ss, 2); ss += __shfl_xor(ss, 4); ss += __shfl_xor(ss, 8);
        const float rn = (c0 < 2048) ? rsqrtf(ss + 1e-6f) : 1.0f;
        *(u32x4*)(p.QKVN + row * DNQKV + c0) = (u32x4){cvt_pk(y[0] * rn, y[1] * rn), cvt_pk(y[2] * rn, y[3] * rn), cvt_pk(y[4] * rn, y[5] * rn), cvt_pk(y[6] * rn, y[7] * rn)};
    }
    for (int it = gt; it < (NTOK + NS) * 8; it += nth) {
        const int row = it >> 3, hh = it & 7;
        const float bb = p.BA[(size_t)row * 16 + hh], aa = p.BA[(size_t)row * 16 + 8 + hh];
        p.BG[(size_t)row * 16 + hh] = sigmoidf_(bb);
        p.BG[(size_t)row * 16 + 8 + hh] = -__expf(p.in[24][hh]) * softplusf_(aa + p.in[25][hh]);
    }
}

typedef float f32x2 __attribute__((ext_vector_type(2)));
template <int J>
__device__ __forceinline__ void solve_step(f32x2 (&s2)[32], const LAS float* Am) {
    const float sj = (J & 1) ? s2[J >> 1].y : s2[J >> 1].x;
    if constexpr ((J & 1) == 0) s2[J >> 1].y -= Am[J * 64 + J + 1] * sj;
    const f32x2 sjj = {sj, sj};
#pragma unroll
    for (int q = (J >> 1) + 1; q < 32; ++q) s2[q] -= *(const LAS f32x2*)(Am + J * 64 + 2 * q) * sjj;
    if constexpr ((J & 3) == 3) asm volatile("" ::: "memory");
    if constexpr (J + 1 < 63) solve_step<J + 1>(s2, Am);
}
__device__ __forceinline__ void ph_dn_chunk(const P& p, LAS char* smem) {
    constexpr int TP = 136;
    LAS float* Gs = (LAS float*)smem; LAS float* Bsh = Gs + 64; LAS float* gS = Bsh + 64;
    LAS float* Am = gS + 64;
    LAS bf16_t* Qs = (LAS bf16_t*)(Am + 4096); LAS bf16_t* Ks = Qs + 64 * TP; LAS bf16_t* Vs = Ks + 64 * TP;
    LAS bf16_t* SolS = Vs + 64 * TP;
    constexpr int NU3 = NB * NCHUNK * 8;
    for (int u = blockIdx.x; u < NU3; u += gridDim.x) {
        int tid = threadIdx.x; asm volatile("" : "+v"(tid));
        const int lane = tid & 63, wid = tid >> 6, li = lane & 15, lg = lane >> 4;
        {
            const int b = u / (NCHUNK * 8), rem = u - b * (NCHUNK * 8), c = rem >> 3, h = rem & 7;
            const int tbase = (c == 0) ? 0 : 16 + 64 * (c - 1), nvalid = (c == 0) ? 16 : 64;
            const size_t grow0 = (size_t)b * LP + tbase;
#pragma unroll
            for (int i = 0; i < 6; ++i) { const int cidx = tid + NTHREADS * i, which = cidx >> 10, r = (cidx >> 4) & 63, part = cidx & 15;
                u32x4 w = {0u, 0u, 0u, 0u};
                if (r < nvalid) w = *(const u32x4*)(p.QKVN + (grow0 + r) * DNQKV + which * 1024 + h * 128 + part * 8);
                *(LAS u32x4*)(Qs + which * 64 * TP + r * TP + part * 8) = w; }
            if (tid < 64) { const bool v = tid < nvalid; gS[tid] = v ? p.BG[(grow0 + tid) * 16 + 8 + h] : 0.f; Bsh[tid] = v ? p.BG[(grow0 + tid) * 16 + h] : 0.f; }
            __syncthreads();
            if (tid < 64) {
                float a = gS[tid];
#pragma unroll
                for (int o = 1; o < 64; o <<= 1) { const float t = __shfl_up(a, o); if (tid >= o) a += t; }
                Gs[tid] = a; }
            __syncthreads();
            {
#pragma unroll
                for (int tt = 0; tt < 4; ++tt) { const int tl = wid * 4 + tt, isQ = tl >> 4, it = (tl >> 2) & 3, jt = tl & 3;
                    const LAS bf16_t* Ap = (isQ ? Qs : Ks) + (16 * it + li) * TP + lg * 8; const LAS bf16_t* Bp = Ks + (16 * jt + li) * TP + lg * 8;
                    f32x4 acc = {0.f, 0.f, 0.f, 0.f};
#pragma unroll
                    for (int ks = 0; ks < 4; ++ks) acc = mfma16(*(const LAS bf16x8*)(Ap + ks * 32), *(const LAS bf16x8*)(Bp + ks * 32), acc);
                    const int j = 16 * jt + li; const float Gj = Gs[j];
#pragma unroll
                    for (int r = 0; r < 4; ++r) { const int i = 16 * it + 4 * lg + r; const float dec = __expf(Gs[i] - Gj);
                        if (isQ) p.DATT[(size_t)u * 4096 + i * 64 + j] = (bf16_t)(cvt_pk((j <= i) ? acc[r] * 0.08838834764831845f * dec : 0.f, 0.f) & 0xffffu);
                        else Am[j * 64 + i] = (j < i) ? Bsh[i] * acc[r] * dec : 0.f; } }
            }
            __syncthreads();
            if (tid < 256) {
                const int cidx = tid; f32x2 s2[32];
#pragma unroll
                for (int q = 0; q < 32; ++q) {
                    const int i0 = 2 * q, i1 = 2 * q + 1;
                    s2[q].x = (cidx < 128) ? bf2f(Vs[i0 * TP + cidx]) * Bsh[i0] : bf2f(Ks[i0 * TP + cidx - 128]) * Bsh[i0] * __expf(Gs[i0]);
                    s2[q].y = (cidx < 128) ? bf2f(Vs[i1 * TP + cidx]) * Bsh[i1] : bf2f(Ks[i1 * TP + cidx - 128]) * Bsh[i1] * __expf(Gs[i1]); }
                solve_step<0>(s2, Am);
#pragma unroll
                for (int q = 0; q < 32; ++q) { SolS[(2 * q) * 256 + cidx] = (bf16_t)(cvt_pk(s2[q].x, 0.f) & 0xffffu); SolS[(2 * q + 1) * 256 + cidx] = (bf16_t)(cvt_pk(s2[q].y, 0.f) & 0xffffu); }
            } else {
                const int t2 = tid - 256;
                {
                    const int part = t2 & 15, i0 = t2 >> 4;
#pragma unroll
                    for (int k = 0; k < 4; ++k) { const int i = i0 + 16 * k; const float sc = 0.08838834764831845f * __expf(Gs[i]); const u32x4 w = *(const LAS u32x4*)(Qs + i * TP + part * 8); u32x4 o;
#pragma unroll
                        for (int e = 0; e < 4; ++e) o[e] = cvt_pk(bflo(w[e]) * sc, bfhi(w[e]) * sc);
                        *(u32x4*)(p.DQD + (size_t)u * 8192 + i * 128 + part * 8) = o; }
                }
                {
                    const int dk = t2 & 127, half = t2 >> 7; const float Gl = Gs[63]; bf16_t* d = p.DKDt + (size_t)u * 8192 + dk * 64 + half * 32;
#pragma unroll
                    for (int q = 0; q < 4; ++q) { float v[8];
#pragma unroll
                        for (int e = 0; e < 8; ++e) { const int rr = half * 32 + q * 8 + e; v[e] = bf2f(Ks[rr * TP + dk]) * __expf(Gl - Gs[rr]); }
                        u32x4 w; w.x = cvt_pk(v[0], v[1]); w.y = cvt_pk(v[2], v[3]); w.z = cvt_pk(v[4], v[5]); w.w = cvt_pk(v[6], v[7]); *(u32x4*)(d + q * 8) = w; }
                }
                if (t2 == 0) p.DGL[u] = Gs[63];
            }
            __syncthreads();
            {
                const int dv = tid & 127, q = tid >> 7; unsigned w[8];
#pragma unroll
                for (int e = 0; e < 8; ++e) w[e] = (unsigned)SolS[(16 * q + 2 * e) * 256 + dv] | ((unsigned)SolS[(16 * q + 2 * e + 1) * 256 + dv] << 16);
                bf16_t* d = p.DUt + (size_t)u * 8192 + dv * 64 + 16 * q;
                *(u32x4*)d = (u32x4){w[0], w[1], w[2], w[3]}; *(u32x4*)(d + 8) = (u32x4){w[4], w[5], w[6], w[7]};
#pragma unroll
                for (int k = 0; k < 2; ++k) { const int c = tid + NTHREADS * k, row = c >> 4, part = c & 15;
                    *(u32x4*)(p.DW + (size_t)u * 8192 + row * 128 + part * 8) = *(const LAS u32x4*)(SolS + row * 256 + 128 + part * 8); }
            }
            __syncthreads();
        }
    }
    for (int v = ((int)blockIdx.x - NU3 % (int)gridDim.x + (int)gridDim.x) % (int)gridDim.x; v < NS * 8; v += gridDim.x) {
        const int tid = ltid();
        {
            const int s = v >> 3, h = v & 7; const size_t row = (size_t)NTOK + s;
            LAS float* qv = (LAS float*)smem; LAS float* kv = qv + 128; LAS float* red = kv + 128;
            LAS float* dl = red + 1024;
            if (tid < 128) { qv[tid] = bf2f(p.QKVN[row * DNQKV + h * 128 + tid]) * 0.08838834764831845f; kv[tid] = bf2f(p.QKVN[row * DNQKV + 1024 + h * 128 + tid]); }
            __syncthreads();
            const int dv = tid & 127, qd = tid >> 7;
            const float* S0 = p.in[4] + ((size_t)(s * 8 + h) * 128) * 128;
            float sreg[32]; float ks_ = 0.f, qs_ = 0.f;
#pragma unroll
            for (int k = 0; k < 32; ++k) { const int dk = qd * 32 + k; sreg[k] = S0[(size_t)dk * 128 + dv]; ks_ += kv[dk] * sreg[k]; qs_ += qv[dk] * sreg[k]; }
            red[(qd * 128 + dv) * 2] = ks_; red[(qd * 128 + dv) * 2 + 1] = qs_;
            __syncthreads();
            const float beta = p.BG[row * 16 + h], eg = __expf(p.BG[row * 16 + 8 + h]);
            if (tid < 128) {
                float kS = 0.f, qS = 0.f, qk = 0.f;
#pragma unroll
                for (int q = 0; q < 4; ++q) { kS += red[(q * 128 + dv) * 2]; qS += red[(q * 128 + dv) * 2 + 1]; }
                for (int k = 0; k < 128; ++k) qk += qv[k] * kv[k];
                const float vv = bf2f(p.QKVN[row * DNQKV + 2048 + h * 128 + dv]);
                const float delta = beta * (vv - eg * kS);
                p.ORAW[row * 1024 + h * 128 + dv] = eg * qS + qk * delta;
                dl[dv] = delta;
            }
            __syncthreads();
            const float delta = dl[dv];
            float* Sout = p.out + O_SDS + ((size_t)(s * 8 + h) * 128) * 128;
#pragma unroll
            for (int k = 0; k < 32; ++k) { const int dk = qd * 32 + k; Sout[(size_t)dk * 128 + dv] = sreg[k] * eg + kv[dk] * delta; }
            __syncthreads();
        }
    }
}

__device__ __forceinline__ void ph_dn_seq(const P& p, LAS char* smem) {
    constexpr int SP = 136, DP = 72;
    LAS bf16_t* St = (LAS bf16_t*)smem;
    LAS bf16_t* Dt = St + 32 * SP;
    const int tid = ltid(), lane = tid & 63, wid = tid >> 6, li = lane & 15, lg = lane >> 4;
    const int rt = wid >> 1, dt = wid & 1;
    for (int u0 = blockIdx.x; u0 < NB * 8 * 4; u0 += gridDim.x) {
        const int u = (gridDim.x == 256) ? (((u0 & 7) * 8 + (u0 >> 5)) * 4 + ((u0 >> 3) & 3)) : u0;
        const int b = u >> 5, h = (u >> 2) & 7, ds = u & 3;
        f32x4 sacc[2] = {{0.f, 0.f, 0.f, 0.f}, {0.f, 0.f, 0.f, 0.f}};
#pragma unroll
        for (int kk = 0; kk < 2; ++kk) { const int kt = 2 * rt + kk; *(LAS u32x2*)(St + (16 * dt + li) * SP + 16 * kt + 4 * lg) = (u32x2){0u, 0u}; }
        __syncthreads();
        bf16x8 wf[4], qf[4], af[2], kf[2][2], nwf[4], nqf[4], naf[2], nkf[2][2]; u32x2 uu, nuu; float eg, neg;
        auto fetch = [&](int c) {
            const size_t u3 = (size_t)(b * NCHUNK + c) * 8 + h;
            const bf16_t* Wp = p.DW + u3 * 8192 + (16 * rt + li) * 128 + 8 * lg;
            const bf16_t* Qp = p.DQD + u3 * 8192 + (16 * rt + li) * 128 + 8 * lg;
            const bf16_t* Ap = p.DATT + u3 * 4096 + (16 * rt + li) * 64 + 8 * lg;
            const bf16_t* Kp = p.DKDt + u3 * 8192 + (16 * (2 * rt) + li) * 64 + 8 * lg;
#pragma unroll
            for (int ks = 0; ks < 4; ++ks) { nwf[ks] = *(const bf16x8*)(Wp + 32 * ks); nqf[ks] = *(const bf16x8*)(Qp + 32 * ks); }
#pragma unroll
            for (int s2 = 0; s2 < 2; ++s2) { naf[s2] = *(const bf16x8*)(Ap + 32 * s2); nkf[0][s2] = *(const bf16x8*)(Kp + 32 * s2); nkf[1][s2] = *(const bf16x8*)(Kp + 16 * 64 + 32 * s2); }
            nuu = *(const u32x2*)(p.DUt + u3 * 8192 + (32 * ds + 16 * dt + li) * 64 + 16 * rt + 4 * lg);
            neg = __expf(p.DGL[u3]);
        };
        fetch(0);
#pragma unroll 1
        for (int c = 0; c < NCHUNK; ++c) {
#pragma unroll
            for (int ks = 0; ks < 4; ++ks) { wf[ks] = nwf[ks]; qf[ks] = nqf[ks]; }
#pragma unroll
            for (int s2 = 0; s2 < 2; ++s2) { af[s2] = naf[s2]; kf[0][s2] = nkf[0][s2]; kf[1][s2] = nkf[1][s2]; }
            uu = nuu; eg = neg;
            if (c + 1 < NCHUNK) fetch(c + 1);
            f32x4 dacc = {0.f, 0.f, 0.f, 0.f}, oacc = {0.f, 0.f, 0.f, 0.f};
#pragma unroll
            for (int ks = 0; ks < 4; ++ks) { const bf16x8 sf = *(const LAS bf16x8*)(St + (16 * dt + li) * SP + 32 * ks + 8 * lg); dacc = mfma16(wf[ks], sf, dacc); oacc = mfma16(qf[ks], sf, oacc); }
            const float d0 = bflo(uu.x) - dacc[0], d1 = bfhi(uu.x) - dacc[1], d2 = bflo(uu.y) - dacc[2], d3 = bfhi(uu.y) - dacc[3];
            *(LAS u32x2*)(Dt + (16 * dt + li) * DP + 16 * rt + 4 * lg) = (u32x2){cvt_pk(d0, d1), cvt_pk(d2, d3)};
            __syncthreads();
            bf16x8 df[2];
#pragma unroll
            for (int s2 = 0; s2 < 2; ++s2) df[s2] = *(const LAS bf16x8*)(Dt + (16 * dt + li) * DP + 32 * s2 + 8 * lg);
#pragma unroll
            for (int s2 = 0; s2 < 2; ++s2) oacc = mfma16(af[s2], df[s2], oacc);
#pragma unroll
            for (int kk = 0; kk < 2; ++kk) { sacc[kk] *= eg;
#pragma unroll
                for (int s2 = 0; s2 < 2; ++s2) sacc[kk] = mfma16(kf[kk][s2], df[s2], sacc[kk]); }
            {
                const int nvalid = (c == 0) ? 16 : 64, tbase = (c == 0) ? 0 : 16 + 64 * (c - 1);
#pragma unroll
                for (int r = 0; r < 4; ++r) { const int i = 16 * rt + 4 * lg + r; if (i < nvalid) p.ORAW[((size_t)b * LP + tbase + i) * 1024 + h * 128 + 32 * ds + 16 * dt + li] = oacc[r]; }
            }
#pragma unroll
            for (int kk = 0; kk < 2; ++kk) { const int kt = 2 * rt + kk; *(LAS u32x2*)(St + (16 * dt + li) * SP + 16 * kt + 4 * lg) = (u32x2){cvt_pk(sacc[kk][0], sacc[kk][1]), cvt_pk(sacc[kk][2], sacc[kk][3])}; }
            __syncthreads();
        }
        float* So = p.out + O_PDS + ((size_t)(b * 8 + h) * 128) * 128;
#pragma unroll
        for (int kk = 0; kk < 2; ++kk)
#pragma unroll
            for (int r = 0; r < 4; ++r) So[(size_t)(16 * (2 * rt + kk) + 4 * lg + r) * 128 + 32 * ds + 16 * dt + li] = sacc[kk][r];
    }
}

__device__ __forceinline__ void ph_dn_onorm(const P& p) {
    const int tid = ltid(), lane = tid & 63, wid = tid >> 6; const float* ng = p.in[26];
    for (int row = blockIdx.x * 8 + wid; row < NTOK + NS; row += gridDim.x * 8) {
#pragma unroll
        for (int it = 0; it < 2; ++it) {
            const int c0 = it * 512 + lane * 8, dv0 = c0 & 127;
            const float4 a = *(const float4*)(p.ORAW + (size_t)row * 1024 + c0), bq = *(const float4*)(p.ORAW + (size_t)row * 1024 + c0 + 4);
            float o[8] = {a.x, a.y, a.z, a.w, bq.x, bq.y, bq.z, bq.w}; float ss = 0.f;
#pragma unroll
            for (int e = 0; e < 8; ++e) ss += o[e] * o[e];
            ss += __shfl_xor(ss, 1); ss += __shfl_xor(ss, 2); ss += __shfl_xor(ss, 4); ss += __shfl_xor(ss, 8);
            const float r = rsqrtf(ss * (1.0f / 128.0f) + RMS_EPS);
            const u32x4 zw = *(const u32x4*)(p.PROJ + (size_t)row * DNPROJP + DNQKV + c0);
            float y[8];
#pragma unroll
            for (int e = 0; e < 4; ++e) { y[2 * e] = o[2 * e] * r * ng[dv0 + 2 * e] * siluf_(bflo(zw[e])); y[2 * e + 1] = o[2 * e + 1] * r * ng[dv0 + 2 * e + 1] * siluf_(bfhi(zw[e])); }
            u32x4 w; w.x = cvt_pk(y[0], y[1]); w.y = cvt_pk(y[2], y[3]); w.z = cvt_pk(y[4], y[5]); w.w = cvt_pk(y[6], y[7]);
            *(u32x4*)(p.ON + (size_t)row * 1024 + c0) = w;
        }
    }
}

__device__ __forceinline__ float rope_freq(int i) { return powf(10000.0f, -(float)i * (1.0f / 32.0f)); }
__device__ __forceinline__ void ph_mla_rows(const P& p) {
    const int tid = ltid(), lane = tid & 63, wid = tid >> 6; const float* qn = p.in[29]; const float* kn = p.in[32];
    for (int row = blockIdx.x * 8 + wid; row < MP; row += gridDim.x * 8) {
        if (row >= NTOK + NS) {
            const u32x4 z = {0u, 0u, 0u, 0u};
            *(u32x4*)(p.CQ + (size_t)row * 512 + lane * 8) = z; if (lane < 32) *(u32x4*)(p.CKVb + (size_t)row * 256 + lane * 8) = z; if (lane < 8) *(u32x4*)(p.KPEb + (size_t)row * 64 + lane * 8) = z;
            continue;
        }
        const float* src = p.DQKV + (size_t)row * 1024;
        {
            const float4 a = *(const float4*)(src + 4 * lane), bq = *(const float4*)(src + 256 + 4 * lane);
            float ss = a.x * a.x + a.y * a.y + a.z * a.z + a.w * a.w + bq.x * bq.x + bq.y * bq.y + bq.z * bq.z + bq.w * bq.w;
            ss = wave_sum(ss); const float r = rsqrtf(ss * (1.0f / 512.0f) + RMS_EPS);
            const float4 g0 = *(const float4*)(qn + 4 * lane), g1 = *(const float4*)(qn + 256 + 4 * lane);
            *(u32x2*)(p.CQ + (size_t)row * 512 + 4 * lane) = (u32x2){cvt_pk(a.x * r * g0.x, a.y * r * g0.y), cvt_pk(a.z * r * g0.z, a.w * r * g0.w)};
            *(u32x2*)(p.CQ + (size_t)row * 512 + 256 + 4 * lane) = (u32x2){cvt_pk(bq.x * r * g1.x, bq.y * r * g1.y), cvt_pk(bq.z * r * g1.z, bq.w * r * g1.w)};
        }
        const bool prompt = row < NTOK; const int b = prompt ? row / LP : 0, t = prompt ? row - b * LP : 0;
        {
            const float4 a = *(const float4*)(src + 512 + 4 * lane);
            float ss = a.x * a.x + a.y * a.y + a.z * a.z + a.w * a.w; ss = wave_sum(ss); const float r = rsqrtf(ss * (1.0f / 256.0f) + RMS_EPS);
            const float4 g0 = *(const float4*)(kn + 4 * lane); const float4 o = make_float4(a.x * r * g0.x, a.y * r * g0.y, a.z * r * g0.z, a.w * r * g0.w);
            float* dst = prompt ? p.out + O_PCKV + (size_t)row * 256 : p.out + O_SCKV + (size_t)(row - NTOK) * 256;
            *(float4*)(dst + 4 * lane) = o;
            *(u32x2*)(p.CKVb + (size_t)row * 256 + 4 * lane) = (u32x2){cvt_pk(o.x, o.y), cvt_pk(o.z, o.w)};
        }
        if (lane < 32) {
            const float x1 = src[768 + lane], x2 = src[800 + lane]; const float pos = prompt ? (float)t : 16384.0f;
            float sn, cs; sincosf(pos * rope_freq(lane), &sn, &cs);
            const float o1 = x1 * cs - x2 * sn, o2 = x1 * sn + x2 * cs;
            float* dst = prompt ? p.out + O_PKPE + (size_t)row * 64 : p.out + O_SKPE + (size_t)(row - NTOK) * 64;
            dst[lane] = o1; dst[32 + lane] = o2;
            p.KPEb[(size_t)row * 64 + lane] = (bf16_t)(cvt_pk(o1, 0.f) & 0xffffu); p.KPEb[(size_t)row * 64 + 32 + lane] = (bf16_t)(cvt_pk(o2, 0.f) & 0xffffu);
        }
    }
}

__device__ __forceinline__ void ph_mla_qlat(const P& p, LAS char* smem) {
    LAS float* Qn = (LAS float*)smem;
    const int tid = ltid(); const float* wuk = p.in[33];
    for (int u = blockIdx.x; u < 32; u += gridDim.x) {
        const int h = u >> 2, cq = u & 3;
        for (int i = tid; i < 32 * 128; i += NTHREADS) { const int s = i >> 7, n = i & 127; Qn[i] = bf2f(p.Q[((size_t)NTOK + s) * 1536 + h * 192 + n]); }
        __syncthreads();
        const int c = cq * 64 + (tid & 63), bg = tid >> 6; float acc[4] = {0.f, 0.f, 0.f, 0.f};
        const float* wr = wuk + (size_t)c * 1024 + h * 128;
#pragma unroll 8
        for (int n4 = 0; n4 < 32; ++n4) { const float4 w = *(const float4*)(wr + 4 * n4);
#pragma unroll
            for (int r = 0; r < 4; ++r) { const LAS float* qr = Qn + (bg * 4 + r) * 128 + 4 * n4; acc[r] += w.x * qr[0] + w.y * qr[1] + w.z * qr[2] + w.w * qr[3]; } }
#pragma unroll
        for (int r = 0; r < 4; ++r) p.QLAT[(size_t)(bg * 4 + r) * 2048 + h * 256 + c] = acc[r];
        if (cq == 0) {
            for (int i = tid; i < 32 * 32; i += NTHREADS) { const int s = i >> 5, d = i & 31; const bf16_t* q = p.Q + ((size_t)NTOK + s) * 1536 + h * 192 + 128;
                const float x1 = bf2f(q[d]), x2 = bf2f(q[32 + d]); float sn, cs; sincosf(16384.0f * rope_freq(d), &sn, &cs);
                p.QPE[(size_t)s * 512 + h * 64 + d] = x1 * cs - x2 * sn; p.QPE[(size_t)s * 512 + h * 64 + 32 + d] = x1 * sn + x2 * cs; }
        }
        __syncthreads();
    }
}

template <int N>
__device__ __forceinline__ void tr_step(float (&v)[32], int lane, int mask) {
    const bool up = (lane & mask) != 0;
#pragma unroll
    for (int i = 0; i < N; ++i) { const float send = up ? v[i] : v[i + N]; const float keep = up ? v[i + N] : v[i]; v[i] = keep + __shfl_xor(send, mask); }
}
__device__ __forceinline__ float readlane_f(float v, int l) { return __int_as_float(__builtin_amdgcn_readlane(__float_as_int(v), l)); }
__device__ __forceinline__ void ph_mla_decode(const P& p, LAS char* smem) {
    LAS float* Om = (LAS float*)smem;
    LAS float* MLs = Om + 8 * 8 * 256;
    const int tid = ltid(), lane = tid & 63, wid = tid >> 6;
    const int* pt = (const int*)p.in[8]; const float* pool_c = p.in[6]; const float* pool_k = p.in[7];
    const float sc = MLA_SCALE * LOG2E;
    for (int u = blockIdx.x; u < NS * 8; u += gridDim.x) {
        const int bq = u >> 3, sp = u & 7;
        f32x2 qlp[4][4], qpp[4];
#pragma unroll
        for (int hp = 0; hp < 4; ++hp) { const float4 a = *(const float4*)(p.QLAT + (size_t)bq * 2048 + (2 * hp) * 256 + 4 * lane), b4 = *(const float4*)(p.QLAT + (size_t)bq * 2048 + (2 * hp + 1) * 256 + 4 * lane);
            qlp[hp][0] = (f32x2){a.x, b4.x}; qlp[hp][1] = (f32x2){a.y, b4.y}; qlp[hp][2] = (f32x2){a.z, b4.z}; qlp[hp][3] = (f32x2){a.w, b4.w};
            qpp[hp] = (f32x2){p.QPE[(size_t)bq * 512 + (2 * hp) * 64 + lane], p.QPE[(size_t)bq * 512 + (2 * hp + 1) * 64 + lane]}; }
        f32x2 O2[8][2];
#pragma unroll
        for (int h = 0; h < 8; ++h) { O2[h][0] = (f32x2){0.f, 0.f}; O2[h][1] = (f32x2){0.f, 0.f}; }
        float m_run = -INFINITY, l_run = 0.f;
        const int pg0 = pt[bq * 128 + sp * 16 + 2 * wid], pg1 = pt[bq * 128 + sp * 16 + 2 * wid + 1];
        float4 cn[4]; float en[4];
        {   const float* cb = pool_c + (size_t)pg0 * 128 * 256; const float* kb = pool_k + (size_t)pg0 * 128 * 64;
#pragma unroll
            for (int k = 0; k < 4; ++k) { cn[k] = *(const float4*)(cb + k * 256 + 4 * lane); en[k] = kb[k * 64 + lane]; } }
        for (int it = 0; it < 64; ++it) {
            float4 c[4]; float e[4];
#pragma unroll
            for (int k = 0; k < 4; ++k) { c[k] = cn[k]; e[k] = en[k]; }
            if (it + 1 < 64) { const int nit = it + 1, pg = (nit < 32) ? pg0 : pg1, kb4 = (nit & 31) * 4;
                const float* cb = pool_c + ((size_t)pg * 128 + kb4) * 256; const float* kb = pool_k + ((size_t)pg * 128 + kb4) * 64;
#pragma unroll
                for (int k = 0; k < 4; ++k) { cn[k] = *(const float4*)(cb + k * 256 + 4 * lane); en[k] = kb[k * 64 + lane]; } }
            float part[32];
#pragma unroll
            for (int k = 0; k < 4; ++k)
#pragma unroll
                for (int hp = 0; hp < 4; ++hp) { const f32x2 t2 = qlp[hp][0] * c[k].x + qlp[hp][1] * c[k].y + qlp[hp][2] * c[k].z + qlp[hp][3] * c[k].w + qpp[hp] * e[k];
                    part[k * 8 + 2 * hp] = t2.x; part[k * 8 + 2 * hp + 1] = t2.y; }
#pragma unroll
            for (int i = 0; i < 16; ++i) { swap32(part[i], part[i + 16]); part[i] += part[i + 16]; }
#pragma unroll
            for (int i = 0; i < 8; ++i) { swap16(part[i], part[i + 8]); part[i] += part[i + 8]; }
            tr_step<4>(part, lane, 8); tr_step<2>(part, lane, 4); tr_step<1>(part, lane, 2);
            float s = (part[0] + __shfl_xor(part[0], 1)) * sc;
            float m4 = max_x32(max_x16(s));
            const float m_new = fmaxf(m_run, m4), alpha = __builtin_amdgcn_exp2f(m_run - m_new), pr = __builtin_amdgcn_exp2f(s - m_new);
            const float ps = sum_x32(sum_x16(pr));
            l_run = l_run * alpha + ps; m_run = m_new;
#pragma unroll
            for (int h = 0; h < 8; ++h) {
                const float al = readlane_f(alpha, 2 * h);
                f32x2 o0 = O2[h][0] * al, o1 = O2[h][1] * al;
#pragma unroll
                for (int k = 0; k < 4; ++k) { const float pk = readlane_f(pr, 16 * k + 2 * h); o0 += (f32x2){c[k].x, c[k].y} * pk; o1 += (f32x2){c[k].z, c[k].w} * pk; }
                O2[h][0] = o0; O2[h][1] = o1;
            }
        }
#pragma unroll
        for (int h = 0; h < 8; ++h) *(LAS f32x4*)(Om + (wid * 8 + h) * 256 + 4 * lane) = (f32x4){O2[h][0].x, O2[h][0].y, O2[h][1].x, O2[h][1].y};
        if (lane < 16 && (lane & 1) == 0) { MLs[(wid * 8 + (lane >> 1)) * 2] = m_run; MLs[(wid * 8 + (lane >> 1)) * 2 + 1] = l_run; }
        __syncthreads();
#pragma unroll
        for (int i = 0; i < 4; ++i) { const int idx = tid + NTHREADS * i, h = idx >> 8, c = idx & 255;
            float M = -INFINITY;
#pragma unroll
            for (int w = 0; w < 8; ++w) M = fmaxf(M, MLs[(w * 8 + h) * 2]);
            float val = 0.f, L = 0.f;
#pragma unroll
            for (int w = 0; w < 8; ++w) { const float f = __builtin_amdgcn_exp2f(MLs[(w * 8 + h) * 2] - M); val += f * Om[(w * 8 + h) * 256 + c]; L += f * MLs[(w * 8 + h) * 2 + 1]; }
            p.PART[((size_t)(bq * 8 + sp) * 8 + h) * 256 + c] = val;
            if (c == 0) { p.ML[((size_t)(bq * 8 + sp) * 8 + h) * 2] = M; p.ML[((size_t)(bq * 8 + sp) * 8 + h) * 2 + 1] = L; }
        }
        __syncthreads();
    }
}

__device__ __forceinline__ void ph_mla_combine(const P& p, LAS char* smem) {
    LAS float* OL = (LAS float*)smem;
    const int tid = ltid(), lane = tid & 63, wid = tid >> 6; const float sc = MLA_SCALE * LOG2E;
    for (int bq = blockIdx.x; bq < NS; bq += gridDim.x) {
        const int h = wid;
        const float4 cnew = *(const float4*)(p.out + O_SCKV + (size_t)bq * 256 + 4 * lane); const float knew = p.out[O_SKPE + (size_t)bq * 64 + lane];
        const float4 ql = *(const float4*)(p.QLAT + (size_t)bq * 2048 + h * 256 + 4 * lane); const float qp = p.QPE[(size_t)bq * 512 + h * 64 + lane];
        float ss = cnew.x * ql.x + cnew.y * ql.y + cnew.z * ql.z + cnew.w * ql.w + knew * qp; ss = wave_sum(ss) * sc;
        float M = ss;
#pragma unroll
        for (int s = 0; s < 8; ++s) M = fmaxf(M, p.ML[((size_t)(bq * 8 + s) * 8 + h) * 2]);
        const float fs = __builtin_amdgcn_exp2f(ss - M); float L = fs; float4 o = make_float4(fs * cnew.x, fs * cnew.y, fs * cnew.z, fs * cnew.w);
#pragma unroll
        for (int s = 0; s < 8; ++s) { const float f = __builtin_amdgcn_exp2f(p.ML[((size_t)(bq * 8 + s) * 8 + h) * 2] - M); L += f * p.ML[((size_t)(bq * 8 + s) * 8 + h) * 2 + 1];
            const float4 pv = *(const float4*)(p.PART + ((size_t)(bq * 8 + s) * 8 + h) * 256 + 4 * lane); o.x += f * pv.x; o.y += f * pv.y; o.z += f * pv.z; o.w += f * pv.w; }
        const float inv = 1.0f / L;
        *(LAS f32x4*)(OL + h * 256 + 4 * lane) = (f32x4){o.x * inv, o.y * inv, o.z * inv, o.w * inv};
        __syncthreads();
        const float* wuv = p.in[34];
#pragma unroll
        for (int i = 0; i < 2; ++i) { const int idx = tid + NTHREADS * i, hh = idx >> 7, v = idx & 127; float acc = 0.f;
#pragma unroll 16
            for (int c = 0; c < 256; ++c) acc += OL[hh * 256 + c] * wuv[(size_t)c * 1024 + hh * 128 + v];
            p.AO[((size_t)NTOK + bq) * 1024 + hh * 128 + v] = (bf16_t)(cvt_pk(acc, 0.f) & 0xffffu); }
        __syncthreads();
    }
}

__device__ __forceinline__ void ph_mla_attn(const P& p, LAS char* smem) {
    constexpr int KP = 200, VP = 144;
    constexpr int KT_BYTES = 64 * KP * 2, VT_BYTES = 64 * VP * 2, STG = KT_BYTES + VT_BYTES;
    const int tid = ltid(), lane = tid & 63, wid = tid >> 6, li = lane & 15, lg = lane >> 4;
    const int G = gridDim.x; const float sc = MLA_SCALE * LOG2E;
    constexpr int NQB = 9, NUNITS = NB * 8 * NQB;
    for (int j = 0;; ++j) {
        const int idx = j * G + ((j & 1) ? (G - 1 - (int)blockIdx.x) : (int)blockIdx.x);
        if (j * G >= NUNITS) break;
        if (idx >= NUNITS) continue;
        const int qb = (NQB - 1) - idx / 64, bh = idx & 63, b = bh >> 3, h = bh & 7;
        const int t0 = qb * 256, nq = (LP - t0) < 256 ? (LP - t0) : 256, kend = t0 + nq, nkt = (kend + 63) >> 6;
        const int tq0 = t0 + 32 * wid + li;
        bf16x8 qf[2][6];
#pragma unroll
        for (int rt = 0; rt < 2; ++rt) { const int tq = tq0 + 16 * rt, tqc = tq < LP ? tq : LP - 1;
            const bf16_t* qsrc = p.Q + ((size_t)b * LP + tqc) * 1536 + h * 192 + 8 * lg;
#pragma unroll
            for (int ks = 0; ks < 6; ++ks) qf[rt][ks] = *(const bf16x8*)(qsrc + 32 * ks);
#pragma unroll
            for (int e = 0; e < 8; ++e) { const float x1 = bf2f((unsigned short)qf[rt][4][e]), x2 = bf2f((unsigned short)qf[rt][5][e]);
                const float ang_ = (float)tqc * __builtin_amdgcn_exp2f(-0.41524101186092033f * (float)(8 * lg + e)); const float sn = __sinf(ang_), cs = __cosf(ang_);
                qf[rt][4][e] = (short)(cvt_pk(x1 * cs - x2 * sn, 0.f) & 0xffffu); qf[rt][5][e] = (short)(cvt_pk(x1 * sn + x2 * cs, 0.f) & 0xffffu); } }
        f32x4 oacc[2][8];
#pragma unroll
        for (int rt = 0; rt < 2; ++rt)
#pragma unroll
            for (int ct = 0; ct < 8; ++ct) oacc[rt][ct] = (f32x4){0.f, 0.f, 0.f, 0.f};
        float m_run[2] = {-INFINITY, -INFINITY}, l_run[2] = {0.f, 0.f};
        u32x4 rgA[5];
        auto gload = [&](int kt, u32x4 (&rg)[5]) {
            int tl = tid; asm volatile("" : "+v"(tl));
#pragma unroll
            for (int i = 0; i < 5; ++i) { const int c = tl + NTHREADS * i; int key, part; const bf16_t* src;
                if (c < 1024) { key = c >> 4; part = c & 15; } else if (c < 1536) { key = (c - 1024) >> 3; part = (c - 1024) & 7; } else { key = (c - 1536) >> 4; part = (c - 1536) & 15; }
                int kr = kt * 64 + key; kr = kr < LP ? kr : LP - 1; const size_t grow = (size_t)b * LP + kr;
                if (c < 1024) src = p.KV + grow * 2048 + h * 128 + part * 8; else if (c < 1536) src = p.KPEb + grow * 64 + part * 8; else src = p.KV + grow * 2048 + 1024 + h * 128 + part * 8;
                rg[i] = *(const u32x4*)src; } };
        auto sstore = [&](int st, const u32x4 (&rg)[5]) {
            LAS bf16_t* Kt = (LAS bf16_t*)(smem + st * STG); LAS bf16_t* Vt = (LAS bf16_t*)(smem + st * STG + KT_BYTES);
            int tl = tid; asm volatile("" : "+v"(tl));
#pragma unroll
            for (int i = 0; i < 5; ++i) { const int c = tl + NTHREADS * i;
                if (c < 1024) *(LAS u32x4*)(Kt + (c >> 4) * KP + (c & 15) * 8) = rg[i];
                else if (c < 1536) *(LAS u32x4*)(Kt + ((c - 1024) >> 3) * KP + 128 + ((c - 1024) & 7) * 8) = rg[i];
                else *(LAS u32x4*)(Vt + ((c - 1536) >> 4) * VP + ((c - 1536) & 15) * 8) = rg[i]; } };
        auto compute = [&](int kt, int st) {
            if (kt * 64 > t0 + 32 * wid + 31) return;
            const LAS bf16_t* Kt = (const LAS bf16_t*)(smem + st * STG); const LAS bf16_t* Vt = (const LAS bf16_t*)(smem + st * STG + KT_BYTES);
            f32x4 sacc[2][4];
#pragma unroll
            for (int rt = 0; rt < 2; ++rt)
#pragma unroll
                for (int k4 = 0; k4 < 4; ++k4) sacc[rt][k4] = (f32x4){0.f, 0.f, 0.f, 0.f};
#pragma unroll
            for (int ks = 0; ks < 6; ++ks)
#pragma unroll
                for (int k4 = 0; k4 < 4; ++k4) { const bf16x8 kf = *(const LAS bf16x8*)(Kt + (16 * k4 + li) * KP + 32 * ks + 8 * lg);
                    sacc[0][k4] = mfma16(kf, qf[0][ks], sacc[0][k4]); sacc[1][k4] = mfma16(kf, qf[1][ks], sacc[1][k4]);
                    if (k4 == 3 && (ks & 1)) asm volatile("" ::: "memory"); }
            bf16x8 pf[2][2];
#pragma unroll
            for (int rt = 0; rt < 2; ++rt) {
                const int tq = tq0 + 16 * rt;
                const bool diag = kt * 64 + 63 > t0 + 32 * wid + 16 * rt;
                float mx = -INFINITY;
#pragma unroll
                for (int k4 = 0; k4 < 4; ++k4)
#pragma unroll
                    for (int r = 0; r < 4; ++r) { const int key = kt * 64 + 16 * k4 + 4 * lg + r; const float sv = (!diag || key <= tq) ? sacc[rt][k4][r] * sc : -INFINITY; sacc[rt][k4][r] = sv; mx = fmaxf(mx, sv); }
                mx = max_x32(max_x16(mx));
                const float m_new = fmaxf(m_run[rt], mx), alpha = __builtin_amdgcn_exp2f(m_run[rt] - m_new); float rs = 0.f;
#pragma unroll
                for (int k4 = 0; k4 < 4; ++k4)
#pragma unroll
                    for (int r = 0; r < 4; ++r) { const float pv = __builtin_amdgcn_exp2f(sacc[rt][k4][r] - m_new); sacc[rt][k4][r] = pv; rs += pv; }
                rs = sum_x32(sum_x16(rs));
                l_run[rt] = l_run[rt] * alpha + rs; m_run[rt] = m_new;
                if (__any(alpha != 1.0f)) {
#pragma unroll
                    for (int ct = 0; ct < 8; ++ct) oacc[rt][ct] *= alpha; }
#pragma unroll
                for (int s2 = 0; s2 < 2; ++s2) { const u32x4 w = {cvt_pk(sacc[rt][2 * s2][0], sacc[rt][2 * s2][1]), cvt_pk(sacc[rt][2 * s2][2], sacc[rt][2 * s2][3]), cvt_pk(sacc[rt][2 * s2 + 1][0], sacc[rt][2 * s2 + 1][1]), cvt_pk(sacc[rt][2 * s2 + 1][2], sacc[rt][2 * s2 + 1][3])};
                    pf[rt][s2] = __builtin_bit_cast(bf16x8, w); }
            }
#pragma unroll
            for (int ct = 0; ct < 8; ++ct)
#pragma unroll
                for (int s2 = 0; s2 < 2; ++s2) {
                    const s16x4 lo = __builtin_amdgcn_ds_read_tr16_b64_v4i16((LAS s16x4*)(Vt + (32 * s2 + 4 * lg + (li >> 2)) * VP + 16 * ct + 4 * (li & 3)));
                    const s16x4 hi = __builtin_amdgcn_ds_read_tr16_b64_v4i16((LAS s16x4*)(Vt + (32 * s2 + 16 + 4 * lg + (li >> 2)) * VP + 16 * ct + 4 * (li & 3)));
                    const bf16x8 vf = {lo[0], lo[1], lo[2], lo[3], hi[0], hi[1], hi[2], hi[3]};
                    oacc[0][ct] = mfma16(vf, pf[0][s2], oacc[0][ct]); oacc[1][ct] = mfma16(vf, pf[1][s2], oacc[1][ct]);
                    if (s2 == 1 && (ct & 1)) asm volatile("" ::: "memory");
                }
        };
        gload(0, rgA); sstore(0, rgA);
        __syncthreads();
#pragma unroll 1
        for (int kt = 0; kt < nkt; ++kt) {
            const int st = kt & 1;
            if (kt + 1 < nkt) gload(kt + 1, rgA);
            compute(kt, st);
            if (kt + 1 < nkt) sstore(st ^ 1, rgA);
            __syncthreads();
        }
#pragma unroll
        for (int rt = 0; rt < 2; ++rt) { const int tq = tq0 + 16 * rt;
            if (tq < LP) { const float inv = 1.0f / l_run[rt]; bf16_t* dst = p.AO + ((size_t)b * LP + tq) * 1024 + h * 128 + 4 * lg;
#pragma unroll
                for (int ct = 0; ct < 8; ++ct) *(u32x2*)(dst + 16 * ct) = (u32x2){cvt_pk(oacc[rt][ct][0] * inv, oacc[rt][ct][1] * inv), cvt_pk(oacc[rt][ct][2] * inv, oacc[rt][ct][3] * inv)}; } }
    }
}

constexpr int NPHASES = 43;
template <int PH>
__device__ __forceinline__ void run_phase(const LAS PG* pl, LAS char* smem) {
    const P p = glob(pl);
    if constexpr (PH == 0) { ph_init(p, smem); return; }
    if constexpr (PH == 42) {
        ph_final_norm(p);
        return; }
    constexpr int layer = PH <= 10 ? 0 : PH <= 20 ? 1 : PH <= 31 ? 2 : 3;
    constexpr int base = layer == 0 ? 1 : layer == 1 ? 11 : layer == 2 ? 21 : 32;
    constexpr int sub = PH - base;
    constexpr int nmix = layer == 2 ? 8 : 7;
    if constexpr (sub == 0 || sub == nmix) return;
    if constexpr (sub == nmix + 1) { norm_gemm(p, p.Wgu + (size_t)layer * 5632 * 1024, 5632, 2 * layer + 1, EpiGU{uni(p.HF)}, smem); return; }
    if constexpr (sub == nmix + 2) { resid_gemm(p, p.HF, p.Wdown + (size_t)layer * 1024 * DFF, DFF, layer < 3 ? 2 * layer + 2 : -1, smem); return; }
    if constexpr (layer == 0 || layer == 3) {
        constexpr int J = layer == 0 ? 0 : 1;
        if constexpr (sub == 1) { norm_gemm(p, p.Wlru_in + (size_t)J * 2048 * 1024, 2048, 2 * layer, EpiLruIn{uni(p.G1)}, smem); }
        if constexpr (sub == 2) ph_lru_conv<J>(p);
        if constexpr (sub == 3) {
            const bf16_t* A = uni((const bf16_t*)p.XC); const bf16_t* Bt = uni((const bf16_t*)(p.Wlru_gate + (size_t)J * 2048 * 256));
            const EpiGate e{uni(p.RI), uni((const float*)p.BCAT) + J * 2048};
            pg8::Gemm g{A, Bt, 4 * MP, 2048, 256}; GateOrder S{(int)gridDim.x, (int)blockIdx.x};
            PgEpiGate pe{e};
            pg8::gemm_phase<PgEpiGate, GateOrder, true, true>((LAS unsigned char*)smem, g, S, pe);
            __syncthreads();
            gemm_small<false>(A, 256, Bt, 256, 2048, MMAIN, 3, 1, e, smem, nullptr, 512); }
        if constexpr (sub == 4) ph_scan1<J>(p);
        if constexpr (sub == 5) ph_scan2<J>(p);
        if constexpr (sub == 6) { resid_gemm(p, p.HG, p.Wlru_out + (size_t)J * 1048576, 1024, 2 * layer + 1, smem); }
    }
    if constexpr (layer == 1) {
        if constexpr (sub == 1) { norm_gemm(p, p.Wdn_in, DNPROJP, 2 * layer, EpiDnIn{uni(p.PROJ), uni(p.BA)}, smem); }
        if constexpr (sub == 2) ph_dn_conv(p);
        if constexpr (sub == 3) ph_dn_chunk(p, smem);
        if constexpr (sub == 4) ph_dn_seq(p, smem);
        if constexpr (sub == 5) ph_dn_onorm(p);
        if constexpr (sub == 6) { resid_gemm(p, p.ON, p.Wdn_out, 1024, 2 * layer + 1, smem); }
    }
    if constexpr (layer == 2) {
        if constexpr (sub == 1) { norm_gemm(p, p.Wmla_d, 1024, 2 * layer, EpiF32{uni(p.DQKV), 1024}, smem); }
        if constexpr (sub == 2) ph_mla_rows(p);
        if constexpr (sub == 3) { big_gemm(p.CQ, p.Wmla_uq, 1536, 512, EpiBf16{uni(p.Q), 1536}, smem); __syncthreads();
                                  big_gemm(p.CKVb, p.Wmla_kvup, 2048, 256, EpiBf16{uni(p.KV), 2048}, smem); }
        if constexpr (sub == 4) ph_mla_qlat(p, smem);
        if constexpr (sub == 5) { ph_mla_decode(p, smem);
            ph_mla_attn(p, smem); }
        if constexpr (sub == 6) ph_mla_combine(p, smem);
        if constexpr (sub == 7) { resid_gemm(p, p.AO, p.Wmla_o, 1024, 2 * layer + 1, smem); }
    }
}

extern __shared__ __attribute__((aligned(16))) char smem_raw[];

constexpr bool phase_active(int ph) {
    if (ph == 0 || ph == 42) return true;
    const int layer = ph <= 10 ? 0 : ph <= 20 ? 1 : ph <= 31 ? 2 : 3, base = layer == 0 ? 1 : layer == 1 ? 11 : layer == 2 ? 21 : 32, sub = ph - base, nmix = layer == 2 ? 8 : 7;
    return !(sub == 0 || sub == nmix);
}
template <int PH>
__device__ __forceinline__ void run_all(const LAS PG* p, LAS char* smem, const XcdBarrier& bar) {
    if constexpr (phase_active(PH)) { run_phase<PH>(p, smem); if constexpr (PH + 1 < NPHASES) xcd_barrier(bar); }
    if constexpr (PH + 1 < NPHASES) run_all<PH + 1>(p, smem, bar);
}
__global__ void __launch_bounds__(NTHREADS, 2) k_mega(P p) {
    LAS char* smem = (LAS char*)smem_raw;
    LAS unsigned long long* lp = (LAS unsigned long long*)(smem + LDS_BYTES - 2048);
    { const unsigned long long* src = (const unsigned long long*)&p; for (int i = threadIdx.x; i < (int)(sizeof(P) / 8); i += NTHREADS) lp[i] = src[i]; }
    LAS unsigned* xbw = (LAS unsigned*)(smem + LDS_BYTES - 16);
    if (threadIdx.x == 0) { xbw[0] = 0u; xbw[1] = 0u; xbw[2] = 0u; xbw[3] = 0u; }
    __syncthreads();
    const LAS PG* q = (const LAS PG*)lp;
    XcdBarrier bar = xcd_barrier_post((unsigned*)q->bar, (volatile LAS unsigned*)xbw);
    run_all<0>(q, smem, bar);
}

extern "C" void kernel_launch(void* const* d_in, const int* in_sizes, int n_in, void* d_out, int out_size, void* d_ws, size_t ws_size, hipStream_t stream) {
    (void)in_sizes; (void)n_in; (void)out_size;
    P p{};
    for (int i = 0; i < 38; ++i) p.in[i] = (const float*)d_in[i];
    p.out = (float*)d_out;
    char* w = (char*)d_ws; size_t off = 0;
    auto take = [&](size_t bytes) { void* r = w + off; off += (bytes + 255) & ~(size_t)255; return r; };
    p.bar = (unsigned*)take(XCD_BAR_WORDS * 4);
    p.X = (float*)take((size_t)MP * D * 4); p.H = (bf16_t*)take((size_t)MP * D * 2); p.SS = (float*)take((size_t)8 * MP * 16 * 4);
    p.G1 = (bf16_t*)take((size_t)MP * 2048 * 2); p.XC = (bf16_t*)take((size_t)MP * 1024 * 2); p.RI = (bf16_t*)take((size_t)MP * 2048 * 2); p.HG = (bf16_t*)take((size_t)MP * 1024 * 2);
    p.CP = (float*)take((size_t)NB * SCH * 1024 * 4); p.CH = (float*)take((size_t)NB * SCH * 1024 * 4); p.BCAT = (float*)take((size_t)2 * 2048 * 4);
    p.PROJ = (bf16_t*)take((size_t)MP * DNPROJP * 2); p.BA = (float*)take((size_t)MP * 16 * 4); p.BG = (float*)take((size_t)MP * 16 * 4); p.QKVN = (bf16_t*)take((size_t)MP * DNQKV * 2);
    const size_t nu3 = (size_t)NB * NCHUNK * 8;
    p.DW = (bf16_t*)take(nu3 * 8192 * 2); p.DUt = (bf16_t*)take(nu3 * 8192 * 2); p.DQD = (bf16_t*)take(nu3 * 8192 * 2); p.DKDt = (bf16_t*)take(nu3 * 8192 * 2); p.DATT = (bf16_t*)take(nu3 * 4096 * 2);
    p.DGL = (float*)take(nu3 * 4); p.ORAW = (float*)take((size_t)MP * 1024 * 4); p.ON = (bf16_t*)take((size_t)MP * 1024 * 2);
    p.DQKV = (float*)take((size_t)MP * 1024 * 4); p.CQ = (bf16_t*)take((size_t)MP * 512 * 2); p.CKVb = (bf16_t*)take((size_t)MP * 256 * 2); p.KPEb = (bf16_t*)take((size_t)MP * 64 * 2);
    p.Q = (bf16_t*)take((size_t)MP * 1536 * 2); p.KV = (bf16_t*)take((size_t)MP * 2048 * 2); p.AO = (bf16_t*)take((size_t)MP * 1024 * 2);
    p.QLAT = (float*)take((size_t)NS * 2048 * 4); p.QPE = (float*)take((size_t)NS * 512 * 4); p.PART = (float*)take((size_t)NS * 8 * 8 * 256 * 4); p.ML = (float*)take((size_t)NS * 8 * 8 * 2 * 4);
    p.HF = (bf16_t*)take((size_t)MP * DFF * 2);
    p.Wlru_in = (bf16_t*)take((size_t)2 * 2048 * 1024 * 2); p.Wlru_gate = (bf16_t*)take((size_t)2 * 2048 * 256 * 2); p.Wlru_out = (bf16_t*)take((size_t)2 * 1048576 * 2);
    p.Wdn_in = (bf16_t*)take((size_t)DNPROJP * 1024 * 2); p.Wdn_out = (bf16_t*)take((size_t)1048576 * 2);
    p.Wmla_d = (bf16_t*)take((size_t)1024 * 1024 * 2); p.Wmla_uq = (bf16_t*)take((size_t)1536 * 512 * 2); p.Wmla_kvup = (bf16_t*)take((size_t)2048 * 256 * 2); p.Wmla_o = (bf16_t*)take((size_t)1048576 * 2);
    p.Wgu = (bf16_t*)take((size_t)4 * 5632 * 1024 * 2); p.Wdown = (bf16_t*)take((size_t)4 * 1024 * DFF * 2);
    if (off > ws_size) return;
    static int grid = 0;
    if (!grid) { int dev = 0, cus = 0; (void)hipGetDevice(&dev); (void)hipDeviceGetAttribute(&cus, hipDeviceAttributeMultiprocessorCount, dev); grid = (cus > 0 && cus < 256) ? cus : 256; }
    static bool attr_done = false;
    if (!attr_done) { (void)hipFuncSetAttribute((const void*)k_mega, hipFuncAttributeMaxDynamicSharedMemorySize, LDS_BYTES); attr_done = true; }
    (void)hipMemsetAsync(p.bar, 0, XCD_BAR_WORDS * 4, stream);
    hipLaunchKernelGGL(k_mega, dim3(grid), dim3(NTHREADS), LDS_BYTES, stream, p);
}
```

```cpp
#include <hip/hip_runtime.h>
#include <stdint.h>
#include <stdio.h>
#include <type_traits>


#define LAS __attribute__((address_space(3)))
typedef unsigned short bf16_t;
typedef short bf16x8 __attribute__((ext_vector_type(8)));
typedef short s16x4 __attribute__((ext_vector_type(4)));
typedef float f32x4 __attribute__((ext_vector_type(4)));
typedef unsigned u32x2 __attribute__((ext_vector_type(2)));
typedef unsigned u32x4 __attribute__((ext_vector_type(4)));

constexpr int D = 1024, NB = 8, NMETA = 16, LP = 2064, NTOK = NB * LP  , NS = 32, MP = 16640, NPANEL = 65;
constexpr int DFF = 2816, DNQKV = 3072, DNPROJ = 4112, DNPROJP = 4352;
constexpr int NCHUNK = 33;
constexpr int SCH = 48, SCL = 43;
constexpr int NTHREADS = 512;
constexpr int MMAIN = 16384;
constexpr int LDS_BYTES = 135168;
constexpr float RMS_EPS = 1e-6f;
constexpr float LOG2E = 1.4426950408889634f;
constexpr float MLA_SCALE = 0.07216878364870322f;

constexpr size_t O_YP = 0, O_YS = 16777216, O_PLH = O_YS + 32768, O_PLC = O_PLH + 16384, O_PDS = O_PLC + 49152, O_PDC = O_PDS + 1048576,
                 O_PCKV = O_PDC + 73728, O_PKPE = O_PCKV + 4227072, O_SLH = O_PKPE + 1056768, O_SLC = O_SLH + 65536, O_SDS = O_SLC + 196608,
                 O_SDC = O_SDS + 4194304, O_SCKV = O_SDC + 294912, O_SKPE = O_SCKV + 8192;

struct P {
    const float* in[38];
    float* out;
    unsigned* bar;
    float* X; bf16_t* H; float* SS;
    bf16_t *G1, *XC, *RI, *HG; float *CP, *CH; float* BCAT;
    bf16_t* PROJ; float *BA, *BG; bf16_t* QKVN; bf16_t *DW, *DUt, *DQD, *DKDt, *DATT; float* DGL; float* ORAW; bf16_t* ON;
    float* DQKV; bf16_t *CQ, *CKVb, *KPEb, *Q, *KV, *AO; float *QLAT, *QPE, *PART, *ML;
    bf16_t* HF;
    bf16_t *Wlru_in, *Wlru_gate, *Wlru_out, *Wdn_in, *Wdn_out, *Wmla_d, *Wmla_uq, *Wmla_kvup, *Wmla_o, *Wgu, *Wdown;
};

#define GASP __attribute__((address_space(1)))
struct PG {
    GASP const float* in[38];
    GASP float* out;
    GASP unsigned* bar;
    GASP float* X; GASP bf16_t* H; GASP float* SS;
    GASP bf16_t *G1, *XC, *RI, *HG; GASP float *CP, *CH; GASP float* BCAT;
    GASP bf16_t* PROJ; GASP float *BA, *BG; GASP bf16_t* QKVN; GASP bf16_t *DW, *DUt, *DQD, *DKDt, *DATT; GASP float* DGL; GASP float* ORAW; GASP bf16_t* ON;
    GASP float* DQKV; GASP bf16_t *CQ, *CKVb, *KPEb, *Q, *KV, *AO; GASP float *QLAT, *QPE, *PART, *ML;
    GASP bf16_t* HF;
    GASP bf16_t *Wlru_in, *Wlru_gate, *Wlru_out, *Wdn_in, *Wdn_out, *Wmla_d, *Wmla_uq, *Wmla_kvup, *Wmla_o, *Wgu, *Wdown;
};
static_assert(sizeof(PG) == sizeof(P), "PG layout");
__device__ __forceinline__ P glob(const LAS PG* gp) {
    const LAS PG& g = *gp; P q;
#pragma unroll
    for (int i = 0; i < 38; ++i) q.in[i] = (const float*)g.in[i];
    q.out = (decltype(q.out))g.out;
    q.bar = (decltype(q.bar))g.bar;
    q.X = (decltype(q.X))g.X;
    q.H = (decltype(q.H))g.H;
    q.SS = (decltype(q.SS))g.SS;
    q.G1 = (decltype(q.G1))g.G1;
    q.XC = (decltype(q.XC))g.XC;
    q.RI = (decltype(q.RI))g.RI;
    q.HG = (decltype(q.HG))g.HG;
    q.CP = (decltype(q.CP))g.CP;
    q.CH = (decltype(q.CH))g.CH;
    q.BCAT = (decltype(q.BCAT))g.BCAT;
    q.PROJ = (decltype(q.PROJ))g.PROJ;
    q.BA = (decltype(q.BA))g.BA;
    q.BG = (decltype(q.BG))g.BG;
    q.QKVN = (decltype(q.QKVN))g.QKVN;
    q.DW = (decltype(q.DW))g.DW;
    q.DUt = (decltype(q.DUt))g.DUt;
    q.DQD = (decltype(q.DQD))g.DQD;
    q.DKDt = (decltype(q.DKDt))g.DKDt;
    q.DATT = (decltype(q.DATT))g.DATT;
    q.DGL = (decltype(q.DGL))g.DGL;
    q.ORAW = (decltype(q.ORAW))g.ORAW;
    q.ON = (decltype(q.ON))g.ON;
    q.DQKV = (decltype(q.DQKV))g.DQKV;
    q.CQ = (decltype(q.CQ))g.CQ;
    q.CKVb = (decltype(q.CKVb))g.CKVb;
    q.KPEb = (decltype(q.KPEb))g.KPEb;
    q.Q = (decltype(q.Q))g.Q;
    q.KV = (decltype(q.KV))g.KV;
    q.AO = (decltype(q.AO))g.AO;
    q.QLAT = (decltype(q.QLAT))g.QLAT;
    q.QPE = (decltype(q.QPE))g.QPE;
    q.PART = (decltype(q.PART))g.PART;
    q.ML = (decltype(q.ML))g.ML;
    q.HF = (decltype(q.HF))g.HF;
    q.Wlru_in = (decltype(q.Wlru_in))g.Wlru_in;
    q.Wlru_gate = (decltype(q.Wlru_gate))g.Wlru_gate;
    q.Wlru_out = (decltype(q.Wlru_out))g.Wlru_out;
    q.Wdn_in = (decltype(q.Wdn_in))g.Wdn_in;
    q.Wdn_out = (decltype(q.Wdn_out))g.Wdn_out;
    q.Wmla_d = (decltype(q.Wmla_d))g.Wmla_d;
    q.Wmla_uq = (decltype(q.Wmla_uq))g.Wmla_uq;
    q.Wmla_kvup = (decltype(q.Wmla_kvup))g.Wmla_kvup;
    q.Wmla_o = (decltype(q.Wmla_o))g.Wmla_o;
    q.Wgu = (decltype(q.Wgu))g.Wgu;
    q.Wdown = (decltype(q.Wdown))g.Wdown;
    return q;
}
typedef float f32x2c __attribute__((ext_vector_type(2)));
typedef __bf16 bf16x2c __attribute__((ext_vector_type(2)));
__device__ __forceinline__ unsigned cvt_pk(float lo, float hi) { const f32x2c v = {lo, hi}; return __builtin_bit_cast(unsigned, __builtin_convertvector(v, bf16x2c)); }
__device__ __forceinline__ float bf2f(unsigned short h) { return __uint_as_float(((unsigned)h) << 16); }
__device__ __forceinline__ float bflo(unsigned w) { return __uint_as_float(w << 16); }
__device__ __forceinline__ float bfhi(unsigned w) { return __uint_as_float(w & 0xffff0000u); }
__device__ __forceinline__ float sigmoidf_(float x) { return __builtin_amdgcn_rcpf(1.0f + __builtin_amdgcn_exp2f(-1.4426950408889634f * x)); }
__device__ __forceinline__ float siluf_(float x) { return x * sigmoidf_(x); }
__device__ __forceinline__ float softplusf_(float x) { return x > 20.f ? x : log1pf(__expf(x)); }
__device__ __forceinline__ float gelu_tanh(float x) { const float y = 0.7978845608028654f * (x + 0.044715f * x * x * x); const float t = 1.0f - 2.0f * __builtin_amdgcn_rcpf(__builtin_amdgcn_exp2f(2.885390081777927f * y) + 1.0f); return 0.5f * x * (1.0f + t); }
__device__ __forceinline__ void swap32(float& a, float& b) { const auto r = __builtin_amdgcn_permlane32_swap(__float_as_uint(a), __float_as_uint(b), false, false); a = __uint_as_float(r[0]); b = __uint_as_float(r[1]); }
__device__ __forceinline__ void swap16(float& a, float& b) { const auto r = __builtin_amdgcn_permlane16_swap(__float_as_uint(a), __float_as_uint(b), false, false); a = __uint_as_float(r[0]); b = __uint_as_float(r[1]); }
__device__ __forceinline__ float sum_x32(float x) { float a = x, b = x; swap32(a, b); return a + b; }
__device__ __forceinline__ float sum_x16(float x) { float a = x, b = x; swap16(a, b); return a + b; }
__device__ __forceinline__ float max_x32(float x) { float a = x, b = x; swap32(a, b); return fmaxf(a, b); }
__device__ __forceinline__ float max_x16(float x) { float a = x, b = x; swap16(a, b); return fmaxf(a, b); }
__device__ __forceinline__ float wave_sum(float v) { v = sum_x32(v); v = sum_x16(v); v += __shfl_xor(v, 8); v += __shfl_xor(v, 4); v += __shfl_xor(v, 2); v += __shfl_xor(v, 1); return v; }
__device__ __forceinline__ int ltid() { int t = threadIdx.x; asm volatile("" : "+v"(t)); return t; }
template <class T> __device__ __forceinline__ T* uni(T* p) {
    const unsigned long long v = (unsigned long long)p; const unsigned lo = __builtin_amdgcn_readfirstlane((unsigned)v), hi = __builtin_amdgcn_readfirstlane((unsigned)(v >> 32));
    return (T*)(__attribute__((address_space(1))) T*)(((unsigned long long)hi << 32) | lo); }
__device__ __forceinline__ f32x4 mfma16(bf16x8 a, bf16x8 b, f32x4 c) { return __builtin_amdgcn_mfma_f32_16x16x32_bf16(a, b, c, 0, 0, 0); }

#define XB_TMO      128
#define XB_XCNT(j)  (256  + 64 * (j))
#define XB_XSUB(j)  (1280 + 64 * (j))
#define XB_XGEN(j)  (2304 + 64 * (j))
#define XB_TOP      3328
#define XB_TOPGEN   3392
#define XCD_BAR_WORDS 3456
#define XB_SPIN_CAP (1u << 18)
__device__ __forceinline__ unsigned xb_ld(unsigned* p)              { return __hip_atomic_load(p, __ATOMIC_RELAXED, __HIP_MEMORY_SCOPE_AGENT); }
__device__ __forceinline__ unsigned xb_add(unsigned* p, unsigned v) { return __hip_atomic_fetch_add(p, v, __ATOMIC_RELAXED, __HIP_MEMORY_SCOPE_AGENT); }
__device__ __forceinline__ unsigned xb_xcc_id() { return (unsigned)__builtin_amdgcn_s_getreg((3 << 11) | 20) & 0xFu; }
#define XB_SPIN(cond, bar) do { unsigned _sp = 0; while (cond) { __builtin_amdgcn_s_sleep(1); \
    if ((++_sp & 255u) == 0u) { if (xb_ld(&(bar)[XB_TMO])) break; if (_sp > XB_SPIN_CAP) { atomicAdd(&(bar)[XB_TMO], 1u); break; } } } } while (0)
struct XcdBarrier { unsigned* bar; unsigned x; volatile LAS unsigned* st; };
__device__ __forceinline__ XcdBarrier xcd_barrier_post(unsigned* bar, volatile LAS unsigned* st) {
    XcdBarrier b; b.bar = bar; b.x = xb_xcc_id(); b.st = st;
    if (threadIdx.x == 0) (void)xb_add(&bar[XB_XCNT(b.x)], 1u);
    return b;
}
__device__ __forceinline__ void xcd_barrier_complete(unsigned* bar, unsigned x, unsigned& nloc, unsigned& nx) {
    const unsigned G = gridDim.x * gridDim.y * gridDim.z;
    unsigned sum, cnt, mine, sp = 0u;
    for (;;) {
        sum = 0u; cnt = 0u; mine = 0u;
#pragma unroll
        for (unsigned j = 0; j < 16; ++j) { const unsigned c = xb_ld(&bar[XB_XCNT(j)]); sum += c; cnt += (c > 0u) ? 1u : 0u; mine = (j == x) ? c : mine; }
        if (sum == G) break;
        __builtin_amdgcn_s_sleep(1);
        if ((++sp & 255u) == 0u) { if (xb_ld(&bar[XB_TMO])) break; if (sp > XB_SPIN_CAP) { atomicAdd(&bar[XB_TMO], 1u); break; } }
    }
    nloc = mine > 0u ? mine : 1u; nx = cnt > 0u ? cnt : 1u;
}
__device__ __forceinline__ void xcd_barrier(const XcdBarrier& b) {
    asm volatile("s_waitcnt vmcnt(0)" ::: "memory");
    __syncthreads();
    if (threadIdx.x == 0) {
        unsigned* bar = b.bar;
        __builtin_amdgcn_s_waitcnt(0);
        unsigned nloc = b.st[0], nx = b.st[1];
        if (nloc == 0u) { xcd_barrier_complete(bar, b.x, nloc, nx); b.st[0] = nloc; b.st[1] = nx; }
        const unsigned old = xb_add(&bar[XB_XSUB(b.x)], 1u);
        const unsigned gen = old / nloc;
        if (old + 1u == (gen + 1u) * nloc) {
            __builtin_amdgcn_fence(__ATOMIC_RELEASE, "agent");
            asm volatile("s_waitcnt vmcnt(0)" ::: "memory");
            const unsigned og = xb_add(&bar[XB_TOP], 1u);
            const unsigned tg = og / nx;
            if (og + 1u == (tg + 1u) * nx) xb_add(&bar[XB_TOPGEN], 1u);
            else XB_SPIN(xb_ld(&bar[XB_TOPGEN]) == tg, bar);
            __builtin_amdgcn_fence(__ATOMIC_ACQUIRE, "agent");
            xb_add(&bar[XB_XGEN(b.x)], 1u);
            asm volatile("s_waitcnt vmcnt(0)" ::: "memory");
        } else {
            XB_SPIN(xb_ld(&bar[XB_XGEN(b.x)]) == gen, bar);
            __builtin_amdgcn_fence(__ATOMIC_ACQUIRE, "agent");
            asm volatile("s_waitcnt vmcnt(0)" ::: "memory");
        }
    }
    __syncthreads();
}

struct Job { const float* src; int ld, K; bf16_t* dst; int nrows, nvalid, mode; const float* gain; };
__device__ __forceinline__ Job get_job(const P& p, int idx) {
    Job j; j.mode = 0; j.gain = nullptr;
    if (idx < 2)        { j.src = p.in[13] + (size_t)idx * 1024 * 2048; j.ld = 2048; j.K = 1024; j.dst = p.Wlru_in + (size_t)idx * 2048 * 1024; j.nrows = 2048; j.nvalid = 2048; j.gain = p.in[10] + (idx == 0 ? 0 : 3) * D; }
    else if (idx < 18)  { const int r = idx - 2, l = r >> 3, q = r & 7, blk = q >> 1, isI = q & 1;
                          j.src = (isI ? p.in[18] : p.in[16]) + (size_t)(l * 4 + blk) * 65536; j.ld = 256; j.K = 256;
                          j.dst = p.Wlru_gate + (size_t)l * 2048 * 256 + (size_t)(blk * 512 + isI * 256) * 256; j.nrows = 256; j.nvalid = 256; }
    else if (idx < 20)  { const int l = idx - 18; j.src = p.in[21] + (size_t)l * 1048576; j.ld = 1024; j.K = 1024; j.dst = p.Wlru_out + (size_t)l * 1048576; j.nrows = 1024; j.nvalid = 1024; }
    else if (idx == 20) { j.src = p.in[22]; j.ld = DNPROJ; j.K = 1024; j.dst = p.Wdn_in; j.nrows = DNPROJP; j.nvalid = DNPROJ; j.gain = p.in[10] + 1 * D; }
    else if (idx == 21) { j.src = p.in[27]; j.ld = 1024; j.K = 1024; j.dst = p.Wdn_out; j.nrows = 1024; j.nvalid = 1024; }
    else if (idx == 22) { j.src = p.in[28]; j.ld = 512; j.K = 1024; j.dst = p.Wmla_d; j.nrows = 512; j.nvalid = 512; j.gain = p.in[10] + 2 * D; }
    else if (idx == 23) { j.src = p.in[31]; j.ld = 320; j.K = 1024; j.dst = p.Wmla_d + (size_t)512 * 1024; j.nrows = 512; j.nvalid = 320; j.gain = p.in[10] + 2 * D; }
    else if (idx == 24) { j.src = p.in[30]; j.ld = 1536; j.K = 512; j.dst = p.Wmla_uq; j.nrows = 1536; j.nvalid = 1536; }
    else if (idx == 25) { j.src = p.in[33]; j.ld = 1024; j.K = 256; j.dst = p.Wmla_kvup; j.nrows = 1024; j.nvalid = 1024; }
    else if (idx == 26) { j.src = p.in[34]; j.ld = 1024; j.K = 256; j.dst = p.Wmla_kvup + (size_t)1024 * 256; j.nrows = 1024; j.nvalid = 1024; }
    else if (idx == 27) { j.src = p.in[35]; j.ld = 1024; j.K = 1024; j.dst = p.Wmla_o; j.nrows = 1024; j.nvalid = 1024; }
    else if (idx < 32)  { const int l = idx - 28; j.src = p.in[36] + (size_t)l * 1024 * 5632; j.ld = 5632; j.K = 1024; j.dst = p.Wgu + (size_t)l * 5632 * 1024; j.nrows = 5632; j.nvalid = 5632; j.mode = 1; j.gain = p.in[11] + l * D; }
    else                { const int l = idx - 32; j.src = p.in[37] + (size_t)l * DFF * 1024; j.ld = 1024; j.K = DFF; j.dst = p.Wdown + (size_t)l * 1024 * DFF; j.nrows = 1024; j.nvalid = 1024; }
    return j;
}
constexpr int NJOBS = 36;
__device__ __forceinline__ void ph_init(const P& p, LAS char* smem) {
    const int tid = ltid();
    {
        const float4* meta = (const float4*)p.in[9]; const float4* xp = (const float4*)p.in[0]; const float4* xs = (const float4*)p.in[1];
        const int lane = tid & 63, wid = tid >> 6;
        for (int row = blockIdx.x * 8 + wid; row < MP; row += gridDim.x * 8) {
            const float4* src = nullptr;
            if (row < NTOK) { const int b = row / LP, t = row - b * LP; src = (t < NMETA) ? meta + t * 256 : xp + (size_t)(b * 2048 + t - NMETA) * 256; }
            else if (row < NTOK + NS) src = xs + (row - NTOK) * 256;
            float ss = 0.f;
#pragma unroll
            for (int i = 0; i < 4; ++i) { const float4 v = src ? src[lane + 64 * i] : make_float4(0.f, 0.f, 0.f, 0.f);
                ((float4*)(p.X + (size_t)row * D))[lane + 64 * i] = v; ss += v.x * v.x + v.y * v.y + v.z * v.z + v.w * v.w;
                *(u32x2*)(p.H + (size_t)row * D + 4 * (lane + 64 * i)) = (u32x2){cvt_pk(v.x, v.y), cvt_pk(v.z, v.w)}; }
            ss = wave_sum(ss);
            if (lane < 16) p.SS[(size_t)row * 16 + lane] = (lane == 0) ? ss : 0.f;
        }
        for (int i = blockIdx.x * NTHREADS + tid; i < 2 * 2048; i += gridDim.x * NTHREADS) { const int l = i >> 11, col = i & 2047, blk = col >> 9, isI = (col >> 8) & 1, c = col & 255;
            p.BCAT[i] = (isI ? p.in[19] : p.in[17])[l * 1024 + blk * 256 + c]; }
        const int npad = (MP - NTOK - NS) * 1024 / 8;
        for (int i = blockIdx.x * NTHREADS + tid; i < npad; i += gridDim.x * NTHREADS) {
            const size_t off = (size_t)(NTOK + NS) * 1024 + (size_t)i * 8; const u32x4 z = {0u, 0u, 0u, 0u};
            *(u32x4*)(p.HG + off) = z; *(u32x4*)(p.ON + off) = z; *(u32x4*)(p.AO + off) = z;
            { const int e = i * 8, prow = e >> 10, c = e & 1023; *(u32x4*)(p.XC + ((size_t)(c >> 8) * MP + (NTOK + NS) + prow) * 256 + (c & 255)) = z; }
        }
    }
    LAS int* jstart = (LAS int*)smem;
    LAS float* tile = (LAS float*)(smem + 256);
    if (tid == 0) { int acc = 0; for (int j = 0; j < NJOBS; ++j) { jstart[j] = acc; const Job jb = get_job(p, j); acc += (jb.nrows >> 6) * (jb.K >> 8); } jstart[NJOBS] = acc; }
    __syncthreads();
    const int total = jstart[NJOBS];
    struct TileRef { const float* src; bf16_t* dst; int ld, K, k0, n0; bool valid; const float* gain; };
    auto locate = [&](int t, TileRef& r, int& col) {
        int ji = 0; while (jstart[ji + 1] <= t) ++ji;
        const Job jb = get_job(p, ji);
        const int lt = t - jstart[ji], nkt = jb.K >> 8, tn = lt / nkt, tk = lt - tn * nkt;
        r.src = jb.src; r.dst = jb.dst; r.ld = jb.ld; r.K = jb.K; r.k0 = tk << 8; r.n0 = tn << 6; r.gain = jb.gain;
        const int nq = (tid & 15) * 4, n = r.n0 + nq; col = n; r.valid = n < jb.nvalid;
        if (jb.mode == 1) { const int q = n >> 5, sgu = (n >> 4) & 1, e = n & 15; col = sgu * DFF + q * 16 + e; } };
    auto fetch = [&](const TileRef& r, int col, float4 (&v)[8]) {
#pragma unroll
        for (int i = 0; i < 8; ++i) { const int kl = (tid >> 4) + 32 * i;
            v[i] = r.valid ? *(const float4*)(r.src + (size_t)(r.k0 + kl) * r.ld + col) : make_float4(0.f, 0.f, 0.f, 0.f);
            if (r.gain) { const float gk = r.gain[r.k0 + kl]; v[i].x *= gk; v[i].y *= gk; v[i].z *= gk; v[i].w *= gk; } } };
    TileRef cur, nxt; int ccol = 0, ncol = 0; float4 cv[8], nv[8];
    int t = blockIdx.x;
    if (t < total) { locate(t, cur, ccol); fetch(cur, ccol, cv); }
    for (; t < total; t += gridDim.x) {
        const bool has_next = t + (int)gridDim.x < total;
        if (has_next) { locate(t + gridDim.x, nxt, ncol); fetch(nxt, ncol, nv); }
        {   const int nq = (tid & 15) * 4;
#pragma unroll
            for (int i = 0; i < 8; ++i) { const int kl = (tid >> 4) + 32 * i;
                tile[kl * 65 + nq] = cv[i].x; tile[kl * 65 + nq + 1] = cv[i].y; tile[kl * 65 + nq + 2] = cv[i].z; tile[kl * 65 + nq + 3] = cv[i].w; }
        }
        __syncthreads();
        {
            const int j = tid & 7, nl = tid >> 3;
#pragma unroll
            for (int q = 0; q < 4; ++q) { float v[8];
#pragma unroll
                for (int e = 0; e < 8; ++e) v[e] = tile[(64 * q + 8 * j + e) * 65 + nl];
                u32x4 w; w.x = cvt_pk(v[0], v[1]); w.y = cvt_pk(v[2], v[3]); w.z = cvt_pk(v[4], v[5]); w.w = cvt_pk(v[6], v[7]);
                *(u32x4*)(cur.dst + (size_t)(cur.n0 + nl) * cur.K + cur.k0 + 64 * q + 8 * j) = w; }
        }
        __syncthreads();
        if (has_next) { cur = nxt; ccol = ncol;
#pragma unroll
            for (int i = 0; i < 8; ++i) cv[i] = nv[i]; }
    }
}

__device__ __forceinline__ void ph_norm(const float* X, const float* g, bf16_t* H) {
    const int tid = ltid(), lane = tid & 63, wid = tid >> 6;
    for (int row = blockIdx.x * 8 + wid; row < MP; row += gridDim.x * 8) {
        const float4* xr = (const float4*)(X + (size_t)row * D); float4 v[4]; float ss = 0.f;
#pragma unroll
        for (int i = 0; i < 4; ++i) { v[i] = xr[lane + 64 * i]; ss += v[i].x * v[i].x + v[i].y * v[i].y + v[i].z * v[i].z + v[i].w * v[i].w; }
        ss = wave_sum(ss); const float r = rsqrtf(ss * (1.0f / D) + RMS_EPS);
#pragma unroll
        for (int i = 0; i < 4; ++i) { const int c = 4 * (lane + 64 * i); const float4 gv = *(const float4*)(g + c);
            u32x2 w; w.x = cvt_pk(v[i].x * r * gv.x, v[i].y * r * gv.y); w.y = cvt_pk(v[i].z * r * gv.z, v[i].w * r * gv.w);
            *(u32x2*)(H + (size_t)row * D + c) = w; }
    }
}
__device__ __forceinline__ void ph_final_norm(const P& p) {
    const int tid = ltid(), lane = tid & 63, wid = tid >> 6; const float* g = p.in[12];
    for (int row = blockIdx.x * 8 + wid; row < NTOK + NS; row += gridDim.x * 8) {
        float* dst;
        if (row < NTOK) { const int b = row / LP, t = row - b * LP; if (t < NMETA) continue; dst = p.out + O_YP + (size_t)(b * 2048 + t - NMETA) * D; }
        else dst = p.out + O_YS + (size_t)(row - NTOK) * D;
        const float4* xr = (const float4*)(p.X + (size_t)row * D); float4 v[4]; float ss = 0.f;
#pragma unroll
        for (int i = 0; i < 4; ++i) { v[i] = xr[lane + 64 * i]; ss += v[i].x * v[i].x + v[i].y * v[i].y + v[i].z * v[i].z + v[i].w * v[i].w; }
        ss = wave_sum(ss); const float r = rsqrtf(ss * (1.0f / D) + RMS_EPS);
#pragma unroll
        for (int i = 0; i < 4; ++i) { const int c = 4 * (lane + 64 * i); const float4 gv = *(const float4*)(g + c);
            *(float4*)(dst + c) = make_float4(v[i].x * r * gv.x, v[i].y * r * gv.y, v[i].z * r * gv.z, v[i].w * r * gv.w); }
    }
}

struct GemmDesc { const bf16_t* A; int lda; const bf16_t* Bt; int K, N, ablk, pm0, npm; };
struct EpiLruIn { static constexpr bool GU = false; bf16_t* G1;
    __device__ __forceinline__ void st(int row, int col, f32x4 v) const {
        u32x2 w; if (col < 1024) { w.x = cvt_pk(gelu_tanh(v[0]), gelu_tanh(v[1])); w.y = cvt_pk(gelu_tanh(v[2]), gelu_tanh(v[3])); } else { w.x = cvt_pk(v[0], v[1]); w.y = cvt_pk(v[2], v[3]); }
        *(u32x2*)(G1 + (size_t)row * 2048 + col) = w; } };
struct EpiGate { static constexpr bool GU = false; bf16_t* RI; const float* bc;
    __device__ __forceinline__ void st(int row, int col, f32x4 v) const {
        const float4 bv = *(const float4*)(bc + col);
        *(u32x2*)(RI + (size_t)row * 2048 + col) = (u32x2){cvt_pk(sigmoidf_(v[0] + bv.x), sigmoidf_(v[1] + bv.y)), cvt_pk(sigmoidf_(v[2] + bv.z), sigmoidf_(v[3] + bv.w))}; } };
struct EpiResid { static constexpr bool GU = false; float* X;
    __device__ __forceinline__ void st(int row, int col, f32x4 v) const {
        float4* px = (float4*)(X + (size_t)row * D + col); float4 x = *px; x.x += v[0]; x.y += v[1]; x.z += v[2]; x.w += v[3]; *px = x; } };
struct EpiBf16 { static constexpr bool GU = false; bf16_t* O; int ld;
    __device__ __forceinline__ void st(int row, int col, f32x4 v) const { u32x2 w; w.x = cvt_pk(v[0], v[1]); w.y = cvt_pk(v[2], v[3]); *(u32x2*)(O + (size_t)row * ld + col) = w; } };
struct EpiDnIn { static constexpr bool GU = false; bf16_t* PROJ; float* BA;
    __device__ __forceinline__ void st(int row, int col, f32x4 v) const {
        u32x2 w; w.x = cvt_pk(v[0], v[1]); w.y = cvt_pk(v[2], v[3]); *(u32x2*)(PROJ + (size_t)row * DNPROJP + col) = w;
        if (col >= 4096 && col < DNPROJ) *(float4*)(BA + (size_t)row * 16 + (col - 4096)) = make_float4(v[0], v[1], v[2], v[3]); } };
struct EpiF32 { static constexpr bool GU = false; float* O; int ld;
    __device__ __forceinline__ void st(int row, int col, f32x4 v) const { *(float4*)(O + (size_t)row * ld + col) = make_float4(v[0], v[1], v[2], v[3]); } };
template <class E> struct EpiScaled { static constexpr bool GU = E::GU; E e; const float* ss;
    __device__ __forceinline__ float rs(int row) const {
        const __attribute__((address_space(1))) f32x4* q = (const __attribute__((address_space(1))) f32x4*)(ss + (size_t)row * 16); const f32x4 a = q[0], b = q[1], c = q[2], d = q[3];
        const float t = ((a[0] + a[1]) + (a[2] + a[3])) + ((b[0] + b[1]) + (b[2] + b[3])) + ((c[0] + c[1]) + (c[2] + c[3])) + ((d[0] + d[1]) + (d[2] + d[3]));
        return rsqrtf(t * (1.0f / D) + RMS_EPS); }
    __device__ __forceinline__ void st(int row, int col, f32x4 v) const { e.st(row, col, v * rs(row)); }
    __device__ __forceinline__ void st2(int row, int colg, f32x4 g, f32x4 u) const { const float r = rs(row); e.st2(row, colg, g * r, u * r); } };
struct EpiGU { static constexpr bool GU = true; bf16_t* HF;
    __device__ __forceinline__ void st2(int row, int colg, f32x4 g, f32x4 u) const {
        const int ff = (colg >> 5) * 16 + (colg & 15);
        u32x2 w; w.x = cvt_pk(siluf_(g[0]) * u[0], siluf_(g[1]) * u[1]); w.y = cvt_pk(siluf_(g[2]) * u[2], siluf_(g[3]) * u[3]);
        *(u32x2*)(HF + (size_t)row * DFF + ff) = w; } };

template <class Epi>
__device__ __forceinline__ void gemm_phase(const GemmDesc g, const Epi& epi, LAS char* smem) {
    constexpr int AP = 72;
    LAS bf16_t* As = (LAS bf16_t*)smem;
    LAS bf16_t* Bs = (LAS bf16_t*)(smem + 2 * 256 * AP * 2);
    int tid_ = threadIdx.x; asm volatile("" : "+v"(tid_));
    const int tid = tid_, lane = tid & 63, wid = tid >> 6, wm = wid >> 1, wn = wid & 1, li = lane & 15, lg = lane >> 4;
    const int nN = g.N >> 7, nU = (g.npm - g.pm0) * nN, nk = g.K >> 6;
    const int lrow = tid >> 3, lkc = (tid & 7) * 8;
    for (int u = blockIdx.x; u < nU; u += gridDim.x) {
        const int pq = u / nN, pn = u - pq * nN, pm = pq + g.pm0, m0 = pm << 8, n0 = pn << 7;
        const bf16_t* Ab = g.A + (size_t)m0 * g.lda + (g.ablk ? (n0 / g.ablk) * g.K : 0) + (size_t)lrow * g.lda + lkc;
        const bf16_t* Bb = g.Bt + (size_t)n0 * g.K + (size_t)lrow * g.K + lkc;
        f32x4 acc[4][4];
#pragma unroll
        for (int a = 0; a < 4; ++a)
#pragma unroll
            for (int b = 0; b < 4; ++b) acc[a][b] = (f32x4){0.f, 0.f, 0.f, 0.f};
        u32x4 ra[4], rb[2];
#pragma unroll
        for (int i = 0; i < 4; ++i) ra[i] = *(const u32x4*)(Ab + (size_t)(64 * i) * g.lda);
#pragma unroll
        for (int i = 0; i < 2; ++i) rb[i] = *(const u32x4*)(Bb + (size_t)(64 * i) * g.K);
#pragma unroll
        for (int i = 0; i < 4; ++i) *(LAS u32x4*)(As + (lrow + 64 * i) * AP + lkc) = ra[i];
#pragma unroll
        for (int i = 0; i < 2; ++i) *(LAS u32x4*)(Bs + (lrow + 64 * i) * AP + lkc) = rb[i];
        __syncthreads();
#pragma unroll 1
        for (int ks = 0; ks < nk; ++ks) {
            const int st = ks & 1;
            if (ks + 1 < nk) {
#pragma unroll
                for (int i = 0; i < 4; ++i) ra[i] = *(const u32x4*)(Ab + (size_t)(64 * i) * g.lda + (ks + 1) * 64);
#pragma unroll
                for (int i = 0; i < 2; ++i) rb[i] = *(const u32x4*)(Bb + (size_t)(64 * i) * g.K + (ks + 1) * 64);
            }
            const LAS bf16_t* as = As + st * 256 * AP + (wm * 64 + li) * AP + lg * 8;
            const LAS bf16_t* bs = Bs + st * 128 * AP + (wn * 64 + li) * AP + lg * 8;
#pragma unroll
            for (int kk = 0; kk < 2; ++kk) {
                bf16x8 xf[4], wf[4];
#pragma unroll
                for (int t = 0; t < 4; ++t) { xf[t] = *(const LAS bf16x8*)(as + t * 16 * AP + kk * 32); wf[t] = *(const LAS bf16x8*)(bs + t * 16 * AP + kk * 32); }
#pragma unroll
                for (int nt = 0; nt < 4; ++nt)
#pragma unroll
                    for (int mt = 0; mt < 4; ++mt) acc[nt][mt] = mfma16(wf[nt], xf[mt], acc[nt][mt]);
            }
            if (ks + 1 < nk) {
#pragma unroll
                for (int i = 0; i < 4; ++i) *(LAS u32x4*)(As + (st ^ 1) * 256 * AP + (lrow + 64 * i) * AP + lkc) = ra[i];
#pragma unroll
                for (int i = 0; i < 2; ++i) *(LAS u32x4*)(Bs + (st ^ 1) * 128 * AP + (lrow + 64 * i) * AP + lkc) = rb[i];
            }
            __syncthreads();
        }
        {   const int rowbase = m0 + wm * 64, colbase = n0 + wn * 64;
#pragma unroll
            for (int mt = 0; mt < 4; ++mt) { const int row = rowbase + 16 * mt + li;
                if constexpr (Epi::GU) {
#pragma unroll
                    for (int qq = 0; qq < 2; ++qq) epi.st2(row, colbase + 32 * qq + 4 * lg, acc[2 * qq][mt], acc[2 * qq + 1][mt]);
                } else {
#pragma unroll
                    for (int nt = 0; nt < 4; ++nt) epi.st(row, colbase + 16 * nt + 4 * lg, acc[nt][mt]);
                } } }
    }
}

namespace pg8 {
#define PG8_LAS __attribute__((address_space(3)))
constexpr int BM = 256, BK = 64, HALF = 128, HTB = HALF * BK * 2  , STAGE_BYTES = 8 * HTB, NXCD = 8, WGM = 8;

__host__ __device__ __forceinline__ int lds_byte(int r, int c) { const int st = (r >> 4) * 2 + (c >> 5), rr = r & 15, cc = c & 31, ob = rr * 64 + cc * 2; return st * 1024 + (ob ^ (((ob >> 9) & 1) << 5)); }
__host__ __device__ __forceinline__ void stage_rc(int b, int& R, int& C) { const int st = b / 1024, sb = b % 1024, swz = sb ^ (((sb >> 9) & 1) << 5); R = (st >> 1) * 16 + swz / 64; C = (st & 1) * 32 + (swz % 64) / 2; }
__host__ __device__ __forceinline__ int perm32(int rho) { const int n = rho >> 4, i = rho & 15; return 8 * (i >> 2) + 4 * n + (i & 3); }

struct Unit { int pm, pn; };
struct Gemm { const bf16_t* A; const bf16_t* Bt; int M, N, K; int lda = 0, ablk = 0; };

struct StaticOrder {
    int nM, nN, nwg, G, c;
    __host__ __device__ void init(int M, int N, int G_, int c_) { nM = M / BM; nN = N / BM; nwg = nM * nN; G = G_; c = c_; }
    __host__ __device__ bool next(int i, Unit& u) const {
        const long L = (long)i * G + c; if (L >= nwg) return false;
        int wgid = (int)L; { const int q = nwg / NXCD, r = nwg % NXCD, xcd = wgid % NXCD, off = wgid / NXCD; wgid = (xcd < r ? xcd * (q + 1) : r * (q + 1) + (xcd - r) * q) + off; }
        const int nig = WGM * nN, gid = wgid / nig, fm = gid * WGM, gsz = (nM - fm) < WGM ? (nM - fm) : WGM;
        u.pm = fm + ((wgid % nig) % gsz); u.pn = (wgid % nig) / gsz; return true;
    }
    __device__ __forceinline__ void a_ready(const Unit&) const {}
    __device__ __forceinline__ void done(const Unit&) const {}
};
template <class Epi, class Sched, bool ALIGN_EPI = false, bool SP2 = false, int LDA = 0, int ABLK = 0>
__device__ __forceinline__ void gemm_phase(PG8_LAS unsigned char* lds, const Gemm g, const Sched& S, const Epi& E) {
    int tid_ = threadIdx.x; asm volatile("" : "+v"(tid_));
    const int tid = tid_, wid = __builtin_amdgcn_readfirstlane(tid >> 6), lane = tid & 63, wr = wid >> 2, wc = wid & 3, fr = lane & 15, fq = lane >> 4;
    const int K = g.K, nt = K / BK, lda = LDA ? LDA : g.K;
    unsigned voffA[2], voffB[2];
#pragma unroll
    for (int i = 0; i < 2; ++i) { int R, C; stage_rc(tid * 16 + i * 8192, R, C); const int Rb = Epi::PERM ? ((R & ~31) + perm32(R & 31)) : R;
        voffA[i] = (unsigned)(R * lda + C) * 2u; voffB[i] = (unsigned)(Rb * K + C) * 2u; }
    const size_t kstep = (size_t)(BK * 2);
    const size_t hstep = (size_t)HALF * K * 2;
    const size_t tstep = 2 * hstep;
    const size_t hstepA = (size_t)HALF * lda * 2, tstepA = 2 * hstepA;
    auto akoff = [&](int pn) -> size_t { if constexpr (ABLK > 0) return (size_t)((pn * BM) / ABLK) * K * 2; else return (size_t)0; };
    const unsigned ldsw = (unsigned)wid * 1024u;
    const int aoff = lds_byte(wr * 64 + fr, fq * 8), boff = lds_byte(wc * 32 + fr, fq * 8);
#define PG8_SA(b, h) (((b) * 2 + (h)) * HTB)
#define PG8_SB(b, h) ((4 + (b) * 2 + (h)) * HTB)
#define PG8_STAGE(bufoff, gbase, voff) do { _Pragma("unroll") for (int _i = 0; _i < 2; ++_i) \
        __builtin_amdgcn_global_load_lds((const __attribute__((address_space(1))) unsigned*)((const char*)(gbase) + (voff)[_i]), (PG8_LAS unsigned*)(lds + (bufoff) + ldsw + _i * 8192), 16, 0, 0); } while (0)
#define PG8_LDA(dst, b, h) do { _Pragma("unroll") for (int m = 0; m < 4; ++m) _Pragma("unroll") for (int k = 0; k < 2; ++k) dst[m][k] = *(const PG8_LAS bf16x8*)(lds + PG8_SA(b, h) + aoff + m * 2048 + k * 1024); } while (0)
#define PG8_LDB(dst, b, h) do { _Pragma("unroll") for (int n = 0; n < 2; ++n) _Pragma("unroll") for (int k = 0; k < 2; ++k) dst[n][k] = *(const PG8_LAS bf16x8*)(lds + PG8_SB(b, h) + boff + n * 2048 + k * 1024); } while (0)
#define PG8_MMA(ai, bj, At, Bt) do { __builtin_amdgcn_s_setprio(1); _Pragma("unroll") for (int m = 0; m < 4; ++m) _Pragma("unroll") for (int n = 0; n < 2; ++n) _Pragma("unroll") for (int k = 0; k < 2; ++k) \
        acc[ai][bj][m][n] = __builtin_amdgcn_mfma_f32_16x16x32_bf16(Bt[n][k], At[m][k], acc[ai][bj][m][n], 0, 0, 0); __builtin_amdgcn_s_setprio(0); } while (0)
#define PG8_WAIT_V(n) asm volatile("s_waitcnt vmcnt(" #n ")" ::: "memory")
#define PG8_WAIT_L(n) asm volatile("s_waitcnt lgkmcnt(" #n ")" ::: "memory")
#define PG8_BAR __builtin_amdgcn_s_barrier()
#define PG8_SCHED __builtin_amdgcn_sched_barrier(0)
    Unit cur, nxt; int ui = 0;
    if (!S.next(0, cur)) return;
    f32x4 acc[2][2][4][2];
#pragma unroll
    for (int a = 0; a < 2; ++a)
#pragma unroll
        for (int b = 0; b < 2; ++b)
#pragma unroll
            for (int m = 0; m < 4; ++m)
#pragma unroll
                for (int n = 0; n < 2; ++n) acc[a][b][m][n] = (f32x4){0.f, 0.f, 0.f, 0.f};
    bf16x8 At[4][2], B0[2][2], B1[2][2];
    const char* cA = (const char*)g.A + (size_t)cur.pm * tstepA + akoff(cur.pn); const char* cB = (const char*)g.Bt + (size_t)cur.pn * tstep;
    S.a_ready(cur);
    if constexpr (SP2) {
        PG8_STAGE(PG8_SB(0, 0), cB, voffB); PG8_STAGE(PG8_SB(0, 1), cB + hstep, voffB); PG8_STAGE(PG8_SA(0, 0), cA, voffA); PG8_STAGE(PG8_SA(0, 1), cA + hstepA, voffA);
        if (wr == 1) PG8_BAR;
        PG8_WAIT_V(2); PG8_BAR;
        PG8_STAGE(PG8_SB(1, 0), cB + kstep, voffB); PG8_STAGE(PG8_SA(1, 0), cA + kstep, voffA); PG8_STAGE(PG8_SB(1, 1), cB + hstep + kstep, voffB);
        PG8_WAIT_V(6); PG8_BAR;
    } else {
        PG8_STAGE(PG8_SB(0, 0), cB, voffB); PG8_STAGE(PG8_SA(0, 0), cA, voffA); PG8_STAGE(PG8_SB(0, 1), cB + hstep, voffB); PG8_STAGE(PG8_SA(0, 1), cA + hstepA, voffA);
        if (wr == 1) PG8_BAR;
        PG8_WAIT_V(4); PG8_BAR;
        PG8_STAGE(PG8_SB(1, 0), cB + kstep, voffB); PG8_STAGE(PG8_SA(1, 0), cA + kstep, voffA); PG8_STAGE(PG8_SB(1, 1), cB + hstep + kstep, voffB);
        PG8_WAIT_V(6); PG8_BAR;
    }
    for (;;) {
        const bool has_next = S.next(ui + 1, nxt);
        const char* nA = has_next ? (const char*)g.A + (size_t)nxt.pm * tstepA + akoff(nxt.pn) : cA; const char* nB = has_next ? (const char*)g.Bt + (size_t)nxt.pn * tstep : cB;
#pragma unroll 1
        for (int t = 0; t < nt; t += 2) {
            const bool last = (t == nt - 2);
            const char* a1 = cA + (size_t)(t + 1) * kstep;
            const char* a2 = last ? nA : cA + (size_t)(t + 2) * kstep; const char* b2 = last ? nB : cB + (size_t)(t + 2) * kstep;
            const char* a3 = a2 + kstep; const char* b3 = b2 + kstep;
            if (last && has_next) S.a_ready(nxt);
            if constexpr (SP2) {
            PG8_LDB(B0, 0, 0); PG8_LDB(B1, 0, 1); PG8_SCHED; PG8_LDA(At, 0, 0); PG8_STAGE(PG8_SA(1, 1), a1 + hstepA, voffA);
            PG8_WAIT_V(8); PG8_WAIT_L(0); PG8_BAR; PG8_MMA(0, 0, At, B0); PG8_MMA(0, 1, At, B1); PG8_BAR; PG8_SCHED;
            PG8_LDA(At, 0, 1); PG8_STAGE(PG8_SB(0, 0), b2, voffB); PG8_STAGE(PG8_SB(0, 1), b2 + hstep, voffB); PG8_STAGE(PG8_SA(0, 0), a2, voffA);
            PG8_WAIT_V(8); PG8_WAIT_L(0); PG8_BAR; PG8_MMA(1, 0, At, B0); PG8_MMA(1, 1, At, B1); PG8_BAR; PG8_SCHED;
            PG8_LDB(B0, 1, 0); PG8_LDB(B1, 1, 1); PG8_SCHED; PG8_LDA(At, 1, 0); PG8_STAGE(PG8_SA(0, 1), a2 + hstepA, voffA);
            PG8_WAIT_V(8); PG8_WAIT_L(0); PG8_BAR; PG8_MMA(0, 0, At, B0); PG8_MMA(0, 1, At, B1); PG8_BAR; PG8_SCHED;
            PG8_LDA(At, 1, 1); PG8_STAGE(PG8_SB(1, 0), b3, voffB); PG8_STAGE(PG8_SB(1, 1), b3 + hstep, voffB); PG8_STAGE(PG8_SA(1, 0), a3, voffA);
            PG8_WAIT_V(8); PG8_WAIT_L(0); PG8_BAR; PG8_MMA(1, 0, At, B0); PG8_MMA(1, 1, At, B1); PG8_BAR; PG8_SCHED;
            } else {
            PG8_LDB(B0, 0, 0); PG8_SCHED; PG8_LDA(At, 0, 0); PG8_STAGE(PG8_SA(1, 1), a1 + hstepA, voffA);
            PG8_WAIT_L(8); PG8_BAR; PG8_WAIT_L(0); PG8_MMA(0, 0, At, B0); PG8_BAR; PG8_SCHED;
            PG8_LDB(B1, 0, 1); PG8_STAGE(PG8_SB(0, 0), b2, voffB);
            PG8_BAR; PG8_WAIT_L(0); PG8_MMA(0, 1, At, B1); PG8_BAR;
            PG8_LDA(At, 0, 1); PG8_STAGE(PG8_SA(0, 0), a2, voffA);
            PG8_BAR; PG8_WAIT_L(0); PG8_MMA(1, 0, At, B0); PG8_BAR; PG8_SCHED;
            PG8_STAGE(PG8_SB(0, 1), b2 + hstep, voffB);
            PG8_WAIT_V(6); PG8_BAR; PG8_MMA(1, 1, At, B1); PG8_BAR;
            PG8_LDB(B0, 1, 0); PG8_SCHED; PG8_LDA(At, 1, 0); PG8_STAGE(PG8_SA(0, 1), a2 + hstepA, voffA);
            PG8_WAIT_L(8); PG8_BAR; PG8_WAIT_L(0); PG8_MMA(0, 0, At, B0); PG8_BAR; PG8_SCHED;
            PG8_LDB(B1, 1, 1); PG8_STAGE(PG8_SB(1, 0), b3, voffB);
            PG8_BAR; PG8_WAIT_L(0); PG8_MMA(0, 1, At, B1); PG8_BAR;
            PG8_LDA(At, 1, 1); PG8_STAGE(PG8_SA(1, 0), a3, voffA);
            PG8_BAR; PG8_WAIT_L(0); PG8_MMA(1, 0, At, B0); PG8_BAR; PG8_SCHED;
            PG8_STAGE(PG8_SB(1, 1), b3 + hstep, voffB);
            PG8_WAIT_V(6); PG8_BAR; PG8_MMA(1, 1, At, B1); PG8_BAR;
            }
        }
        if constexpr (ALIGN_EPI) { if (wr == 0) PG8_BAR; }
        if constexpr (!Epi::AFTER_DRAIN) { E(acc, cur, wr, wc, fr, fq); S.done(cur); }
        if (!has_next) break;
#pragma unroll
        for (int a = 0; a < 2; ++a)
#pragma unroll
            for (int b = 0; b < 2; ++b)
#pragma unroll
                for (int m = 0; m < 4; ++m)
#pragma unroll
                    for (int n = 0; n < 2; ++n) acc[a][b][m][n] = (f32x4){0.f, 0.f, 0.f, 0.f};
        cur = nxt; cA = nA; cB = nB; ++ui;
        if constexpr (ALIGN_EPI) { if (wr == 1) PG8_BAR; }
    }
    PG8_WAIT_V(0);
    if constexpr (!ALIGN_EPI) { if (wr == 0) PG8_BAR; }
    PG8_BAR;
    if constexpr (Epi::AFTER_DRAIN) { E.fused(acc, cur, wr, wc, fr, fq, lds, wid, lane); S.done(cur); }
#undef PG8_SA
#undef PG8_SB
#undef PG8_STAGE
#undef PG8_LDA
#undef PG8_LDB
#undef PG8_MMA
#undef PG8_WAIT_V
#undef PG8_WAIT_L
#undef PG8_BAR
#undef PG8_SCHED
}
}


struct EpiResidAt { static constexpr bool GU = false; float* X;
    __device__ __forceinline__ void st(int row, int col, f32x4 v) const { float* px = X + (size_t)row * D + col;
        unsafeAtomicAdd(px, v[0]); unsafeAtomicAdd(px + 1, v[1]); unsafeAtomicAdd(px + 2, v[2]); unsafeAtomicAdd(px + 3, v[3]); } };
template <bool XN, class Epi>
__device__ __forceinline__ void gemm_small(const bf16_t* A, int lda, const bf16_t* Bt, int K, int N, int row0, int nrt, int S, const Epi& epi, LAS char* smem, const float* Xf = nullptr, int ablk = 0) {
    constexpr int AP = 72;
    LAS bf16_t* As = (LAS bf16_t*)smem;
    LAS bf16_t* Bs = (LAS bf16_t*)(smem + 2 * 64 * AP * 2);
    LAS float* rsS = (LAS float*)(smem + 2 * 64 * AP * 2 + 2 * 128 * AP * 2);
    int tid_ = threadIdx.x; asm volatile("" : "+v"(tid_));
    const int tid = tid_, lane = tid & 63, wid = tid >> 6, wm = wid >> 2, wn = wid & 3, li = lane & 15, lg = lane >> 4;
    const int nN = N >> 7, kper = (K >> 6) / S, nU = nrt * nN * S;
    const int lrow = tid >> 3, lkc = (tid & 7) * 8;
    const int G = (int)gridDim.x, nmain = (MMAIN / 256) * (N >> 8), first = nmain % G;
    for (int u = ((int)blockIdx.x - first + G) % G; u < nU; u += G) {
        const int ksp = u % S, t = u / S, pn = t % nN, rt = t / nN, m0 = row0 + rt * 64, n0 = pn << 7, k0 = ksp * kper * 64;
        const bf16_t* Ab = A + (ablk ? (size_t)(n0 / ablk) * MP * K : (size_t)0) + (size_t)(m0 + lrow) * lda + k0 + lkc;
        const bf16_t* Bb = Bt + (size_t)(n0 + lrow) * K + k0 + lkc;
        f32x4 acc[2][2];
#pragma unroll
        for (int a = 0; a < 2; ++a)
#pragma unroll
            for (int b = 0; b < 2; ++b) acc[a][b] = (f32x4){0.f, 0.f, 0.f, 0.f};
        u32x4 ra, rb[2];
        const float* Xb = XN ? Xf + (size_t)(m0 + lrow) * D + k0 + lkc : nullptr;
        auto loadA = [&](int ks) { if constexpr (XN) { const float4 a = *(const float4*)(Xb + ks * 64), c = *(const float4*)(Xb + ks * 64 + 4); ra = (u32x4){cvt_pk(a.x, a.y), cvt_pk(a.z, a.w), cvt_pk(c.x, c.y), cvt_pk(c.z, c.w)}; } else ra = *(const u32x4*)(Ab + ks * 64); };
        if constexpr (XN) {
#pragma unroll
            for (int r = 0; r < 8; ++r) { const float4* xr = (const float4*)(Xf + (size_t)(m0 + wid * 8 + r) * D); float ss = 0.f;
#pragma unroll
                for (int i = 0; i < 4; ++i) { const float4 v = xr[lane + 64 * i]; ss += v.x * v.x + v.y * v.y + v.z * v.z + v.w * v.w; }
                ss = wave_sum(ss); if (lane == 0) rsS[wid * 8 + r] = rsqrtf(ss * (1.0f / D) + RMS_EPS); }
        }
        loadA(0);
#pragma unroll
        for (int i = 0; i < 2; ++i) rb[i] = *(const u32x4*)(Bb + (size_t)(64 * i) * K);
        *(LAS u32x4*)(As + lrow * AP + lkc) = ra;
#pragma unroll
        for (int i = 0; i < 2; ++i) *(LAS u32x4*)(Bs + (lrow + 64 * i) * AP + lkc) = rb[i];
        __syncthreads();
#pragma unroll 1
        for (int ks = 0; ks < kper; ++ks) {
            const int st = ks & 1;
            if (ks + 1 < kper) { loadA(ks + 1);
#pragma unroll
                for (int i = 0; i < 2; ++i) rb[i] = *(const u32x4*)(Bb + (size_t)(64 * i) * K + (ks + 1) * 64); }
            const LAS bf16_t* as = As + st * 64 * AP + (wm * 32 + li) * AP + lg * 8;
            const LAS bf16_t* bs = Bs + st * 128 * AP + (wn * 32 + li) * AP + lg * 8;
#pragma unroll
            for (int kk = 0; kk < 2; ++kk) {
                bf16x8 xf[2], wf[2];
#pragma unroll
                for (int t2 = 0; t2 < 2; ++t2) { xf[t2] = *(const LAS bf16x8*)(as + t2 * 16 * AP + kk * 32); wf[t2] = *(const LAS bf16x8*)(bs + t2 * 16 * AP + kk * 32); }
#pragma unroll
                for (int nt = 0; nt < 2; ++nt)
#pragma unroll
                    for (int mt = 0; mt < 2; ++mt) acc[nt][mt] = mfma16(wf[nt], xf[mt], acc[nt][mt]);
            }
            if (ks + 1 < kper) { *(LAS u32x4*)(As + (st ^ 1) * 64 * AP + lrow * AP + lkc) = ra;
#pragma unroll
                for (int i = 0; i < 2; ++i) *(LAS u32x4*)(Bs + (st ^ 1) * 128 * AP + (lrow + 64 * i) * AP + lkc) = rb[i]; }
            __syncthreads();
        }
#pragma unroll
        for (int mt = 0; mt < 2; ++mt) { const int row = m0 + wm * 32 + 16 * mt + li, colb = n0 + wn * 32 + 4 * lg;
            if constexpr (XN) { const float r = rsS[wm * 32 + 16 * mt + li]; acc[0][mt] *= r; acc[1][mt] *= r; }
            if constexpr (Epi::GU) epi.st2(row, colb, acc[0][mt], acc[1][mt]);
            else { epi.st(row, colb, acc[0][mt]); epi.st(row, colb + 16, acc[1][mt]); } }
        if constexpr (XN) __syncthreads();
    }
}

template <class T> struct is_scaled : std::false_type {};
template <class E> struct is_scaled<EpiScaled<E>> : std::true_type {};
template <class E> struct PgEpi {
    static constexpr bool PERM = false, AFTER_DRAIN = false; E e;
    __device__ __forceinline__ void operator()(const f32x4 (&acc)[2][2][4][2], const pg8::Unit& u, int wr, int wc, int fr, int fq) const {
#pragma unroll
        for (int ai = 0; ai < 2; ++ai)
#pragma unroll
            for (int m = 0; m < 4; ++m) { const int row = u.pm * 256 + ai * 128 + wr * 64 + m * 16 + fr; float r = 1.f;
                if constexpr (is_scaled<E>::value) r = e.rs(row);
#pragma unroll
                for (int bj = 0; bj < 2; ++bj) { const int colb = u.pn * 256 + bj * 128 + wc * 32 + 4 * fq;
                    if constexpr (is_scaled<E>::value) {
                        if constexpr (E::GU) e.e.st2(row, colb, acc[ai][bj][m][0] * r, acc[ai][bj][m][1] * r);
                        else { e.e.st(row, colb, acc[ai][bj][m][0] * r); e.e.st(row, colb + 16, acc[ai][bj][m][1] * r); } }
                    else {
                        if constexpr (E::GU) e.st2(row, colb, acc[ai][bj][m][0], acc[ai][bj][m][1]);
                        else { e.st(row, colb, acc[ai][bj][m][0]); e.st(row, colb + 16, acc[ai][bj][m][1]); } } }
                asm volatile("" ::: "memory"); }
    }
};
struct GateOrder { int G, c;
    __device__ __forceinline__ bool next(int i, pg8::Unit& u) const { const int L = i * G + c; if (L >= 512) return false;
        const int half = L & 1, pm = (L >> 1) & 63, blk = L >> 7; u.pm = blk * NPANEL + pm; u.pn = 2 * blk + half; return true; }
    __device__ __forceinline__ void a_ready(const pg8::Unit&) const {}
    __device__ __forceinline__ void done(const pg8::Unit&) const {} };
struct PgEpiGate { static constexpr bool PERM = false, AFTER_DRAIN = false; EpiGate e;
    __device__ __forceinline__ void operator()(const f32x4 (&acc)[2][2][4][2], const pg8::Unit& u, int wr, int wc, int fr, int fq) const {
        const int pm = u.pm % NPANEL;
#pragma unroll
        for (int ai = 0; ai < 2; ++ai)
#pragma unroll
            for (int m = 0; m < 4; ++m) { const int row = pm * 256 + ai * 128 + wr * 64 + m * 16 + fr;
#pragma unroll
                for (int bj = 0; bj < 2; ++bj) { const int colb = u.pn * 256 + bj * 128 + wc * 32 + 4 * fq; e.st(row, colb, acc[ai][bj][m][0]); e.st(row, colb + 16, acc[ai][bj][m][1]); asm volatile("" ::: "memory"); } }
    } };
template <class E>
__device__ __forceinline__ void big_gemm(const bf16_t* A, const bf16_t* Bt, int N, int K, const E& e, LAS char* smem) {
    A = uni(A); Bt = uni(Bt);
    pg8::Gemm g{A, Bt, MMAIN, N, K}; pg8::StaticOrder S; S.init(MMAIN, N, (int)gridDim.x, (int)blockIdx.x);
    PgEpi<E> pe{e};
    pg8::gemm_phase<PgEpi<E>, pg8::StaticOrder, true, true>((LAS unsigned char*)smem, g, S, pe);
    __syncthreads();
    gemm_small<false>(A, K, Bt, K, N, MMAIN, 3, 1, e, smem);
}
template <class E>
__device__ __forceinline__ void norm_gemm(const P& p, const bf16_t* Bt, int N, int site, const E& e, LAS char* smem) {
    const bf16_t* A = uni((const bf16_t*)p.H); Bt = uni(Bt); const float* ss = uni((const float*)p.SS) + (size_t)site * MP * 16;
    pg8::Gemm g{A, Bt, MMAIN, N, D}; pg8::StaticOrder S; S.init(MMAIN, N, (int)gridDim.x, (int)blockIdx.x);
    PgEpi<EpiScaled<E>> pe{EpiScaled<E>{e, ss}};
    pg8::gemm_phase<PgEpi<EpiScaled<E>>, pg8::StaticOrder, true, true>((LAS unsigned char*)smem, g, S, pe);
    __syncthreads();
    gemm_small<true>(A, D, Bt, D, N, MMAIN, 3, 1, e, smem, uni((const float*)p.X));
}
struct PgEpiResidN { static constexpr bool PERM = false, AFTER_DRAIN = false; float* X; bf16_t* XB; float* SSo;
    __device__ __forceinline__ void operator()(const f32x4 (&acc)[2][2][4][2], const pg8::Unit& u, int wr, int wc, int fr, int fq) const {
#pragma unroll
        for (int ai = 0; ai < 2; ++ai)
#pragma unroll
            for (int m = 0; m < 4; ++m) { const int row = u.pm * 256 + ai * 128 + wr * 64 + m * 16 + fr; float ssum = 0.f;
#pragma unroll
                for (int bj = 0; bj < 2; ++bj)
#pragma unroll
                    for (int n = 0; n < 2; ++n) { const int col = u.pn * 256 + bj * 128 + wc * 32 + 16 * n + 4 * fq; const f32x4 v = acc[ai][bj][m][n];
                        float4* px = (float4*)(X + (size_t)row * D + col); float4 x = *px; x.x += v[0]; x.y += v[1]; x.z += v[2]; x.w += v[3]; *px = x;
                        if (SSo) { *(u32x2*)(XB + (size_t)row * D + col) = (u32x2){cvt_pk(x.x, x.y), cvt_pk(x.z, x.w)}; ssum += x.x * x.x + x.y * x.y + x.z * x.z + x.w * x.w; } }
                if (SSo) { ssum = sum_x32(sum_x16(ssum)); if (fq == 0) SSo[(size_t)row * 16 + u.pn * 4 + wc] = ssum; } }
    }
};
__device__ __forceinline__ void resid_gemm(const P& p, const bf16_t* A, const bf16_t* Bt, int K, int site_out, LAS char* smem) {
    A = uni(A); Bt = uni(Bt); float* X = uni(p.X);
    pg8::Gemm g{A, Bt, MMAIN, D, K}; pg8::StaticOrder S; S.init(MMAIN, D, (int)gridDim.x, (int)blockIdx.x);
    PgEpiResidN pe{X, uni(p.H), site_out >= 0 ? uni(p.SS) + (size_t)site_out * MP * 16 : nullptr};
    pg8::gemm_phase<PgEpiResidN, pg8::StaticOrder, true, true>((LAS unsigned char*)smem, g, S, pe);
    __syncthreads();
    gemm_small<false>(A, K, Bt, K, D, MMAIN, 3, (K == DFF) ? 11 : 8, EpiResidAt{X}, smem);
}

template <int J>
__device__ __forceinline__ void ph_lru_conv(const P& p) {
    const float* cw = p.in[14] + J * 4 * 1024; const float* cb = p.in[15] + J * 1024;
    const float* sbuf = p.in[3] + (size_t)J * NS * 3 * 1024;
    float* pconv = p.out + O_PLC + (size_t)J * NB * 3 * 1024; float* sconv = p.out + O_SLC + (size_t)J * NS * 3 * 1024;
    const int gt = blockIdx.x * NTHREADS + ltid(), nth = gridDim.x * NTHREADS;
    constexpr int RUN = 16, RPS = LP / RUN;
    for (int it = gt; it < NB * RPS * 128; it += nth) {
        const int run = it >> 7, c0 = (it & 127) * 8, b = run / RPS, t0 = (run - b * RPS) * RUN;
        float w[4][8], bias[8];
#pragma unroll
        for (int e = 0; e < 8; ++e) { bias[e] = cb[c0 + e];
#pragma unroll
            for (int j = 0; j < 4; ++j) w[j][e] = cw[j * 1024 + c0 + e]; }
        const bf16_t* src = p.G1 + ((size_t)b * LP + t0) * 2048 + 1024 + c0;
        float x[4][8];
#pragma unroll
        for (int j = 0; j < 3; ++j) { const int back = 3 - j;
            if (t0 >= back) { const u32x4 q = *(const u32x4*)(src - (size_t)back * 2048);
#pragma unroll
                for (int e = 0; e < 4; ++e) { x[j][2 * e] = bflo(q[e]); x[j][2 * e + 1] = bfhi(q[e]); } }
            else {
#pragma unroll
                for (int e = 0; e < 8; ++e) x[j][e] = 0.f; } }
        bf16_t* dst = p.XC + ((size_t)(c0 >> 8) * MP + (size_t)b * LP + t0) * 256 + (c0 & 255);
#pragma unroll 4
        for (int r = 0; r < RUN; ++r) {
            const u32x4 q = *(const u32x4*)(src + (size_t)r * 2048);
#pragma unroll
            for (int e = 0; e < 4; ++e) { x[3][2 * e] = bflo(q[e]); x[3][2 * e + 1] = bfhi(q[e]); }
            float y[8];
#pragma unroll
            for (int e = 0; e < 8; ++e) y[e] = bias[e] + x[0][e] * w[0][e] + x[1][e] * w[1][e] + x[2][e] * w[2][e] + x[3][e] * w[3][e];
            *(u32x4*)(dst + (size_t)r * 256) = (u32x4){cvt_pk(y[0], y[1]), cvt_pk(y[2], y[3]), cvt_pk(y[4], y[5]), cvt_pk(y[6], y[7])};
            const int t = t0 + r;
            if (t >= LP - 3) { float* d = pconv + (size_t)(b * 3 + (t - (LP - 3))) * 1024 + c0;
                *(float4*)d = make_float4(x[3][0], x[3][1], x[3][2], x[3][3]); *(float4*)(d + 4) = make_float4(x[3][4], x[3][5], x[3][6], x[3][7]); }
#pragma unroll
            for (int e = 0; e < 8; ++e) { x[0][e] = x[1][e]; x[1][e] = x[2][e]; x[2][e] = x[3][e]; }
        }
    }
    for (int it = gt; it < NS * 128; it += nth) {
        const int s = it >> 7, c0 = (it & 127) * 8; const size_t row = (size_t)NTOK + s;
        float x[4][8];
        { const u32x4 q = *(const u32x4*)(p.G1 + row * 2048 + 1024 + c0);
#pragma unroll
          for (int e = 0; e < 4; ++e) { x[3][2 * e] = bflo(q[e]); x[3][2 * e + 1] = bfhi(q[e]); } }
#pragma unroll
        for (int j = 0; j < 3; ++j) { const float* bsrc = sbuf + (size_t)(s * 3 + j) * 1024 + c0; const float4 a = *(const float4*)bsrc, bq = *(const float4*)(bsrc + 4);
            x[j][0] = a.x; x[j][1] = a.y; x[j][2] = a.z; x[j][3] = a.w; x[j][4] = bq.x; x[j][5] = bq.y; x[j][6] = bq.z; x[j][7] = bq.w; }
#pragma unroll
        for (int j = 0; j < 3; ++j) { float* d = sconv + (size_t)(s * 3 + j) * 1024 + c0;
            *(float4*)d = make_float4(x[j + 1][0], x[j + 1][1], x[j + 1][2], x[j + 1][3]); *(float4*)(d + 4) = make_float4(x[j + 1][4], x[j + 1][5], x[j + 1][6], x[j + 1][7]); }
        float y[8];
#pragma unroll
        for (int e = 0; e < 8; ++e) { y[e] = cb[c0 + e];
#pragma unroll
            for (int j = 0; j < 4; ++j) y[e] += x[j][e] * cw[j * 1024 + c0 + e]; }
        *(u32x4*)(p.XC + ((size_t)(c0 >> 8) * MP + row) * 256 + (c0 & 255)) = (u32x4){cvt_pk(y[0], y[1]), cvt_pk(y[2], y[3]), cvt_pk(y[4], y[5]), cvt_pk(y[6], y[7])};
    }
}

__device__ __forceinline__ void lru_au(float cla, float r, float ig, float xc, float& a, float& u) {
    const float la = cla * r, x2 = 2.0f * la; a = __builtin_amdgcn_exp2f(1.4426950408889634f * la);
    const float om = (x2 > -0.02f) ? -x2 * (1.0f + x2 * (0.5f + x2 * (1.0f / 6.0f))) : 1.0f - a * a;
    u = __builtin_amdgcn_sqrtf(om) * (ig * xc);
}
template <int J>
__device__ __forceinline__ void ph_scan1(const P& p) {
    const float* lam = p.in[20] + J * 1024;
    const int tid = ltid(), sub = tid >> 8, ch = (tid & 255) * 4, blk = ch >> 8, cc = ch & 255;
    float cla[4];
#pragma unroll
    for (int e = 0; e < 4; ++e) cla[e] = -8.0f * softplusf_(-lam[ch + e]);
    for (int u = blockIdx.x; u < NB * SCH / 2; u += gridDim.x) {
        const int pr_ = 2 * u + sub, b = pr_ / SCH, ci = pr_ - b * SCH;
        const size_t row0 = (size_t)b * LP + ci * SCL;
        const bf16_t* pr = p.RI + row0 * 2048 + blk * 512 + cc; const bf16_t* px = p.XC + ((size_t)blk * MP + row0) * 256 + cc;
        float Pp[4] = {1.f, 1.f, 1.f, 1.f}, h[4] = {0.f, 0.f, 0.f, 0.f};
#pragma unroll 8
        for (int t = 0; t < SCL; ++t) {
            const u32x2 rw = *(const u32x2*)(pr + (size_t)t * 2048), iw = *(const u32x2*)(pr + (size_t)t * 2048 + 256), xw = *(const u32x2*)(px + (size_t)t * 256);
            const float r[4] = {bflo(rw.x), bfhi(rw.x), bflo(rw.y), bfhi(rw.y)}, ig[4] = {bflo(iw.x), bfhi(iw.x), bflo(iw.y), bfhi(iw.y)}, xc[4] = {bflo(xw.x), bfhi(xw.x), bflo(xw.y), bfhi(xw.y)};
#pragma unroll
            for (int e = 0; e < 4; ++e) { float a, uu; lru_au(cla[e], r[e], ig[e], xc[e], a, uu); h[e] = a * h[e] + uu; Pp[e] *= a; }
        }
        *(float4*)(p.CP + (size_t)(b * SCH + ci) * 1024 + ch) = make_float4(Pp[0], Pp[1], Pp[2], Pp[3]);
        *(float4*)(p.CH + (size_t)(b * SCH + ci) * 1024 + ch) = make_float4(h[0], h[1], h[2], h[3]);
    }
}
template <int J>
__device__ __forceinline__ void ph_scan2(const P& p) {
    const float* lam = p.in[20] + J * 1024;
    const int tid = ltid(), sub = tid >> 8, ch = (tid & 255) * 4, blk = ch >> 8, cc = ch & 255;
    float cla[4];
#pragma unroll
    for (int e = 0; e < 4; ++e) cla[e] = -8.0f * softplusf_(-lam[ch + e]);
    for (int u = blockIdx.x; u < NB * SCH / 2 + NS / 2; u += gridDim.x) {
        if (u < NB * SCH / 2) {
            const int pr_ = 2 * u + sub, b = pr_ / SCH, ci = pr_ - b * SCH;
            float h[4] = {0.f, 0.f, 0.f, 0.f};
            for (int cj = 0; cj < ci; ++cj) { const float4 cp = *(const float4*)(p.CP + (size_t)(b * SCH + cj) * 1024 + ch), chv = *(const float4*)(p.CH + (size_t)(b * SCH + cj) * 1024 + ch);
                h[0] = cp.x * h[0] + chv.x; h[1] = cp.y * h[1] + chv.y; h[2] = cp.z * h[2] + chv.z; h[3] = cp.w * h[3] + chv.w; }
            const size_t row0 = (size_t)b * LP + ci * SCL;
            const bf16_t* pr = p.RI + row0 * 2048 + blk * 512 + cc; const bf16_t* px = p.XC + ((size_t)blk * MP + row0) * 256 + cc; const bf16_t* pg = p.G1 + row0 * 2048 + ch;
            bf16_t* po = p.HG + row0 * 1024 + ch;
#pragma unroll 8
            for (int t = 0; t < SCL; ++t) {
                const u32x2 rw = *(const u32x2*)(pr + (size_t)t * 2048), iw = *(const u32x2*)(pr + (size_t)t * 2048 + 256), xw = *(const u32x2*)(px + (size_t)t * 256), gw = *(const u32x2*)(pg + (size_t)t * 2048);
                const float r[4] = {bflo(rw.x), bfhi(rw.x), bflo(rw.y), bfhi(rw.y)}, ig[4] = {bflo(iw.x), bfhi(iw.x), bflo(iw.y), bfhi(iw.y)}, xc[4] = {bflo(xw.x), bfhi(xw.x), bflo(xw.y), bfhi(xw.y)};
                const float gt[4] = {bflo(gw.x), bfhi(gw.x), bflo(gw.y), bfhi(gw.y)};
#pragma unroll
                for (int e = 0; e < 4; ++e) { float a, uu; lru_au(cla[e], r[e], ig[e], xc[e], a, uu); h[e] = a * h[e] + uu; }
                *(u32x2*)(po + (size_t)t * 1024) = (u32x2){cvt_pk(h[0] * gt[0], h[1] * gt[1]), cvt_pk(h[2] * gt[2], h[3] * gt[3])};
            }
            if (ci == SCH - 1) *(float4*)(p.out + O_PLH + (size_t)(J * NB + b) * 1024 + ch) = make_float4(h[0], h[1], h[2], h[3]);
        } else {
            const int s = 2 * (u - NB * SCH / 2) + sub; const size_t row = (size_t)NTOK + s;
            const u32x2 rw = *(const u32x2*)(p.RI + row * 2048 + blk * 512 + cc), iw = *(const u32x2*)(p.RI + row * 2048 + blk * 512 + 256 + cc), xw = *(const u32x2*)(p.XC + ((size_t)blk * MP + row) * 256 + cc), gw = *(const u32x2*)(p.G1 + row * 2048 + ch);
            const float r[4] = {bflo(rw.x), bfhi(rw.x), bflo(rw.y), bfhi(rw.y)}, ig[4] = {bflo(iw.x), bfhi(iw.x), bflo(iw.y), bfhi(iw.y)}, xc[4] = {bflo(xw.x), bfhi(xw.x), bflo(xw.y), bfhi(xw.y)};
            const float gt[4] = {bflo(gw.x), bfhi(gw.x), bflo(gw.y), bfhi(gw.y)};
            const float4 h0 = *(const float4*)(p.in[2] + (size_t)(J * NS + s) * 1024 + ch); const float h0v[4] = {h0.x, h0.y, h0.z, h0.w}; float h[4];
#pragma unroll
            for (int e = 0; e < 4; ++e) { float a, uu; lru_au(cla[e], r[e], ig[e], xc[e], a, uu); h[e] = a * h0v[e] + uu; }
            *(float4*)(p.out + O_SLH + (size_t)(J * NS + s) * 1024 + ch) = make_float4(h[0], h[1], h[2], h[3]);
            *(u32x2*)(p.HG + row * 1024 + ch) = (u32x2){cvt_pk(h[0] * gt[0], h[1] * gt[1]), cvt_pk(h[2] * gt[2], h[3] * gt[3])};
        }
    }
}

__device__ __forceinline__ void ph_dn_conv(const P& p) {
    const float* cw = p.in[23]; const float* sbuf = p.in[5];
    const int gt = blockIdx.x * NTHREADS + ltid(), nth = gridDim.x * NTHREADS;
    constexpr int RUN = 16, RPS = LP / RUN, NCG = DNQKV / 8;
    for (int it = gt; it < NB * RPS * NCG; it += nth) {
        const int run = it / NCG, cg = it - run * NCG, c0 = cg * 8, b = run / RPS, t0 = (run - b * RPS) * RUN; const bool nrm = c0 < 2048;
        float w[4][8];
#pragma unroll
        for (int e = 0; e < 8; ++e)
#pragma unroll
            for (int j = 0; j < 4; ++j) w[j][e] = cw[j * DNQKV + c0 + e];
        const bf16_t* src = p.PROJ + ((size_t)b * LP + t0) * DNPROJP + c0;
        float x[4][8];
#pragma unroll
        for (int j = 0; j < 3; ++j) { const int back = 3 - j;
            if (t0 >= back) { const u32x4 q = *(const u32x4*)(src - (size_t)back * DNPROJP);
#pragma unroll
                for (int e = 0; e < 4; ++e) { x[j][2 * e] = bflo(q[e]); x[j][2 * e + 1] = bfhi(q[e]); } }
            else {
#pragma unroll
                for (int e = 0; e < 8; ++e) x[j][e] = 0.f; } }
        bf16_t* dst = p.QKVN + ((size_t)b * LP + t0) * DNQKV + c0;
#pragma unroll 4
        for (int r = 0; r < RUN; ++r) {
            const u32x4 q = *(const u32x4*)(src + (size_t)r * DNPROJP);
#pragma unroll
            for (int e = 0; e < 4; ++e) { x[3][2 * e] = bflo(q[e]); x[3][2 * e + 1] = bfhi(q[e]); }
            float y[8]; float ss = 0.f;
#pragma unroll
            for (int e = 0; e < 8; ++e) { y[e] = siluf_(x[0][e] * w[0][e] + x[1][e] * w[1][e] + x[2][e] * w[2][e] + x[3][e] * w[3][e]); ss += y[e] * y[e]; }
            ss += __shfl_xor(ss, 1); ss += __shfl_xor(ss, 2); ss += __shfl_xor(ss, 4); ss += __shfl_xor(ss, 8);
            const float rn = nrm ? rsqrtf(ss + 1e-6f) : 1.0f;
            *(u32x4*)(dst + (size_t)r * DNQKV) = (u32x4){cvt_pk(y[0] * rn, y[1] * rn), cvt_pk(y[2] * rn, y[3] * rn), cvt_pk(y[4] * rn, y[5] * rn), cvt_pk(y[6] * rn, y[7] * rn)};
            const int t = t0 + r;
            if (t >= LP - 3) { float* d = p.out + O_PDC + (size_t)(b * 3 + (t - (LP - 3))) * DNQKV + c0;
                *(float4*)d = make_float4(x[3][0], x[3][1], x[3][2], x[3][3]); *(float4*)(d + 4) = make_float4(x[3][4], x[3][5], x[3][6], x[3][7]); }
#pragma unroll
            for (int e = 0; e < 8; ++e) { x[0][e] = x[1][e]; x[1][e] = x[2][e]; x[2][e] = x[3][e]; }
        }
    }
    for (int it = gt; it < NS * NCG; it += nth) {
        const int s = it / NCG, cg = it - s * NCG, c0 = cg * 8; const size_t row = (size_t)NTOK + s;
        float x[4][8];
        { const u32x4 q = *(const u32x4*)(p.PROJ + row * DNPROJP + c0);
#pragma unroll
          for (int e = 0; e < 4; ++e) { x[3][2 * e] = bflo(q[e]); x[3][2 * e + 1] = bfhi(q[e]); } }
#pragma unroll
        for (int j = 0; j < 3; ++j) { const float* bsrc = sbuf + (size_t)(s * 3 + j) * DNQKV + c0; const float4 a = *(const float4*)bsrc, bq = *(const float4*)(bsrc + 4);
            x[j][0] = a.x; x[j][1] = a.y; x[j][2] = a.z; x[j][3] = a.w; x[j][4] = bq.x; x[j][5] = bq.y; x[j][6] = bq.z; x[j][7] = bq.w; }
#pragma unroll
        for (int j = 0; j < 3; ++j) { float* d = p.out + O_SDC + (size_t)(s * 3 + j) * DNQKV + c0;
            *(float4*)d = make_float4(x[j + 1][0], x[j + 1][1], x[j + 1][2], x[j + 1][3]); *(float4*)(d + 4) = make_float4(x[j + 1][4], x[j + 1][5], x[j + 1][6], x[j + 1][7]); }
        float y[8]; float ss = 0.f;
#pragma unroll
        for (int e = 0; e < 8; ++e) { float a = 0.f;
#pragma unroll
            for (int j = 0; j < 4; ++j) a += x[j][e] * cw[j * DNQKV + c0 + e];
            y[e] = siluf_(a); ss += y[e] * y[e]; }
        ss += __shfl_xor(ss, 1); ss += __shfl_xor(ss, 2); ss += __shfl_xor(ss, 4); ss += __shfl_xor(ss, 8);
        const float rn = (c0 < 2048) ? rsqrtf(ss + 1e-6f) : 1.0f;
        *(u32x4*)(p.QKVN + row * DNQKV + c0) = (u32x4){cvt_pk(y[0] * rn, y[1] * rn), cvt_pk(y[2] * rn, y[3] * rn), cvt_pk(y[4] * rn, y[5] * rn), cvt_pk(y[6] * rn, y[7] * rn)};
    }
    for (int it = gt; it < (NTOK + NS) * 8; it += nth) {
        const int row = it >> 3, hh = it & 7;
        const float bb = p.BA[(size_t)row * 16 + hh], aa = p.BA[(size_t)row * 16 + 8 + hh];
        p.BG[(size_t)row * 16 + hh] = sigmoidf_(bb);
        p.BG[(size_t)row * 16 + 8 + hh] = -__expf(p.in[24][hh]) * softplusf_(aa + p.in[25][hh]);
    }
}

typedef float f32x2 __attribute__((ext_vector_type(2)));
template <int J>
__device__ __forceinline__ void solve_step(f32x2 (&s2)[32], const LAS float* Am) {
    const float sj = (J & 1) ? s2[J >> 1].y : s2[J >> 1].x;
    if constexpr ((J & 1) == 0) s2[J >> 1].y -= Am[J * 64 + J + 1] * sj;
    const f32x2 sjj = {sj, sj};
#pragma unroll
    for (int q = (J >> 1) + 1; q < 32; ++q) s2[q] -= *(const LAS f32x2*)(Am + J * 64 + 2 * q) * sjj;
    if constexpr ((J & 3) == 3) asm volatile("" ::: "memory");
    if constexpr (J + 1 < 63) solve_step<J + 1>(s2, Am);
}
__device__ __forceinline__ void ph_dn_chunk(const P& p, LAS char* smem) {
    constexpr int TP = 136;
    LAS float* Gs = (LAS float*)smem; LAS float* Bsh = Gs + 64; LAS float* gS = Bsh + 64;
    LAS float* Am = gS + 64;
    LAS bf16_t* Qs = (LAS bf16_t*)(Am + 4096); LAS bf16_t* Ks = Qs + 64 * TP; LAS bf16_t* Vs = Ks + 64 * TP;
    LAS bf16_t* SolS = Vs + 64 * TP;
    constexpr int NU3 = NB * NCHUNK * 8;
    for (int u = blockIdx.x; u < NU3; u += gridDim.x) {
        int tid = threadIdx.x; asm volatile("" : "+v"(tid));
        const int lane = tid & 63, wid = tid >> 6, li = lane & 15, lg = lane >> 4;
        {
            const int b = u / (NCHUNK * 8), rem = u - b * (NCHUNK * 8), c = rem >> 3, h = rem & 7;
            const int tbase = (c == 0) ? 0 : 16 + 64 * (c - 1), nvalid = (c == 0) ? 16 : 64;
            const size_t grow0 = (size_t)b * LP + tbase;
#pragma unroll
            for (int i = 0; i < 6; ++i) { const int cidx = tid + NTHREADS * i, which = cidx >> 10, r = (cidx >> 4) & 63, part = cidx & 15;
                u32x4 w = {0u, 0u, 0u, 0u};
                if (r < nvalid) w = *(const u32x4*)(p.QKVN + (grow0 + r) * DNQKV + which * 1024 + h * 128 + part * 8);
                *(LAS u32x4*)(Qs + which * 64 * TP + r * TP + part * 8) = w; }
            if (tid < 64) { const bool v = tid < nvalid; gS[tid] = v ? p.BG[(grow0 + tid) * 16 + 8 + h] : 0.f; Bsh[tid] = v ? p.BG[(grow0 + tid) * 16 + h] : 0.f; }
            __syncthreads();
            if (tid < 64) {
                float a = gS[tid];
#pragma unroll
                for (int o = 1; o < 64; o <<= 1) { const float t = __shfl_up(a, o); if (tid >= o) a += t; }
                Gs[tid] = a; }
            __syncthreads();
            {
#pragma unroll
                for (int tt = 0; tt < 4; ++tt) { const int tl = wid * 4 + tt, isQ = tl >> 4, it = (tl >> 2) & 3, jt = tl & 3;
                    const LAS bf16_t* Ap = (isQ ? Qs : Ks) + (16 * it + li) * TP + lg * 8; const LAS bf16_t* Bp = Ks + (16 * jt + li) * TP + lg * 8;
                    f32x4 acc = {0.f, 0.f, 0.f, 0.f};
#pragma unroll
                    for (int ks = 0; ks < 4; ++ks) acc = mfma16(*(const LAS bf16x8*)(Ap + ks * 32), *(const LAS bf16x8*)(Bp + ks * 32), acc);
                    const int j = 16 * jt + li; const float Gj = Gs[j];
#pragma unroll
                    for (int r = 0; r < 4; ++r) { const int i = 16 * it + 4 * lg + r; const float dec = __expf(Gs[i] - Gj);
                        if (isQ) p.DATT[(size_t)u * 4096 + i * 64 + j] = (bf16_t)(cvt_pk((j <= i) ? acc[r] * 0.08838834764831845f * dec : 0.f, 0.f) & 0xffffu);
                        else Am[j * 64 + i] = (j < i) ? Bsh[i] * acc[r] * dec : 0.f; } }
            }
            __syncthreads();
            if (tid < 256) {
                const int cidx = tid; f32x2 s2[32];
#pragma unroll
                for (int q = 0; q < 32; ++q) {
                    const int i0 = 2 * q, i1 = 2 * q + 1;
                    s2[q].x = (cidx < 128) ? bf2f(Vs[i0 * TP + cidx]) * Bsh[i0] : bf2f(Ks[i0 * TP + cidx - 128]) * Bsh[i0] * __expf(Gs[i0]);
                    s2[q].y = (cidx < 128) ? bf2f(Vs[i1 * TP + cidx]) * Bsh[i1] : bf2f(Ks[i1 * TP + cidx - 128]) * Bsh[i1] * __expf(Gs[i1]); }
                solve_step<0>(s2, Am);
#pragma unroll
                for (int q = 0; q < 32; ++q) { SolS[(2 * q) * 256 + cidx] = (bf16_t)(cvt_pk(s2[q].x, 0.f) & 0xffffu); SolS[(2 * q + 1) * 256 + cidx] = (bf16_t)(cvt_pk(s2[q].y, 0.f) & 0xffffu); }
            } else {
                const int t2 = tid - 256;
                {
                    const int part = t2 & 15, i0 = t2 >> 4;
#pragma unroll
                    for (int k = 0; k < 4; ++k) { const int i = i0 + 16 * k; const float sc = 0.08838834764831845f * __expf(Gs[i]); const u32x4 w = *(const LAS u32x4*)(Qs + i * TP + part * 8); u32x4 o;
#pragma unroll
                        for (int e = 0; e < 4; ++e) o[e] = cvt_pk(bflo(w[e]) * sc, bfhi(w[e]) * sc);
                        *(u32x4*)(p.DQD + (size_t)u * 8192 + i * 128 + part * 8) = o; }
                }
                {
                    const int dk = t2 & 127, half = t2 >> 7; const float Gl = Gs[63]; bf16_t* d = p.DKDt + (size_t)u * 8192 + dk * 64 + half * 32;
#pragma unroll
                    for (int q = 0; q < 4; ++q) { float v[8];
#pragma unroll
                        for (int e = 0; e < 8; ++e) { const int rr = half * 32 + q * 8 + e; v[e] = bf2f(Ks[rr * TP + dk]) * __expf(Gl - Gs[rr]); }
                        u32x4 w; w.x = cvt_pk(v[0], v[1]); w.y = cvt_pk(v[2], v[3]); w.z = cvt_pk(v[4], v[5]); w.w = cvt_pk(v[6], v[7]); *(u32x4*)(d + q * 8) = w; }
                }
                if (t2 == 0) p.DGL[u] = Gs[63];
            }
            __syncthreads();
            {
                const int dv = tid & 127, q = tid >> 7; unsigned w[8];
#pragma unroll
                for (int e = 0; e < 8; ++e) w[e] = (unsigned)SolS[(16 * q + 2 * e) * 256 + dv] | ((unsigned)SolS[(16 * q + 2 * e + 1) * 256 + dv] << 16);
                bf16_t* d = p.DUt + (size_t)u * 8192 + dv * 64 + 16 * q;
                *(u32x4*)d = (u32x4){w[0], w[1], w[2], w[3]}; *(u32x4*)(d + 8) = (u32x4){w[4], w[5], w[6], w[7]};
#pragma unroll
                for (int k = 0; k < 2; ++k) { const int c = tid + NTHREADS * k, row = c >> 4, part = c & 15;
                    *(u32x4*)(p.DW + (size_t)u * 8192 + row * 128 + part * 8) = *(const LAS u32x4*)(SolS + row * 256 + 128 + part * 8); }
            }
            __syncthreads();
        }
    }
    for (int v = ((int)blockIdx.x - NU3 % (int)gridDim.x + (int)gridDim.x) % (int)gridDim.x; v < NS * 8; v += gridDim.x) {
        const int tid = ltid();
        {
            const int s = v >> 3, h = v & 7; const size_t row = (size_t)NTOK + s;
            LAS float* qv = (LAS float*)smem; LAS float* kv = qv + 128; LAS float* red = kv + 128;
            LAS float* dl = red + 1024;
            if (tid < 128) { qv[tid] = bf2f(p.QKVN[row * DNQKV + h * 128 + tid]) * 0.08838834764831845f; kv[tid] = bf2f(p.QKVN[row * DNQKV + 1024 + h * 128 + tid]); }
            __syncthreads();
            const int dv = tid & 127, qd = tid >> 7;
            const float* S0 = p.in[4] + ((size_t)(s * 8 + h) * 128) * 128;
            float sreg[32]; float ks_ = 0.f, qs_ = 0.f;
#pragma unroll
            for (int k = 0; k < 32; ++k) { const int dk = qd * 32 + k; sreg[k] = S0[(size_t)dk * 128 + dv]; ks_ += kv[dk] * sreg[k]; qs_ += qv[dk] * sreg[k]; }
            red[(qd * 128 + dv) * 2] = ks_; red[(qd * 128 + dv) * 2 + 1] = qs_;
            __syncthreads();
            const float beta = p.BG[row * 16 + h], eg = __expf(p.BG[row * 16 + 8 + h]);
            if (tid < 128) {
                float kS = 0.f, qS = 0.f, qk = 0.f;
#pragma unroll
                for (int q = 0; q < 4; ++q) { kS += red[(q * 128 + dv) * 2]; qS += red[(q * 128 + dv) * 2 + 1]; }
                for (int k = 0; k < 128; ++k) qk += qv[k] * kv[k];
                const float vv = bf2f(p.QKVN[row * DNQKV + 2048 + h * 128 + dv]);
                const float delta = beta * (vv - eg * kS);
                p.ORAW[row * 1024 + h * 128 + dv] = eg * qS + qk * delta;
                dl[dv] = delta;
            }
            __syncthreads();
            const float delta = dl[dv];
            float* Sout = p.out + O_SDS + ((size_t)(s * 8 + h) * 128) * 128;
#pragma unroll
            for (int k = 0; k < 32; ++k) { const int dk = qd * 32 + k; Sout[(size_t)dk * 128 + dv] = sreg[k] * eg + kv[dk] * delta; }
            __syncthreads();
        }
    }
}

__device__ __forceinline__ void ph_dn_seq(const P& p, LAS char* smem) {
    constexpr int SP = 136, DP = 72;
    LAS bf16_t* St = (LAS bf16_t*)smem;
    LAS bf16_t* Dt = St + 32 * SP;
    const int tid = ltid(), lane = tid & 63, wid = tid >> 6, li = lane & 15, lg = lane >> 4;
    const int rt = wid >> 1, dt = wid & 1;
    for (int u0 = blockIdx.x; u0 < NB * 8 * 4; u0 += gridDim.x) {
        const int u = (gridDim.x == 256) ? (((u0 & 7) * 8 + (u0 >> 5)) * 4 + ((u0 >> 3) & 3)) : u0;
        const int b = u >> 5, h = (u >> 2) & 7, ds = u & 3;
        f32x4 sacc[2] = {{0.f, 0.f, 0.f, 0.f}, {0.f, 0.f, 0.f, 0.f}};
#pragma unroll
        for (int kk = 0; kk < 2; ++kk) { const int kt = 2 * rt + kk; *(LAS u32x2*)(St + (16 * dt + li) * SP + 16 * kt + 4 * lg) = (u32x2){0u, 0u}; }
        __syncthreads();
        bf16x8 wf[4], qf[4], af[2], kf[2][2], nwf[4], nqf[4], naf[2], nkf[2][2]; u32x2 uu, nuu; float eg, neg;
        auto fetch = [&](int c) {
            const size_t u3 = (size_t)(b * NCHUNK + c) * 8 + h;
            const bf16_t* Wp = p.DW + u3 * 8192 + (16 * rt + li) * 128 + 8 * lg;
            const bf16_t* Qp = p.DQD + u3 * 8192 + (16 * rt + li) * 128 + 8 * lg;
            const bf16_t* Ap = p.DATT + u3 * 4096 + (16 * rt + li) * 64 + 8 * lg;
            const bf16_t* Kp = p.DKDt + u3 * 8192 + (16 * (2 * rt) + li) * 64 + 8 * lg;
#pragma unroll
            for (int ks = 0; ks < 4; ++ks) { nwf[ks] = *(const bf16x8*)(Wp + 32 * ks); nqf[ks] = *(const bf16x8*)(Qp + 32 * ks); }
#pragma unroll
            for (int s2 = 0; s2 < 2; ++s2) { naf[s2] = *(const bf16x8*)(Ap + 32 * s2); nkf[0][s2] = *(const bf16x8*)(Kp + 32 * s2); nkf[1][s2] = *(const bf16x8*)(Kp + 16 * 64 + 32 * s2); }
            nuu = *(const u32x2*)(p.DUt + u3 * 8192 + (32 * ds + 16 * dt + li) * 64 + 16 * rt + 4 * lg);
            neg = __expf(p.DGL[u3]);
        };
        fetch(0);
#pragma unroll 1
        for (int c = 0; c < NCHUNK; ++c) {
#pragma unroll
            for (int ks = 0; ks < 4; ++ks) { wf[ks] = nwf[ks]; qf[ks] = nqf[ks]; }
#pragma unroll
            for (int s2 = 0; s2 < 2; ++s2) { af[s2] = naf[s2]; kf[0][s2] = nkf[0][s2]; kf[1][s2] = nkf[1][s2]; }
            uu = nuu; eg = neg;
            if (c + 1 < NCHUNK) fetch(c + 1);
            f32x4 dacc = {0.f, 0.f, 0.f, 0.f}, oacc = {0.f, 0.f, 0.f, 0.f};
#pragma unroll
            for (int ks = 0; ks < 4; ++ks) { const bf16x8 sf = *(const LAS bf16x8*)(St + (16 * dt + li) * SP + 32 * ks + 8 * lg); dacc = mfma16(wf[ks], sf, dacc); oacc = mfma16(qf[ks], sf, oacc); }
            const float d0 = bflo(uu.x) - dacc[0], d1 = bfhi(uu.x) - dacc[1], d2 = bflo(uu.y) - dacc[2], d3 = bfhi(uu.y) - dacc[3];
            *(LAS u32x2*)(Dt + (16 * dt + li) * DP + 16 * rt + 4 * lg) = (u32x2){cvt_pk(d0, d1), cvt_pk(d2, d3)};
            __syncthreads();
            bf16x8 df[2];
#pragma unroll
            for (int s2 = 0; s2 < 2; ++s2) df[s2] = *(const LAS bf16x8*)(Dt + (16 * dt + li) * DP + 32 * s2 + 8 * lg);
#pragma unroll
            for (int s2 = 0; s2 < 2; ++s2) oacc = mfma16(af[s2], df[s2], oacc);
#pragma unroll
            for (int kk = 0; kk < 2; ++kk) { sacc[kk] *= eg;
#pragma unroll
                for (int s2 = 0; s2 < 2; ++s2) sacc[kk] = mfma16(kf[kk][s2], df[s2], sacc[kk]); }
            {
                const int nvalid = (c == 0) ? 16 : 64, tbase = (c == 0) ? 0 : 16 + 64 * (c - 1);
#pragma unroll
                for (int r = 0; r < 4; ++r) { const int i = 16 * rt + 4 * lg + r; if (i < nvalid) p.ORAW[((size_t)b * LP + tbase + i) * 1024 + h * 128 + 32 * ds + 16 * dt + li] = oacc[r]; }
            }
#pragma unroll
            for (int kk = 0; kk < 2; ++kk) { const int kt = 2 * rt + kk; *(LAS u32x2*)(St + (16 * dt + li) * SP + 16 * kt + 4 * lg) = (u32x2){cvt_pk(sacc[kk][0], sacc[kk][1]), cvt_pk(sacc[kk][2], sacc[kk][3])}; }
            __syncthreads();
        }
        float* So = p.out + O_PDS + ((size_t)(b * 8 + h) * 128) * 128;
#pragma unroll
        for (int kk = 0; kk < 2; ++kk)
#pragma unroll
            for (int r = 0; r < 4; ++r) So[(size_t)(16 * (2 * rt + kk) + 4 * lg + r) * 128 + 32 * ds + 16 * dt + li] = sacc[kk][r];
    }
}

__device__ __forceinline__ void ph_dn_onorm(const P& p) {
    const int tid = ltid(), lane = tid & 63, wid = tid >> 6; const float* ng = p.in[26];
    for (int row = blockIdx.x * 8 + wid; row < NTOK + NS; row += gridDim.x * 8) {
#pragma unroll
        for (int it = 0; it < 2; ++it) {
            const int c0 = it * 512 + lane * 8, dv0 = c0 & 127;
            const float4 a = *(const float4*)(p.ORAW + (size_t)row * 1024 + c0), bq = *(const float4*)(p.ORAW + (size_t)row * 1024 + c0 + 4);
            float o[8] = {a.x, a.y, a.z, a.w, bq.x, bq.y, bq.z, bq.w}; float ss = 0.f;
#pragma unroll
            for (int e = 0; e < 8; ++e) ss += o[e] * o[e];
            ss += __shfl_xor(ss, 1); ss += __shfl_xor(ss, 2); ss += __shfl_xor(ss, 4); ss += __shfl_xor(ss, 8);
            const float r = rsqrtf(ss * (1.0f / 128.0f) + RMS_EPS);
            const u32x4 zw = *(const u32x4*)(p.PROJ + (size_t)row * DNPROJP + DNQKV + c0);
            float y[8];
#pragma unroll
            for (int e = 0; e < 4; ++e) { y[2 * e] = o[2 * e] * r * ng[dv0 + 2 * e] * siluf_(bflo(zw[e])); y[2 * e + 1] = o[2 * e + 1] * r * ng[dv0 + 2 * e + 1] * siluf_(bfhi(zw[e])); }
            u32x4 w; w.x = cvt_pk(y[0], y[1]); w.y = cvt_pk(y[2], y[3]); w.z = cvt_pk(y[4], y[5]); w.w = cvt_pk(y[6], y[7]);
            *(u32x4*)(p.ON + (size_t)row * 1024 + c0) = w;
        }
    }
}

__device__ __forceinline__ float rope_freq(int i) { return powf(10000.0f, -(float)i * (1.0f / 32.0f)); }
__device__ __forceinline__ void ph_mla_rows(const P& p) {
    const int tid = ltid(), lane = tid & 63, wid = tid >> 6; const float* qn = p.in[29]; const float* kn = p.in[32];
    for (int row = blockIdx.x * 8 + wid; row < MP; row += gridDim.x * 8) {
        if (row >= NTOK + NS) {
            const u32x4 z = {0u, 0u, 0u, 0u};
            *(u32x4*)(p.CQ + (size_t)row * 512 + lane * 8) = z; if (lane < 32) *(u32x4*)(p.CKVb + (size_t)row * 256 + lane * 8) = z; if (lane < 8) *(u32x4*)(p.KPEb + (size_t)row * 64 + lane * 8) = z;
            continue;
        }
        const float* src = p.DQKV + (size_t)row * 1024;
        {
            const float4 a = *(const float4*)(src + 4 * lane), bq = *(const float4*)(src + 256 + 4 * lane);
            float ss = a.x * a.x + a.y * a.y + a.z * a.z + a.w * a.w + bq.x * bq.x + bq.y * bq.y + bq.z * bq.z + bq.w * bq.w;
            ss = wave_sum(ss); const float r = rsqrtf(ss * (1.0f / 512.0f) + RMS_EPS);
            const float4 g0 = *(const float4*)(qn + 4 * lane), g1 = *(const float4*)(qn + 256 + 4 * lane);
            *(u32x2*)(p.CQ + (size_t)row * 512 + 4 * lane) = (u32x2){cvt_pk(a.x * r * g0.x, a.y * r * g0.y), cvt_pk(a.z * r * g0.z, a.w * r * g0.w)};
            *(u32x2*)(p.CQ + (size_t)row * 512 + 256 + 4 * lane) = (u32x2){cvt_pk(bq.x * r * g1.x, bq.y * r * g1.y), cvt_pk(bq.z * r * g1.z, bq.w * r * g1.w)};
        }
        const bool prompt = row < NTOK; const int b = prompt ? row / LP : 0, t = prompt ? row - b * LP : 0;
        {
            const float4 a = *(const float4*)(src + 512 + 4 * lane);
            float ss = a.x * a.x + a.y * a.y + a.z * a.z + a.w * a.w; ss = wave_sum(ss); const float r = rsqrtf(ss * (1.0f / 256.0f) + RMS_EPS);
            const float4 g0 = *(const float4*)(kn + 4 * lane); const float4 o = make_float4(a.x * r * g0.x, a.y * r * g0.y, a.z * r * g0.z, a.w * r * g0.w);
            float* dst = prompt ? p.out + O_PCKV + (size_t)row * 256 : p.out + O_SCKV + (size_t)(row - NTOK) * 256;
            *(float4*)(dst + 4 * lane) = o;
            *(u32x2*)(p.CKVb + (size_t)row * 256 + 4 * lane) = (u32x2){cvt_pk(o.x, o.y), cvt_pk(o.z, o.w)};
        }
        if (lane < 32) {
            const float x1 = src[768 + lane], x2 = src[800 + lane]; const float pos = prompt ? (float)t : 16384.0f;
            float sn, cs; sincosf(pos * rope_freq(lane), &sn, &cs);
            const float o1 = x1 * cs - x2 * sn, o2 = x1 * sn + x2 * cs;
            float* dst = prompt ? p.out + O_PKPE + (size_t)row * 64 : p.out + O_SKPE + (size_t)(row - NTOK) * 64;
            dst[lane] = o1; dst[32 + lane] = o2;
            p.KPEb[(size_t)row * 64 + lane] = (bf16_t)(cvt_pk(o1, 0.f) & 0xffffu); p.KPEb[(size_t)row * 64 + 32 + lane] = (bf16_t)(cvt_pk(o2, 0.f) & 0xffffu);
        }
    }
}

__device__ __forceinline__ void ph_mla_qlat(const P& p, LAS char* smem) {
    LAS float* Qn = (LAS float*)smem;
    const int tid = ltid(); const float* wuk = p.in[33];
    for (int u = blockIdx.x; u < 32; u += gridDim.x) {
        const int h = u >> 2, cq = u & 3;
        for (int i = tid; i < 32 * 128; i += NTHREADS) { const int s = i >> 7, n = i & 127; Qn[i] = bf2f(p.Q[((size_t)NTOK + s) * 1536 + h * 192 + n]); }
        __syncthreads();
        const int c = cq * 64 + (tid & 63), bg = tid >> 6; float acc[4] = {0.f, 0.f, 0.f, 0.f};
        const float* wr = wuk + (size_t)c * 1024 + h * 128;
#pragma unroll 8
        for (int n4 = 0; n4 < 32; ++n4) { const float4 w = *(const float4*)(wr + 4 * n4);
#pragma unroll
            for (int r = 0; r < 4; ++r) { const LAS float* qr = Qn + (bg * 4 + r) * 128 + 4 * n4; acc[r] += w.x * qr[0] + w.y * qr[1] + w.z * qr[2] + w.w * qr[3]; } }
#pragma unroll
        for (int r = 0; r < 4; ++r) p.QLAT[(size_t)(bg * 4 + r) * 2048 + h * 256 + c] = acc[r];
        if (cq == 0) {
            for (int i = tid; i < 32 * 32; i += NTHREADS) { const int s = i >> 5, d = i & 31; const bf16_t* q = p.Q + ((size_t)NTOK + s) * 1536 + h * 192 + 128;
                const float x1 = bf2f(q[d]), x2 = bf2f(q[32 + d]); float sn, cs; sincosf(16384.0f * rope_freq(d), &sn, &cs);
                p.QPE[(size_t)s * 512 + h * 64 + d] = x1 * cs - x2 * sn; p.QPE[(size_t)s * 512 + h * 64 + 32 + d] = x1 * sn + x2 * cs; }
        }
        __syncthreads();
    }
}

template <int N>
__device__ __forceinline__ void tr_step(float (&v)[32], int lane, int mask) {
    const bool up = (lane & mask) != 0;
#pragma unroll
    for (int i = 0; i < N; ++i) { const float send = up ? v[i] : v[i + N]; const float keep = up ? v[i + N] : v[i]; v[i] = keep + __shfl_xor(send, mask); }
}
__device__ __forceinline__ float readlane_f(float v, int l) { return __int_as_float(__builtin_amdgcn_readlane(__float_as_int(v), l)); }
__device__ __forceinline__ void ph_mla_decode(const P& p, LAS char* smem) {
    LAS float* Om = (LAS float*)smem;
    LAS float* MLs = Om + 8 * 8 * 256;
    const int tid = ltid(), lane = tid & 63, wid = tid >> 6;
    const int* pt = (const int*)p.in[8]; const float* pool_c = p.in[6]; const float* pool_k = p.in[7];
    const float sc = MLA_SCALE * LOG2E;
    for (int u = blockIdx.x; u < NS * 8; u += gridDim.x) {
        const int bq = u >> 3, sp = u & 7;
        f32x2 qlp[4][4], qpp[4];
#pragma unroll
        for (int hp = 0; hp < 4; ++hp) { const float4 a = *(const float4*)(p.QLAT + (size_t)bq * 2048 + (2 * hp) * 256 + 4 * lane), b4 = *(const float4*)(p.QLAT + (size_t)bq * 2048 + (2 * hp + 1) * 256 + 4 * lane);
            qlp[hp][0] = (f32x2){a.x, b4.x}; qlp[hp][1] = (f32x2){a.y, b4.y}; qlp[hp][2] = (f32x2){a.z, b4.z}; qlp[hp][3] = (f32x2){a.w, b4.w};
            qpp[hp] = (f32x2){p.QPE[(size_t)bq * 512 + (2 * hp) * 64 + lane], p.QPE[(size_t)bq * 512 + (2 * hp + 1) * 64 + lane]}; }
        f32x2 O2[8][2];
#pragma unroll
        for (int h = 0; h < 8; ++h) { O2[h][0] = (f32x2){0.f, 0.f}; O2[h][1] = (f32x2){0.f, 0.f}; }
        float m_run = -INFINITY, l_run = 0.f;
        const int pg0 = pt[bq * 128 + sp * 16 + 2 * wid], pg1 = pt[bq * 128 + sp * 16 + 2 * wid + 1];
        float4 cn[4]; float en[4];
        {   const float* cb = pool_c + (size_t)pg0 * 128 * 256; const float* kb = pool_k + (size_t)pg0 * 128 * 64;
#pragma unroll
            for (int k = 0; k < 4; ++k) { cn[k] = *(const float4*)(cb + k * 256 + 4 * lane); en[k] = kb[k * 64 + lane]; } }
        for (int it = 0; it < 64; ++it) {
            float4 c[4]; float e[4];
#pragma unroll
            for (int k = 0; k < 4; ++k) { c[k] = cn[k]; e[k] = en[k]; }
            if (it + 1 < 64) { const int nit = it + 1, pg = (nit < 32) ? pg0 : pg1, kb4 = (nit & 31) * 4;
                const float* cb = pool_c + ((size_t)pg * 128 + kb4) * 256; const float* kb = pool_k + ((size_t)pg * 128 + kb4) * 64;
#pragma unroll
                for (int k = 0; k < 4; ++k) { cn[k] = *(const float4*)(cb + k * 256 + 4 * lane); en[k] = kb[k * 64 + lane]; } }
            float part[32];
#pragma unroll
            for (int k = 0; k < 4; ++k)
#pragma unroll
                for (int hp = 0; hp < 4; ++hp) { const f32x2 t2 = qlp[hp][0] * c[k].x + qlp[hp][1] * c[k].y + qlp[hp][2] * c[k].z + qlp[hp][3] * c[k].w + qpp[hp] * e[k];
                    part[k * 8 + 2 * hp] = t2.x; part[k * 8 + 2 * hp + 1] = t2.y; }
#pragma unroll
            for (int i = 0; i < 16; ++i) { swap32(part[i], part[i + 16]); part[i] += part[i + 16]; }
#pragma unroll
            for (int i = 0; i < 8; ++i) { swap16(part[i], part[i + 8]); part[i] += part[i + 8]; }
            tr_step<4>(part, lane, 8); tr_step<2>(part, lane, 4); tr_step<1>(part, lane, 2);
            float s = (part[0] + __shfl_xor(part[0], 1)) * sc;
            float m4 = max_x32(max_x16(s));
            const float m_new = fmaxf(m_run, m4), alpha = __builtin_amdgcn_exp2f(m_run - m_new), pr = __builtin_amdgcn_exp2f(s - m_new);
            const float ps = sum_x32(sum_x16(pr));
            l_run = l_run * alpha + ps; m_run = m_new;
#pragma unroll
            for (int h = 0; h < 8; ++h) {
                const float al = readlane_f(alpha, 2 * h);
                f32x2 o0 = O2[h][0] * al, o1 = O2[h][1] * al;
#pragma unroll
                for (int k = 0; k < 4; ++k) { const float pk = readlane_f(pr, 16 * k + 2 * h); o0 += (f32x2){c[k].x, c[k].y} * pk; o1 += (f32x2){c[k].z, c[k].w} * pk; }
                O2[h][0] = o0; O2[h][1] = o1;
            }
        }
#pragma unroll
        for (int h = 0; h < 8; ++h) *(LAS f32x4*)(Om + (wid * 8 + h) * 256 + 4 * lane) = (f32x4){O2[h][0].x, O2[h][0].y, O2[h][1].x, O2[h][1].y};
        if (lane < 16 && (lane & 1) == 0) { MLs[(wid * 8 + (lane >> 1)) * 2] = m_run; MLs[(wid * 8 + (lane >> 1)) * 2 + 1] = l_run; }
        __syncthreads();
#pragma unroll
        for (int i = 0; i < 4; ++i) { const int idx = tid + NTHREADS * i, h = idx >> 8, c = idx & 255;
            float M = -INFINITY;
#pragma unroll
            for (int w = 0; w < 8; ++w) M = fmaxf(M, MLs[(w * 8 + h) * 2]);
            float val = 0.f, L = 0.f;
#pragma unroll
            for (int w = 0; w < 8; ++w) { const float f = __builtin_amdgcn_exp2f(MLs[(w * 8 + h) * 2] - M); val += f * Om[(w * 8 + h) * 256 + c]; L += f * MLs[(w * 8 + h) * 2 + 1]; }
            p.PART[((size_t)(bq * 8 + sp) * 8 + h) * 256 + c] = val;
            if (c == 0) { p.ML[((size_t)(bq * 8 + sp) * 8 + h) * 2] = M; p.ML[((size_t)(bq * 8 + sp) * 8 + h) * 2 + 1] = L; }
        }
        __syncthreads();
    }
}

__device__ __forceinline__ void ph_mla_combine(const P& p, LAS char* smem) {
    LAS float* OL = (LAS float*)smem;
    const int tid = ltid(), lane = tid & 63, wid = tid >> 6; const float sc = MLA_SCALE * LOG2E;
    for (int bq = blockIdx.x; bq < NS; bq += gridDim.x) {
        const int h = wid;
        const float4 cnew = *(const float4*)(p.out + O_SCKV + (size_t)bq * 256 + 4 * lane); const float knew = p.out[O_SKPE + (size_t)bq * 64 + lane];
        const float4 ql = *(const float4*)(p.QLAT + (size_t)bq * 2048 + h * 256 + 4 * lane); const float qp = p.QPE[(size_t)bq * 512 + h * 64 + lane];
        float ss = cnew.x * ql.x + cnew.y * ql.y + cnew.z * ql.z + cnew.w * ql.w + knew * qp; ss = wave_sum(ss) * sc;
        float M = ss;
#pragma unroll
        for (int s = 0; s < 8; ++s) M = fmaxf(M, p.ML[((size_t)(bq * 8 + s) * 8 + h) * 2]);
        const float fs = __builtin_amdgcn_exp2f(ss - M); float L = fs; float4 o = make_float4(fs * cnew.x, fs * cnew.y, fs * cnew.z, fs * cnew.w);
#pragma unroll
        for (int s = 0; s < 8; ++s) { const float f = __builtin_amdgcn_exp2f(p.ML[((size_t)(bq * 8 + s) * 8 + h) * 2] - M); L += f * p.ML[((size_t)(bq * 8 + s) * 8 + h) * 2 + 1];
            const float4 pv = *(const float4*)(p.PART + ((size_t)(bq * 8 + s) * 8 + h) * 256 + 4 * lane); o.x += f * pv.x; o.y += f * pv.y; o.z += f * pv.z; o.w += f * pv.w; }
        const float inv = 1.0f / L;
        *(LAS f32x4*)(OL + h * 256 + 4 * lane) = (f32x4){o.x * inv, o.y * inv, o.z * inv, o.w * inv};
        __syncthreads();
        const float* wuv = p.in[34];
#pragma unroll
        for (int i = 0; i < 2; ++i) { const int idx = tid + NTHREADS * i, hh = idx >> 7, v = idx & 127; float acc = 0.f;
#pragma unroll 16
            for (int c = 0; c < 256; ++c) acc += OL[hh * 256 + c] * wuv[(size_t)c * 1024 + hh * 128 + v];
            p.AO[((size_t)NTOK + bq) * 1024 + hh * 128 + v] = (bf16_t)(cvt_pk(acc, 0.f) & 0xffffu); }
        __syncthreads();
    }
}

__device__ __forceinline__ void ph_mla_attn(const P& p, LAS char* smem) {
    constexpr int KP = 200, VP = 144;
    constexpr int KT_BYTES = 64 * KP * 2, VT_BYTES = 64 * VP * 2, STG = KT_BYTES + VT_BYTES;
    const int tid = ltid(), lane = tid & 63, wid = tid >> 6, li = lane & 15, lg = lane >> 4;
    const int G = gridDim.x; const float sc = MLA_SCALE * LOG2E;
    constexpr int NQB = 9, NUNITS = NB * 8 * NQB;
    for (int j = 0;; ++j) {
        const int idx = j * G + ((j & 1) ? (G - 1 - (int)blockIdx.x) : (int)blockIdx.x);
        if (j * G >= NUNITS) break;
        if (idx >= NUNITS) continue;
        const int qb = (NQB - 1) - idx / 64, bh = idx & 63, b = bh >> 3, h = bh & 7;
        const int t0 = qb * 256, nq = (LP - t0) < 256 ? (LP - t0) : 256, kend = t0 + nq, nkt = (kend + 63) >> 6;
        const int tq0 = t0 + 32 * wid + li;
        bf16x8 qf[2][6];
#pragma unroll
        for (int rt = 0; rt < 2; ++rt) { const int tq = tq0 + 16 * rt, tqc = tq < LP ? tq : LP - 1;
            const bf16_t* qsrc = p.Q + ((size_t)b * LP + tqc) * 1536 + h * 192 + 8 * lg;
#pragma unroll
            for (int ks = 0; ks < 6; ++ks) qf[rt][ks] = *(const bf16x8*)(qsrc + 32 * ks);
#pragma unroll
            for (int e = 0; e < 8; ++e) { const float x1 = bf2f((unsigned short)qf[rt][4][e]), x2 = bf2f((unsigned short)qf[rt][5][e]);
                const float ang_ = (float)tqc * __builtin_amdgcn_exp2f(-0.41524101186092033f * (float)(8 * lg + e)); const float sn = __sinf(ang_), cs = __cosf(ang_);
                qf[rt][4][e] = (short)(cvt_pk(x1 * cs - x2 * sn, 0.f) & 0xffffu); qf[rt][5][e] = (short)(cvt_pk(x1 * sn + x2 * cs, 0.f) & 0xffffu); } }
        f32x4 oacc[2][8];
#pragma unroll
        for (int rt = 0; rt < 2; ++rt)
#pragma unroll
            for (int ct = 0; ct < 8; ++ct) oacc[rt][ct] = (f32x4){0.f, 0.f, 0.f, 0.f};
        float m_run[2] = {-INFINITY, -INFINITY}, l_run[2] = {0.f, 0.f};
        u32x4 rgA[5];
        auto gload = [&](int kt, u32x4 (&rg)[5]) {
            int tl = tid; asm volatile("" : "+v"(tl));
#pragma unroll
            for (int i = 0; i < 5; ++i) { const int c = tl + NTHREADS * i; int key, part; const bf16_t* src;
                if (c < 1024) { key = c >> 4; part = c & 15; } else if (c < 1536) { key = (c - 1024) >> 3; part = (c - 1024) & 7; } else { key = (c - 1536) >> 4; part = (c - 1536) & 15; }
                int kr = kt * 64 + key; kr = kr < LP ? kr : LP - 1; const size_t grow = (size_t)b * LP + kr;
                if (c < 1024) src = p.KV + grow * 2048 + h * 128 + part * 8; else if (c < 1536) src = p.KPEb + grow * 64 + part * 8; else src = p.KV + grow * 2048 + 1024 + h * 128 + part * 8;
                rg[i] = *(const u32x4*)src; } };
        auto sstore = [&](int st, const u32x4 (&rg)[5]) {
            LAS bf16_t* Kt = (LAS bf16_t*)(smem + st * STG); LAS bf16_t* Vt = (LAS bf16_t*)(smem + st * STG + KT_BYTES);
            int tl = tid; asm volatile("" : "+v"(tl));
#pragma unroll
            for (int i = 0; i < 5; ++i) { const int c = tl + NTHREADS * i;
                if (c < 1024) *(LAS u32x4*)(Kt + (c >> 4) * KP + (c & 15) * 8) = rg[i];
                else if (c < 1536) *(LAS u32x4*)(Kt + ((c - 1024) >> 3) * KP + 128 + ((c - 1024) & 7) * 8) = rg[i];
                else *(LAS u32x4*)(Vt + ((c - 1536) >> 4) * VP + ((c - 1536) & 15) * 8) = rg[i]; } };
        auto compute = [&](int kt, int st) {
            if (kt * 64 > t0 + 32 * wid + 31) return;
            const LAS bf16_t* Kt = (const LAS bf16_t*)(smem + st * STG); const LAS bf16_t* Vt = (const LAS bf16_t*)(smem + st * STG + KT_BYTES);
            f32x4 sacc[2][4];
#pragma unroll
            for (int rt = 0; rt < 2; ++rt)
#pragma unroll
                for (int k4 = 0; k4 < 4; ++k4) sacc[rt][k4] = (f32x4){0.f, 0.f, 0.f, 0.f};
#pragma unroll
            for (int ks = 0; ks < 6; ++ks)
#pragma unroll
                for (int k4 = 0; k4 < 4; ++k4) { const bf16x8 kf = *(const LAS bf16x8*)(Kt + (16 * k4 + li) * KP + 32 * ks + 8 * lg);
                    sacc[0][k4] = mfma16(kf, qf[0][ks], sacc[0][k4]); sacc[1][k4] = mfma16(kf, qf[1][ks], sacc[1][k4]);
                    if (k4 == 3 && (ks & 1)) asm volatile("" ::: "memory"); }
            bf16x8 pf[2][2];
#pragma unroll
            for (int rt = 0; rt < 2; ++rt) {
                const int tq = tq0 + 16 * rt;
                const bool diag = kt * 64 + 63 > t0 + 32 * wid + 16 * rt;
                float mx = -INFINITY;
                if (diag) {
#pragma unroll
                    for (int k4 = 0; k4 < 4; ++k4)
#pragma unroll
                        for (int r = 0; r < 4; ++r) { const int key = kt * 64 + 16 * k4 + 4 * lg + r; const float sv = (key <= tq) ? sacc[rt][k4][r] * sc : -INFINITY; sacc[rt][k4][r] = sv; mx = fmaxf(mx, sv); }
                } else {
#pragma unroll
                    for (int k4 = 0; k4 < 4; ++k4) { sacc[rt][k4] *= sc; mx = fmaxf(fmaxf(mx, fmaxf(sacc[rt][k4][0], sacc[rt][k4][1])), fmaxf(sacc[rt][k4][2], sacc[rt][k4][3])); }
                }
                mx = max_x32(max_x16(mx));
                const float m_new = fmaxf(m_run[rt], mx), alpha = __builtin_amdgcn_exp2f(m_run[rt] - m_new); float rs = 0.f;
#pragma unroll
                for (int k4 = 0; k4 < 4; ++k4)
#pragma unroll
                    for (int r = 0; r < 4; ++r) { const float pv = __builtin_amdgcn_exp2f(sacc[rt][k4][r] - m_new); sacc[rt][k4][r] = pv; rs += pv; }
                rs = sum_x32(sum_x16(rs));
                l_run[rt] = l_run[rt] * alpha + rs; m_run[rt] = m_new;
                if (__any(alpha != 1.0f)) {
#pragma unroll
                    for (int ct = 0; ct < 8; ++ct) oacc[rt][ct] *= alpha; }
#pragma unroll
                for (int s2 = 0; s2 < 2; ++s2) { const u32x4 w = {cvt_pk(sacc[rt][2 * s2][0], sacc[rt][2 * s2][1]), cvt_pk(sacc[rt][2 * s2][2], sacc[rt][2 * s2][3]), cvt_pk(sacc[rt][2 * s2 + 1][0], sacc[rt][2 * s2 + 1][1]), cvt_pk(sacc[rt][2 * s2 + 1][2], sacc[rt][2 * s2 + 1][3])};
                    pf[rt][s2] = __builtin_bit_cast(bf16x8, w); }
            }
#pragma unroll
            for (int ct = 0; ct < 8; ++ct)
#pragma unroll
                for (int s2 = 0; s2 < 2; ++s2) {
                    const s16x4 lo = __builtin_amdgcn_ds_read_tr16_b64_v4i16((LAS s16x4*)(Vt + (32 * s2 + 4 * lg + (li >> 2)) * VP + 16 * ct + 4 * (li & 3)));
                    const s16x4 hi = __builtin_amdgcn_ds_read_tr16_b64_v4i16((LAS s16x4*)(Vt + (32 * s2 + 16 + 4 * lg + (li >> 2)) * VP + 16 * ct + 4 * (li & 3)));
                    const bf16x8 vf = {lo[0], lo[1], lo[2], lo[3], hi[0], hi[1], hi[2], hi[3]};
                    oacc[0][ct] = mfma16(vf, pf[0][s2], oacc[0][ct]); oacc[1][ct] = mfma16(vf, pf[1][s2], oacc[1][ct]);
                    if (s2 == 1 && (ct & 1)) asm volatile("" ::: "memory");
                }
        };
        gload(0, rgA); sstore(0, rgA);
        __syncthreads();
#pragma unroll 1
        for (int kt = 0; kt < nkt; ++kt) {
            const int st = kt & 1;
            if (kt + 1 < nkt) gload(kt + 1, rgA);
            compute(kt, st);
            if (kt + 1 < nkt) sstore(st ^ 1, rgA);
            __syncthreads();
        }
#pragma unroll
        for (int rt = 0; rt < 2; ++rt) { const int tq = tq0 + 16 * rt;
            if (tq < LP) { const float inv = 1.0f / l_run[rt]; bf16_t* dst = p.AO + ((size_t)b * LP + tq) * 1024 + h * 128 + 4 * lg;
#pragma unroll
                for (int ct = 0; ct < 8; ++ct) *(u32x2*)(dst + 16 * ct) = (u32x2){cvt_pk(oacc[rt][ct][0] * inv, oacc[rt][ct][1] * inv), cvt_pk(oacc[rt][ct][2] * inv, oacc[rt][ct][3] * inv)}; } }
    }
}

constexpr int NPHASES = 43;
template <int PH>
__device__ __forceinline__ void run_phase(const LAS PG* pl, LAS char* smem) {
    const P p = glob(pl);
    if constexpr (PH == 0) { ph_init(p, smem); return; }
    if constexpr (PH == 42) {
        ph_final_norm(p);
        return; }
    constexpr int layer = PH <= 10 ? 0 : PH <= 20 ? 1 : PH <= 31 ? 2 : 3;
    constexpr int base = layer == 0 ? 1 : layer == 1 ? 11 : layer == 2 ? 21 : 32;
    constexpr int sub = PH - base;
    constexpr int nmix = layer == 2 ? 8 : 7;
    if constexpr (sub == 0 || sub == nmix) return;
    if constexpr (sub == nmix + 1) { norm_gemm(p, p.Wgu + (size_t)layer * 5632 * 1024, 5632, 2 * layer + 1, EpiGU{uni(p.HF)}, smem); return; }
    if constexpr (sub == nmix + 2) { resid_gemm(p, p.HF, p.Wdown + (size_t)layer * 1024 * DFF, DFF, layer < 3 ? 2 * layer + 2 : -1, smem); return; }
    if constexpr (layer == 0 || layer == 3) {
        constexpr int J = layer == 0 ? 0 : 1;
        if constexpr (sub == 1) { norm_gemm(p, p.Wlru_in + (size_t)J * 2048 * 1024, 2048, 2 * layer, EpiLruIn{uni(p.G1)}, smem); }
        if constexpr (sub == 2) ph_lru_conv<J>(p);
        if constexpr (sub == 3) {
            const bf16_t* A = uni((const bf16_t*)p.XC); const bf16_t* Bt = uni((const bf16_t*)(p.Wlru_gate + (size_t)J * 2048 * 256));
            const EpiGate e{uni(p.RI), uni((const float*)p.BCAT) + J * 2048};
            pg8::Gemm g{A, Bt, 4 * MP, 2048, 256}; GateOrder S{(int)gridDim.x, (int)blockIdx.x};
            PgEpiGate pe{e};
            pg8::gemm_phase<PgEpiGate, GateOrder, true, true>((LAS unsigned char*)smem, g, S, pe);
            __syncthreads();
            gemm_small<false>(A, 256, Bt, 256, 2048, MMAIN, 3, 1, e, smem, nullptr, 512); }
        if constexpr (sub == 4) ph_scan1<J>(p);
        if constexpr (sub == 5) ph_scan2<J>(p);
        if constexpr (sub == 6) { resid_gemm(p, p.HG, p.Wlru_out + (size_t)J * 1048576, 1024, 2 * layer + 1, smem); }
    }
    if constexpr (layer == 1) {
        if constexpr (sub == 1) { norm_gemm(p, p.Wdn_in, DNPROJP, 2 * layer, EpiDnIn{uni(p.PROJ), uni(p.BA)}, smem); }
        if constexpr (sub == 2) ph_dn_conv(p);
        if constexpr (sub == 3) ph_dn_chunk(p, smem);
        if constexpr (sub == 4) ph_dn_seq(p, smem);
        if constexpr (sub == 5) ph_dn_onorm(p);
        if constexpr (sub == 6) { resid_gemm(p, p.ON, p.Wdn_out, 1024, 2 * layer + 1, smem); }
    }
    if constexpr (layer == 2) {
        if constexpr (sub == 1) { norm_gemm(p, p.Wmla_d, 1024, 2 * layer, EpiF32{uni(p.DQKV), 1024}, smem); }
        if constexpr (sub == 2) ph_mla_rows(p);
        if constexpr (sub == 3) { big_gemm(p.CQ, p.Wmla_uq, 1536, 512, EpiBf16{uni(p.Q), 1536}, smem); __syncthreads();
                                  big_gemm(p.CKVb, p.Wmla_kvup, 2048, 256, EpiBf16{uni(p.KV), 2048}, smem); }
        if constexpr (sub == 4) ph_mla_qlat(p, smem);
        if constexpr (sub == 5) { ph_mla_decode(p, smem);
            ph_mla_attn(p, smem); }
        if constexpr (sub == 6) ph_mla_combine(p, smem);
        if constexpr (sub == 7) { resid_gemm(p, p.AO, p.Wmla_o, 1024, 2 * layer + 1, smem); }
    }
}

extern __shared__ __attribute__((aligned(16))) char smem_raw[];

constexpr bool phase_active(int ph) {
    if (ph == 0 || ph == 42) return true;
    const int layer = ph <= 10 ? 0 : ph <= 20 ? 1 : ph <= 31 ? 2 : 3, base = layer == 0 ? 1 : layer == 1 ? 11 : layer == 2 ? 21 : 32, sub = ph - base, nmix = layer == 2 ? 8 : 7;
    return !(sub == 0 || sub == nmix);
}
template <int PH>
__device__ __forceinline__ void run_all(const LAS PG* p, LAS char* smem, const XcdBarrier& bar) {
    if constexpr (phase_active(PH)) { run_phase<PH>(p, smem); if constexpr (PH + 1 < NPHASES) xcd_barrier(bar); }
    if constexpr (PH + 1 < NPHASES) run_all<PH + 1>(p, smem, bar);
}
__global__ void __launch_bounds__(NTHREADS, 2) k_mega(P p) {
    LAS char* smem = (LAS char*)smem_raw;
    LAS unsigned long long* lp = (LAS unsigned long long*)(smem + LDS_BYTES - 2048);
    { const unsigned long long* src = (const unsigned long long*)&p; for (int i = threadIdx.x; i < (int)(sizeof(P) / 8); i += NTHREADS) lp[i] = src[i]; }
    LAS unsigned* xbw = (LAS unsigned*)(smem + LDS_BYTES - 16);
    if (threadIdx.x == 0) { xbw[0] = 0u; xbw[1] = 0u; xbw[2] = 0u; xbw[3] = 0u; }
    __syncthreads();
    const LAS PG* q = (const LAS PG*)lp;
    XcdBarrier bar = xcd_barrier_post((unsigned*)q->bar, (volatile LAS unsigned*)xbw);
    run_all<0>(q, smem, bar);
}

extern "C" void kernel_launch(void* const* d_in, const int* in_sizes, int n_in, void* d_out, int out_size, void* d_ws, size_t ws_size, hipStream_t stream) {
    (void)in_sizes; (void)n_in; (void)out_size;
    P p{};
    for (int i = 0; i < 38; ++i) p.in[i] = (const float*)d_in[i];
    p.out = (float*)d_out;
    char* w = (char*)d_ws; size_t off = 0;
    auto take = [&](size_t bytes) { void* r = w + off; off += (bytes + 255) & ~(size_t)255; return r; };
    p.bar = (unsigned*)take(XCD_BAR_WORDS * 4);
    p.X = (float*)take((size_t)MP * D * 4); p.H = (bf16_t*)take((size_t)MP * D * 2); p.SS = (float*)take((size_t)8 * MP * 16 * 4);
    p.G1 = (bf16_t*)take((size_t)MP * 2048 * 2); p.XC = (bf16_t*)take((size_t)MP * 1024 * 2); p.RI = (bf16_t*)take((size_t)MP * 2048 * 2); p.HG = (bf16_t*)take((size_t)MP * 1024 * 2);
    p.CP = (float*)take((size_t)NB * SCH * 1024 * 4); p.CH = (float*)take((size_t)NB * SCH * 1024 * 4); p.BCAT = (float*)take((size_t)2 * 2048 * 4);
    p.PROJ = (bf16_t*)take((size_t)MP * DNPROJP * 2); p.BA = (float*)take((size_t)MP * 16 * 4); p.BG = (float*)take((size_t)MP * 16 * 4); p.QKVN = (bf16_t*)take((size_t)MP * DNQKV * 2);
    const size_t nu3 = (size_t)NB * NCHUNK * 8;
    p.DW = (bf16_t*)take(nu3 * 8192 * 2); p.DUt = (bf16_t*)take(nu3 * 8192 * 2); p.DQD = (bf16_t*)take(nu3 * 8192 * 2); p.DKDt = (bf16_t*)take(nu3 * 8192 * 2); p.DATT = (bf16_t*)take(nu3 * 4096 * 2);
    p.DGL = (float*)take(nu3 * 4); p.ORAW = (float*)take((size_t)MP * 1024 * 4); p.ON = (bf16_t*)take((size_t)MP * 1024 * 2);
    p.DQKV = (float*)take((size_t)MP * 1024 * 4); p.CQ = (bf16_t*)take((size_t)MP * 512 * 2); p.CKVb = (bf16_t*)take((size_t)MP * 256 * 2); p.KPEb = (bf16_t*)take((size_t)MP * 64 * 2);
    p.Q = (bf16_t*)take((size_t)MP * 1536 * 2); p.KV = (bf16_t*)take((size_t)MP * 2048 * 2); p.AO = (bf16_t*)take((size_t)MP * 1024 * 2);
    p.QLAT = (float*)take((size_t)NS * 2048 * 4); p.QPE = (float*)take((size_t)NS * 512 * 4); p.PART = (float*)take((size_t)NS * 8 * 8 * 256 * 4); p.ML = (float*)take((size_t)NS * 8 * 8 * 2 * 4);
    p.HF = (bf16_t*)take((size_t)MP * DFF * 2);
    p.Wlru_in = (bf16_t*)take((size_t)2 * 2048 * 1024 * 2); p.Wlru_gate = (bf16_t*)take((size_t)2 * 2048 * 256 * 2); p.Wlru_out = (bf16_t*)take((size_t)2 * 1048576 * 2);
    p.Wdn_in = (bf16_t*)take((size_t)DNPROJP * 1024 * 2); p.Wdn_out = (bf16_t*)take((size_t)1048576 * 2);
    p.Wmla_d = (bf16_t*)take((size_t)1024 * 1024 * 2); p.Wmla_uq = (bf16_t*)take((size_t)1536 * 512 * 2); p.Wmla_kvup = (bf16_t*)take((size_t)2048 * 256 * 2); p.Wmla_o = (bf16_t*)take((size_t)1048576 * 2);
    p.Wgu = (bf16_t*)take((size_t)4 * 5632 * 1024 * 2); p.Wdown = (bf16_t*)take((size_t)4 * 1024 * DFF * 2);
    if (off > ws_size) return;
    static int grid = 0;
    if (!grid) { int dev = 0, cus = 0; (void)hipGetDevice(&dev); (void)hipDeviceGetAttribute(&cus, hipDeviceAttributeMultiprocessorCount, dev); grid = (cus > 0 && cus < 256) ? cus : 256; }
    static bool attr_done = false;
    if (!attr_done) { (void)hipFuncSetAttribute((const void*)k_mega, hipFuncAttributeMaxDynamicSharedMemorySize, LDS_BYTES); attr_done = true; }
    (void)hipMemsetAsync(p.bar, 0, XCD_BAR_WORDS * 4, stream);
    hipLaunchKernelGGL(k_mega, dim3(grid), dim3(NTHREADS), LDS_BYTES, stream, p);
}
```

```cpp
#include <hip/hip_runtime.h>
#include <stdint.h>
#include <stdio.h>
#include <type_traits>


#define LAS __attribute__((address_space(3)))
typedef unsigned short bf16_t;
typedef short bf16x8 __attribute__((ext_vector_type(8)));
typedef short s16x4 __attribute__((ext_vector_type(4)));
typedef float f32x4 __attribute__((ext_vector_type(4)));
typedef unsigned u32x2 __attribute__((ext_vector_type(2)));
typedef unsigned u32x4 __attribute__((ext_vector_type(4)));

constexpr int D = 1024, NB = 8, NMETA = 16, LP = 2064, NTOK = NB * LP  , NS = 32, MP = 16640, NPANEL = 65;
constexpr int DFF = 2816, DNQKV = 3072, DNPROJ = 4112, DNPROJP = 4352;
constexpr int NCHUNK = 33;
constexpr int SCH = 48, SCL = 43;
constexpr int NTHREADS = 512;
constexpr int MMAIN = 16384;
constexpr int LDS_BYTES = 135168;
constexpr float RMS_EPS = 1e-6f;
constexpr float LOG2E = 1.4426950408889634f;
constexpr float MLA_SCALE = 0.07216878364870322f;

constexpr size_t O_YP = 0, O_YS = 16777216, O_PLH = O_YS + 32768, O_PLC = O_PLH + 16384, O_PDS = O_PLC + 49152, O_PDC = O_PDS + 1048576,
                 O_PCKV = O_PDC + 73728, O_PKPE = O_PCKV + 4227072, O_SLH = O_PKPE + 1056768, O_SLC = O_SLH + 65536, O_SDS = O_SLC + 196608,
                 O_SDC = O_SDS + 4194304, O_SCKV = O_SDC + 294912, O_SKPE = O_SCKV + 8192;

struct P {
    const float* in[38];
    float* out;
    unsigned* bar;
    float* X; bf16_t* H; float* SS;
    bf16_t *G1, *XC, *RI, *HG; float *CP, *CH; float* BCAT;
    bf16_t* PROJ; float *BA, *BG; bf16_t* QKVN; bf16_t *DW, *DUt, *DQD, *DKDt, *DATT; float* DGL; float* ORAW; bf16_t* ON;
    float* DQKV; bf16_t *CQ, *CKVb, *KPEb, *Q, *KV, *AO; float *QLAT, *QPE, *PART, *ML;
    bf16_t* HF;
    bf16_t *Wlru_in, *Wlru_gate, *Wlru_out, *Wdn_in, *Wdn_out, *Wmla_d, *Wmla_uq, *Wmla_kvup, *Wmla_o, *Wgu, *Wdown;
};

#define GASP __attribute__((address_space(1)))
struct PG {
    GASP const float* in[38];
    GASP float* out;
    GASP unsigned* bar;
    GASP float* X; GASP bf16_t* H; GASP float* SS;
    GASP bf16_t *G1, *XC, *RI, *HG; GASP float *CP, *CH; GASP float* BCAT;
    GASP bf16_t* PROJ; GASP float *BA, *BG; GASP bf16_t* QKVN; GASP bf16_t *DW, *DUt, *DQD, *DKDt, *DATT; GASP float* DGL; GASP float* ORAW; GASP bf16_t* ON;
    GASP float* DQKV; GASP bf16_t *CQ, *CKVb, *KPEb, *Q, *KV, *AO; GASP float *QLAT, *QPE, *PART, *ML;
    GASP bf16_t* HF;
    GASP bf16_t *Wlru_in, *Wlru_gate, *Wlru_out, *Wdn_in, *Wdn_out, *Wmla_d, *Wmla_uq, *Wmla_kvup, *Wmla_o, *Wgu, *Wdown;
};
static_assert(sizeof(PG) == sizeof(P), "PG layout");
__device__ __forceinline__ P glob(const LAS PG* gp) {
    const LAS PG& g = *gp; P q;
#pragma unroll
    for (int i = 0; i < 38; ++i) q.in[i] = (const float*)g.in[i];
    q.out = (decltype(q.out))g.out;
    q.bar = (decltype(q.bar))g.bar;
    q.X = (decltype(q.X))g.X;
    q.H = (decltype(q.H))g.H;
    q.SS = (decltype(q.SS))g.SS;
    q.G1 = (decltype(q.G1))g.G1;
    q.XC = (decltype(q.XC))g.XC;
    q.RI = (decltype(q.RI))g.RI;
    q.HG = (decltype(q.HG))g.HG;
    q.CP = (decltype(q.CP))g.CP;
    q.CH = (decltype(q.CH))g.CH;
    q.BCAT = (decltype(q.BCAT))g.BCAT;
    q.PROJ = (decltype(q.PROJ))g.PROJ;
    q.BA = (decltype(q.BA))g.BA;
    q.BG = (decltype(q.BG))g.BG;
    q.QKVN = (decltype(q.QKVN))g.QKVN;
    q.DW = (decltype(q.DW))g.DW;
    q.DUt = (decltype(q.DUt))g.DUt;
    q.DQD = (decltype(q.DQD))g.DQD;
    q.DKDt = (decltype(q.DKDt))g.DKDt;
    q.DATT = (decltype(q.DATT))g.DATT;
    q.DGL = (decltype(q.DGL))g.DGL;
    q.ORAW = (decltype(q.ORAW))g.ORAW;
    q.ON = (decltype(q.ON))g.ON;
    q.DQKV = (decltype(q.DQKV))g.DQKV;
    q.CQ = (decltype(q.CQ))g.CQ;
    q.CKVb = (decltype(q.CKVb))g.CKVb;
    q.KPEb = (decltype(q.KPEb))g.KPEb;
    q.Q = (decltype(q.Q))g.Q;
    q.KV = (decltype(q.KV))g.KV;
    q.AO = (decltype(q.AO))g.AO;
    q.QLAT = (decltype(q.QLAT))g.QLAT;
    q.QPE = (decltype(q.QPE))g.QPE;
    q.PART = (decltype(q.PART))g.PART;
    q.ML = (decltype(q.ML))g.ML;
    q.HF = (decltype(q.HF))g.HF;
    q.Wlru_in = (decltype(q.Wlru_in))g.Wlru_in;
    q.Wlru_gate = (decltype(q.Wlru_gate))g.Wlru_gate;
    q.Wlru_out = (decltype(q.Wlru_out))g.Wlru_out;
    q.Wdn_in = (decltype(q.Wdn_in))g.Wdn_in;
    q.Wdn_out = (decltype(q.Wdn_out))g.Wdn_out;
    q.Wmla_d = (decltype(q.Wmla_d))g.Wmla_d;
    q.Wmla_uq = (decltype(q.Wmla_uq))g.Wmla_uq;
    q.Wmla_kvup = (decltype(q.Wmla_kvup))g.Wmla_kvup;
    q.Wmla_o = (decltype(q.Wmla_o))g.Wmla_o;
    q.Wgu = (decltype(q.Wgu))g.Wgu;
    q.Wdown = (decltype(q.Wdown))g.Wdown;
    return q;
}
typedef float f32x2c __attribute__((ext_vector_type(2)));
typedef __bf16 bf16x2c __attribute__((ext_vector_type(2)));
__device__ __forceinline__ unsigned cvt_pk(float lo, float hi) { const f32x2c v = {lo, hi}; return __builtin_bit_cast(unsigned, __builtin_convertvector(v, bf16x2c)); }
__device__ __forceinline__ float bf2f(unsigned short h) { return __uint_as_float(((unsigned)h) << 16); }
__device__ __forceinline__ float bflo(unsigned w) { return __uint_as_float(w << 16); }
__device__ __forceinline__ float bfhi(unsigned w) { return __uint_as_float(w & 0xffff0000u); }
__device__ __forceinline__ float sigmoidf_(float x) { return __builtin_amdgcn_rcpf(1.0f + __builtin_amdgcn_exp2f(-1.4426950408889634f * x)); }
__device__ __forceinline__ float siluf_(float x) { return x * sigmoidf_(x); }
__device__ __forceinline__ float softplusf_(float x) { return x > 20.f ? x : log1pf(__expf(x)); }
__device__ __forceinline__ float gelu_tanh(float x) { const float y = 0.7978845608028654f * (x + 0.044715f * x * x * x); const float t = 1.0f - 2.0f * __builtin_amdgcn_rcpf(__builtin_amdgcn_exp2f(2.885390081777927f * y) + 1.0f); return 0.5f * x * (1.0f + t); }
__device__ __forceinline__ void swap32(float& a, float& b) { const auto r = __builtin_amdgcn_permlane32_swap(__float_as_uint(a), __float_as_uint(b), false, false); a = __uint_as_float(r[0]); b = __uint_as_float(r[1]); }
__device__ __forceinline__ void swap16(float& a, float& b) { const auto r = __builtin_amdgcn_permlane16_swap(__float_as_uint(a), __float_as_uint(b), false, false); a = __uint_as_float(r[0]); b = __uint_as_float(r[1]); }
__device__ __forceinline__ float sum_x32(float x) { float a = x, b = x; swap32(a, b); return a + b; }
__device__ __forceinline__ float sum_x16(float x) { float a = x, b = x; swap16(a, b); return a + b; }
__device__ __forceinline__ float max_x32(float x) { float a = x, b = x; swap32(a, b); return fmaxf(a, b); }
__device__ __forceinline__ float max_x16(float x) { float a = x, b = x; swap16(a, b); return fmaxf(a, b); }
__device__ __forceinline__ float wave_sum(float v) { v = sum_x32(v); v = sum_x16(v); v += __shfl_xor(v, 8); v += __shfl_xor(v, 4); v += __shfl_xor(v, 2); v += __shfl_xor(v, 1); return v; }
__device__ __forceinline__ int ltid() { int t = threadIdx.x; asm volatile("" : "+v"(t)); return t; }
template <class T> __device__ __forceinline__ T* uni(T* p) {
    const unsigned long long v = (unsigned long long)p; const unsigned lo = __builtin_amdgcn_readfirstlane((unsigned)v), hi = __builtin_amdgcn_readfirstlane((unsigned)(v >> 32));
    return (T*)(__attribute__((address_space(1))) T*)(((unsigned long long)hi << 32) | lo); }
__device__ __forceinline__ f32x4 mfma16(bf16x8 a, bf16x8 b, f32x4 c) { return __builtin_amdgcn_mfma_f32_16x16x32_bf16(a, b, c, 0, 0, 0); }

#define XB_TMO      128
#define XB_XCNT(j)  (256  + 64 * (j))
#define XB_XSUB(j)  (1280 + 64 * (j))
#define XB_XGEN(j)  (2304 + 64 * (j))
#define XB_TOP      3328
#define XB_TOPGEN   3392
#define XCD_BAR_WORDS 3456
#define XB_SPIN_CAP (1u << 18)
__device__ __forceinline__ unsigned xb_ld(unsigned* p)              { return __hip_atomic_load(p, __ATOMIC_RELAXED, __HIP_MEMORY_SCOPE_AGENT); }
__device__ __forceinline__ unsigned xb_add(unsigned* p, unsigned v) { return __hip_atomic_fetch_add(p, v, __ATOMIC_RELAXED, __HIP_MEMORY_SCOPE_AGENT); }
__device__ __forceinline__ unsigned xb_xcc_id() { return (unsigned)__builtin_amdgcn_s_getreg((3 << 11) | 20) & 0xFu; }
#define XB_SPIN(cond, bar) do { unsigned _sp = 0; while (cond) { __builtin_amdgcn_s_sleep(1); \
    if ((++_sp & 255u) == 0u) { if (xb_ld(&(bar)[XB_TMO])) break; if (_sp > XB_SPIN_CAP) { atomicAdd(&(bar)[XB_TMO], 1u); break; } } } } while (0)
struct XcdBarrier { unsigned* bar; unsigned x; volatile LAS unsigned* st; };
__device__ __forceinline__ XcdBarrier xcd_barrier_post(unsigned* bar, volatile LAS unsigned* st) {
    XcdBarrier b; b.bar = bar; b.x = xb_xcc_id(); b.st = st;
    if (threadIdx.x == 0) (void)xb_add(&bar[XB_XCNT(b.x)], 1u);
    return b;
}
__device__ __forceinline__ void xcd_barrier_complete(unsigned* bar, unsigned x, unsigned& nloc, unsigned& nx) {
    const unsigned G = gridDim.x * gridDim.y * gridDim.z;
    unsigned sum, cnt, mine, sp = 0u;
    for (;;) {
        sum = 0u; cnt = 0u; mine = 0u;
#pragma unroll
        for (unsigned j = 0; j < 16; ++j) { const unsigned c = xb_ld(&bar[XB_XCNT(j)]); sum += c; cnt += (c > 0u) ? 1u : 0u; mine = (j == x) ? c : mine; }
        if (sum == G) break;
        __builtin_amdgcn_s_sleep(1);
        if ((++sp & 255u) == 0u) { if (xb_ld(&bar[XB_TMO])) break; if (sp > XB_SPIN_CAP) { atomicAdd(&bar[XB_TMO], 1u); break; } }
    }
    nloc = mine > 0u ? mine : 1u; nx = cnt > 0u ? cnt : 1u;
}
__device__ __forceinline__ void xcd_barrier(const XcdBarrier& b) {
    asm volatile("s_waitcnt vmcnt(0)" ::: "memory");
    __syncthreads();
    if (threadIdx.x == 0) {
        unsigned* bar = b.bar;
        __builtin_amdgcn_s_waitcnt(0);
        unsigned nloc = b.st[0], nx = b.st[1];
        if (nloc == 0u) { xcd_barrier_complete(bar, b.x, nloc, nx); b.st[0] = nloc; b.st[1] = nx; }
        const unsigned old = xb_add(&bar[XB_XSUB(b.x)], 1u);
        const unsigned gen = old / nloc;
        if (old + 1u == (gen + 1u) * nloc) {
            __builtin_amdgcn_fence(__ATOMIC_RELEASE, "agent");
            asm volatile("s_waitcnt vmcnt(0)" ::: "memory");
            const unsigned og = xb_add(&bar[XB_TOP], 1u);
            const unsigned tg = og / nx;
            if (og + 1u == (tg + 1u) * nx) xb_add(&bar[XB_TOPGEN], 1u);
            else XB_SPIN(xb_ld(&bar[XB_TOPGEN]) == tg, bar);
            __builtin_amdgcn_fence(__ATOMIC_ACQUIRE, "agent");
            xb_add(&bar[XB_XGEN(b.x)], 1u);
            asm volatile("s_waitcnt vmcnt(0)" ::: "memory");
        } else {
            XB_SPIN(xb_ld(&bar[XB_XGEN(b.x)]) == gen, bar);
            __builtin_amdgcn_fence(__ATOMIC_ACQUIRE, "agent");
            asm volatile("s_waitcnt vmcnt(0)" ::: "memory");
        }
    }
    __syncthreads();
}

struct Job { const float* src; int ld, K; bf16_t* dst; int nrows, nvalid, mode; const float* gain; };
__device__ __forceinline__ Job get_job(const P& p, int idx) {
    Job j; j.mode = 0; j.gain = nullptr;
    if (idx < 2)        { j.src = p.in[13] + (size_t)idx * 1024 * 2048; j.ld = 2048; j.K = 1024; j.dst = p.Wlru_in + (size_t)idx * 2048 * 1024; j.nrows = 2048; j.nvalid = 2048; j.gain = p.in[10] + (idx == 0 ? 0 : 3) * D; }
    else if (idx < 18)  { const int r = idx - 2, l = r >> 3, q = r & 7, blk = q >> 1, isI = q & 1;
                          j.src = (isI ? p.in[18] : p.in[16]) + (size_t)(l * 4 + blk) * 65536; j.ld = 256; j.K = 256;
                          j.dst = p.Wlru_gate + (size_t)l * 2048 * 256 + (size_t)(blk * 512 + isI * 256) * 256; j.nrows = 256; j.nvalid = 256; }
    else if (idx < 20)  { const int l = idx - 18; j.src = p.in[21] + (size_t)l * 1048576; j.ld = 1024; j.K = 1024; j.dst = p.Wlru_out + (size_t)l * 1048576; j.nrows = 1024; j.nvalid = 1024; }
    else if (idx == 20) { j.src = p.in[22]; j.ld = DNPROJ; j.K = 1024; j.dst = p.Wdn_in; j.nrows = DNPROJP; j.nvalid = DNPROJ; j.gain = p.in[10] + 1 * D; }
    else if (idx == 21) { j.src = p.in[27]; j.ld = 1024; j.K = 1024; j.dst = p.Wdn_out; j.nrows = 1024; j.nvalid = 1024; }
    else if (idx == 22) { j.src = p.in[28]; j.ld = 512; j.K = 1024; j.dst = p.Wmla_d; j.nrows = 512; j.nvalid = 512; j.gain = p.in[10] + 2 * D; }
    else if (idx == 23) { j.src = p.in[31]; j.ld = 320; j.K = 1024; j.dst = p.Wmla_d + (size_t)512 * 1024; j.nrows = 512; j.nvalid = 320; j.gain = p.in[10] + 2 * D; }
    else if (idx == 24) { j.src = p.in[30]; j.ld = 1536; j.K = 512; j.dst = p.Wmla_uq; j.nrows = 1536; j.nvalid = 1536; }
    else if (idx == 25) { j.src = p.in[33]; j.ld = 1024; j.K = 256; j.dst = p.Wmla_kvup; j.nrows = 1024; j.nvalid = 1024; }
    else if (idx == 26) { j.src = p.in[34]; j.ld = 1024; j.K = 256; j.dst = p.Wmla_kvup + (size_t)1024 * 256; j.nrows = 1024; j.nvalid = 1024; }
    else if (idx == 27) { j.src = p.in[35]; j.ld = 1024; j.K = 1024; j.dst = p.Wmla_o; j.nrows = 1024; j.nvalid = 1024; }
    else if (idx < 32)  { const int l = idx - 28; j.src = p.in[36] + (size_t)l * 1024 * 5632; j.ld = 5632; j.K = 1024; j.dst = p.Wgu + (size_t)l * 5632 * 1024; j.nrows = 5632; j.nvalid = 5632; j.mode = 1; j.gain = p.in[11] + l * D; }
    else                { const int l = idx - 32; j.src = p.in[37] + (size_t)l * DFF * 1024; j.ld = 1024; j.K = DFF; j.dst = p.Wdown + (size_t)l * 1024 * DFF; j.nrows = 1024; j.nvalid = 1024; }
    return j;
}
constexpr int NJOBS = 36;
__device__ __forceinline__ void ph_init(const P& p, LAS char* smem) {
    const int tid = ltid();
    {
        const float4* meta = (const float4*)p.in[9]; const float4* xp = (const float4*)p.in[0]; const float4* xs = (const float4*)p.in[1];
        const int lane = tid & 63, wid = tid >> 6;
        for (int row = blockIdx.x * 8 + wid; row < MP; row += gridDim.x * 8) {
            const float4* src = nullptr;
            if (row < NTOK) { const int b = row / LP, t = row - b * LP; src = (t < NMETA) ? meta + t * 256 : xp + (size_t)(b * 2048 + t - NMETA) * 256; }
            else if (row < NTOK + NS) src = xs + (row - NTOK) * 256;
            float ss = 0.f;
#pragma unroll
            for (int i = 0; i < 4; ++i) { const float4 v = src ? src[lane + 64 * i] : make_float4(0.f, 0.f, 0.f, 0.f);
                ((float4*)(p.X + (size_t)row * D))[lane + 64 * i] = v; ss += v.x * v.x + v.y * v.y + v.z * v.z + v.w * v.w;
                *(u32x2*)(p.H + (size_t)row * D + 4 * (lane + 64 * i)) = (u32x2){cvt_pk(v.x, v.y), cvt_pk(v.z, v.w)}; }
            ss = wave_sum(ss);
            if (lane < 16) p.SS[(size_t)row * 16 + lane] = (lane == 0) ? ss : 0.f;
        }
        for (int i = blockIdx.x * NTHREADS + tid; i < 2 * 2048; i += gridDim.x * NTHREADS) { const int l = i >> 11, col = i & 2047, blk = col >> 9, isI = (col >> 8) & 1, c = col & 255;
            p.BCAT[i] = (isI ? p.in[19] : p.in[17])[l * 1024 + blk * 256 + c]; }
        const int npad = (MP - NTOK - NS) * 1024 / 8;
        for (int i = blockIdx.x * NTHREADS + tid; i < npad; i += gridDim.x * NTHREADS) {
            const size_t off = (size_t)(NTOK + NS) * 1024 + (size_t)i * 8; const u32x4 z = {0u, 0u, 0u, 0u};
            *(u32x4*)(p.HG + off) = z; *(u32x4*)(p.ON + off) = z; *(u32x4*)(p.AO + off) = z;
            { const int e = i * 8, prow = e >> 10, c = e & 1023; *(u32x4*)(p.XC + ((size_t)(c >> 8) * MP + (NTOK + NS) + prow) * 256 + (c & 255)) = z; }
        }
    }
    LAS int* jstart = (LAS int*)smem;
    LAS float* tile = (LAS float*)(smem + 256);
    if (tid == 0) { int acc = 0; for (int j = 0; j < NJOBS; ++j) { jstart[j] = acc; const Job jb = get_job(p, j); acc += (jb.nrows >> 6) * (jb.K >> 8); } jstart[NJOBS] = acc; }
    __syncthreads();
    const int total = jstart[NJOBS];
    struct TileRef { const float* src; bf16_t* dst; int ld, K, k0, n0; bool valid; const float* gain; };
    auto locate = [&](int t, TileRef& r, int& col) {
        int ji = 0; while (jstart[ji + 1] <= t) ++ji;
        const Job jb = get_job(p, ji);
        const int lt = t - jstart[ji], nkt = jb.K >> 8, tn = lt / nkt, tk = lt - tn * nkt;
        r.src = jb.src; r.dst = jb.dst; r.ld = jb.ld; r.K = jb.K; r.k0 = tk << 8; r.n0 = tn << 6; r.gain = jb.gain;
        const int nq = (tid & 15) * 4, n = r.n0 + nq; col = n; r.valid = n < jb.nvalid;
        if (jb.mode == 1) { const int q = n >> 5, sgu = (n >> 4) & 1, e = n & 15; col = sgu * DFF + q * 16 + e; } };
    auto fetch = [&](const TileRef& r, int col, float4 (&v)[8]) {
#pragma unroll
        for (int i = 0; i < 8; ++i) { const int kl = (tid >> 4) + 32 * i;
            v[i] = r.valid ? *(const float4*)(r.src + (size_t)(r.k0 + kl) * r.ld + col) : make_float4(0.f, 0.f, 0.f, 0.f);
            if (r.gain) { const float gk = r.gain[r.k0 + kl]; v[i].x *= gk; v[i].y *= gk; v[i].z *= gk; v[i].w *= gk; } } };
    TileRef cur, nxt; int ccol = 0, ncol = 0; float4 cv[8], nv[8];
    int t = blockIdx.x;
    if (t < total) { locate(t, cur, ccol); fetch(cur, ccol, cv); }
    for (; t < total; t += gridDim.x) {
        const bool has_next = t + (int)gridDim.x < total;
        if (has_next) { locate(t + gridDim.x, nxt, ncol); fetch(nxt, ncol, nv); }
        {   const int nq = (tid & 15) * 4;
#pragma unroll
            for (int i = 0; i < 8; ++i) { const int kl = (tid >> 4) + 32 * i;
                tile[kl * 65 + nq] = cv[i].x; tile[kl * 65 + nq + 1] = cv[i].y; tile[kl * 65 + nq + 2] = cv[i].z; tile[kl * 65 + nq + 3] = cv[i].w; }
        }
        __syncthreads();
        {
            const int j = tid & 7, nl = tid >> 3;
#pragma unroll
            for (int q = 0; q < 4; ++q) { float v[8];
#pragma unroll
                for (int e = 0; e < 8; ++e) v[e] = tile[(64 * q + 8 * j + e) * 65 + nl];
                u32x4 w; w.x = cvt_pk(v[0], v[1]); w.y = cvt_pk(v[2], v[3]); w.z = cvt_pk(v[4], v[5]); w.w = cvt_pk(v[6], v[7]);
                *(u32x4*)(cur.dst + (size_t)(cur.n0 + nl) * cur.K + cur.k0 + 64 * q + 8 * j) = w; }
        }
        __syncthreads();
        if (has_next) { cur = nxt; ccol = ncol;
#pragma unroll
            for (int i = 0; i < 8; ++i) cv[i] = nv[i]; }
    }
}

__device__ __forceinline__ void ph_norm(const float* X, const float* g, bf16_t* H) {
    const int tid = ltid(), lane = tid & 63, wid = tid >> 6;
    for (int row = blockIdx.x * 8 + wid; row < MP; row += gridDim.x * 8) {
        const float4* xr = (const float4*)(X + (size_t)row * D); float4 v[4]; float ss = 0.f;
#pragma unroll
        for (int i = 0; i < 4; ++i) { v[i] = xr[lane + 64 * i]; ss += v[i].x * v[i].x + v[i].y * v[i].y + v[i].z * v[i].z + v[i].w * v[i].w; }
        ss = wave_sum(ss); const float r = rsqrtf(ss * (1.0f / D) + RMS_EPS);
#pragma unroll
        for (int i = 0; i < 4; ++i) { const int c = 4 * (lane + 64 * i); const float4 gv = *(const float4*)(g + c);
            u32x2 w; w.x = cvt_pk(v[i].x * r * gv.x, v[i].y * r * gv.y); w.y = cvt_pk(v[i].z * r * gv.z, v[i].w * r * gv.w);
            *(u32x2*)(H + (size_t)row * D + c) = w; }
    }
}
__device__ __forceinline__ void ph_final_norm(const P& p) {
    const int tid = ltid(), lane = tid & 63, wid = tid >> 6; const float* g = p.in[12];
    for (int row = blockIdx.x * 8 + wid; row < NTOK + NS; row += gridDim.x * 8) {
        float* dst;
        if (row < NTOK) { const int b = row / LP, t = row - b * LP; if (t < NMETA) continue; dst = p.out + O_YP + (size_t)(b * 2048 + t - NMETA) * D; }
        else dst = p.out + O_YS + (size_t)(row - NTOK) * D;
        const float4* xr = (const float4*)(p.X + (size_t)row * D); float4 v[4]; float ss = 0.f;
#pragma unroll
        for (int i = 0; i < 4; ++i) { v[i] = xr[lane + 64 * i]; ss += v[i].x * v[i].x + v[i].y * v[i].y + v[i].z * v[i].z + v[i].w * v[i].w; }
        ss = wave_sum(ss); const float r = rsqrtf(ss * (1.0f / D) + RMS_EPS);
#pragma unroll
        for (int i = 0; i < 4; ++i) { const int c = 4 * (lane + 64 * i); const float4 gv = *(const float4*)(g + c);
            *(float4*)(dst + c) = make_float4(v[i].x * r * gv.x, v[i].y * r * gv.y, v[i].z * r * gv.z, v[i].w * r * gv.w); }
    }
}

struct GemmDesc { const bf16_t* A; int lda; const bf16_t* Bt; int K, N, ablk, pm0, npm; };
struct EpiLruIn { static constexpr bool GU = false; bf16_t* G1;
    __device__ __forceinline__ void st(int row, int col, f32x4 v) const {
        u32x2 w; if (col < 1024) { w.x = cvt_pk(gelu_tanh(v[0]), gelu_tanh(v[1])); w.y = cvt_pk(gelu_tanh(v[2]), gelu_tanh(v[3])); } else { w.x = cvt_pk(v[0], v[1]); w.y = cvt_pk(v[2], v[3]); }
        *(u32x2*)(G1 + (size_t)row * 2048 + col) = w; } };
struct EpiGate { static constexpr bool GU = false; bf16_t* RI; const float* bc;
    __device__ __forceinline__ void st(int row, int col, f32x4 v) const {
        const float4 bv = *(const float4*)(bc + col);
        *(u32x2*)(RI + (size_t)row * 2048 + col) = (u32x2){cvt_pk(sigmoidf_(v[0] + bv.x), sigmoidf_(v[1] + bv.y)), cvt_pk(sigmoidf_(v[2] + bv.z), sigmoidf_(v[3] + bv.w))}; } };
struct EpiResid { static constexpr bool GU = false; float* X;
    __device__ __forceinline__ void st(int row, int col, f32x4 v) const {
        float4* px = (float4*)(X + (size_t)row * D + col); float4 x = *px; x.x += v[0]; x.y += v[1]; x.z += v[2]; x.w += v[3]; *px = x; } };
struct EpiBf16 { static constexpr bool GU = false; bf16_t* O; int ld;
    __device__ __forceinline__ void st(int row, int col, f32x4 v) const { u32x2 w; w.x = cvt_pk(v[0], v[1]); w.y = cvt_pk(v[2], v[3]); *(u32x2*)(O + (size_t)row * ld + col) = w; } };
struct EpiDnIn { static constexpr bool GU = false; bf16_t* PROJ; float* BA;
    __device__ __forceinline__ void st(int row, int col, f32x4 v) const {
        u32x2 w; w.x = cvt_pk(v[0], v[1]); w.y = cvt_pk(v[2], v[3]); *(u32x2*)(PROJ + (size_t)row * DNPROJP + col) = w;
        if (col >= 4096 && col < DNPROJ) *(float4*)(BA + (size_t)row * 16 + (col - 4096)) = make_float4(v[0], v[1], v[2], v[3]); } };
struct EpiF32 { static constexpr bool GU = false; float* O; int ld;
    __device__ __forceinline__ void st(int row, int col, f32x4 v) const { *(float4*)(O + (size_t)row * ld + col) = make_float4(v[0], v[1], v[2], v[3]); } };
template <class E> struct EpiScaled { static constexpr bool GU = E::GU; E e; const float* ss;
    __device__ __forceinline__ float rs(int row) const {
        const __attribute__((address_space(1))) f32x4* q = (const __attribute__((address_space(1))) f32x4*)(ss + (size_t)row * 16); const f32x4 a = q[0], b = q[1], c = q[2], d = q[3];
        const float t = ((a[0] + a[1]) + (a[2] + a[3])) + ((b[0] + b[1]) + (b[2] + b[3])) + ((c[0] + c[1]) + (c[2] + c[3])) + ((d[0] + d[1]) + (d[2] + d[3]));
        return rsqrtf(t * (1.0f / D) + RMS_EPS); }
    __device__ __forceinline__ void st(int row, int col, f32x4 v) const { e.st(row, col, v * rs(row)); }
    __device__ __forceinline__ void st2(int row, int colg, f32x4 g, f32x4 u) const { const float r = rs(row); e.st2(row, colg, g * r, u * r); } };
struct EpiGU { static constexpr bool GU = true; bf16_t* HF;
    __device__ __forceinline__ void st2(int row, int colg, f32x4 g, f32x4 u) const {
        const int ff = (colg >> 5) * 16 + (colg & 15);
        u32x2 w; w.x = cvt_pk(siluf_(g[0]) * u[0], siluf_(g[1]) * u[1]); w.y = cvt_pk(siluf_(g[2]) * u[2], siluf_(g[3]) * u[3]);
        *(u32x2*)(HF + (size_t)row * DFF + ff) = w; } };

template <class Epi>
__device__ __forceinline__ void gemm_phase(const GemmDesc g, const Epi& epi, LAS char* smem) {
    constexpr int AP = 72;
    LAS bf16_t* As = (LAS bf16_t*)smem;
    LAS bf16_t* Bs = (LAS bf16_t*)(smem + 2 * 256 * AP * 2);
    int tid_ = threadIdx.x; asm volatile("" : "+v"(tid_));
    const int tid = tid_, lane = tid & 63, wid = tid >> 6, wm = wid >> 1, wn = wid & 1, li = lane & 15, lg = lane >> 4;
    const int nN = g.N >> 7, nU = (g.npm - g.pm0) * nN, nk = g.K >> 6;
    const int lrow = tid >> 3, lkc = (tid & 7) * 8;
    for (int u = blockIdx.x; u < nU; u += gridDim.x) {
        const int pq = u / nN, pn = u - pq * nN, pm = pq + g.pm0, m0 = pm << 8, n0 = pn << 7;
        const bf16_t* Ab = g.A + (size_t)m0 * g.lda + (g.ablk ? (n0 / g.ablk) * g.K : 0) + (size_t)lrow * g.lda + lkc;
        const bf16_t* Bb = g.Bt + (size_t)n0 * g.K + (size_t)lrow * g.K + lkc;
        f32x4 acc[4][4];
#pragma unroll
        for (int a = 0; a < 4; ++a)
#pragma unroll
            for (int b = 0; b < 4; ++b) acc[a][b] = (f32x4){0.f, 0.f, 0.f, 0.f};
        u32x4 ra[4], rb[2];
#pragma unroll
        for (int i = 0; i < 4; ++i) ra[i] = *(const u32x4*)(Ab + (size_t)(64 * i) * g.lda);
#pragma unroll
        for (int i = 0; i < 2; ++i) rb[i] = *(const u32x4*)(Bb + (size_t)(64 * i) * g.K);
#pragma unroll
        for (int i = 0; i < 4; ++i) *(LAS u32x4*)(As + (lrow + 64 * i) * AP + lkc) = ra[i];
#pragma unroll
        for (int i = 0; i < 2; ++i) *(LAS u32x4*)(Bs + (lrow + 64 * i) * AP + lkc) = rb[i];
        __syncthreads();
#pragma unroll 1
        for (int ks = 0; ks < nk; ++ks) {
            const int st = ks & 1;
            if (ks + 1 < nk) {
#pragma unroll
                for (int i = 0; i < 4; ++i) ra[i] = *(const u32x4*)(Ab + (size_t)(64 * i) * g.lda + (ks + 1) * 64);
#pragma unroll
                for (int i = 0; i < 2; ++i) rb[i] = *(const u32x4*)(Bb + (size_t)(64 * i) * g.K + (ks + 1) * 64);
            }
            const LAS bf16_t* as = As + st * 256 * AP + (wm * 64 + li) * AP + lg * 8;
            const LAS bf16_t* bs = Bs + st * 128 * AP + (wn * 64 + li) * AP + lg * 8;
#pragma unroll
            for (int kk = 0; kk < 2; ++kk) {
                bf16x8 xf[4], wf[4];
#pragma unroll
                for (int t = 0; t < 4; ++t) { xf[t] = *(const LAS bf16x8*)(as + t * 16 * AP + kk * 32); wf[t] = *(const LAS bf16x8*)(bs + t * 16 * AP + kk * 32); }
#pragma unroll
                for (int nt = 0; nt < 4; ++nt)
#pragma unroll
                    for (int mt = 0; mt < 4; ++mt) acc[nt][mt] = mfma16(wf[nt], xf[mt], acc[nt][mt]);
            }
            if (ks + 1 < nk) {
#pragma unroll
                for (int i = 0; i < 4; ++i) *(LAS u32x4*)(As + (st ^ 1) * 256 * AP + (lrow + 64 * i) * AP + lkc) = ra[i];
#pragma unroll
                for (int i = 0; i < 2; ++i) *(LAS u32x4*)(Bs + (st ^ 1) * 128 * AP + (lrow + 64 * i) * AP + lkc) = rb[i];
            }
            __syncthreads();
        }
        {   const int rowbase = m0 + wm * 64, colbase = n0 + wn * 64;
#pragma unroll
            for (int mt = 0; mt < 4; ++mt) { const int row = rowbase + 16 * mt + li;
                if constexpr (Epi::GU) {
#pragma unroll
                    for (int qq = 0; qq < 2; ++qq) epi.st2(row, colbase + 32 * qq + 4 * lg, acc[2 * qq][mt], acc[2 * qq + 1][mt]);
                } else {
#pragma unroll
                    for (int nt = 0; nt < 4; ++nt) epi.st(row, colbase + 16 * nt + 4 * lg, acc[nt][mt]);
                } } }
    }
}

namespace pg8 {
#define PG8_LAS __attribute__((address_space(3)))
constexpr int BM = 256, BK = 64, HALF = 128, HTB = HALF * BK * 2  , STAGE_BYTES = 8 * HTB, NXCD = 8, WGM = 8;

__host__ __device__ __forceinline__ int lds_byte(int r, int c) { const int st = (r >> 4) * 2 + (c >> 5), rr = r & 15, cc = c & 31, ob = rr * 64 + cc * 2; return st * 1024 + (ob ^ (((ob >> 9) & 1) << 5)); }
__host__ __device__ __forceinline__ void stage_rc(int b, int& R, int& C) { const int st = b / 1024, sb = b % 1024, swz = sb ^ (((sb >> 9) & 1) << 5); R = (st >> 1) * 16 + swz / 64; C = (st & 1) * 32 + (swz % 64) / 2; }
__host__ __device__ __forceinline__ int perm32(int rho) { const int n = rho >> 4, i = rho & 15; return 8 * (i >> 2) + 4 * n + (i & 3); }

struct Unit { int pm, pn; };
struct Gemm { const bf16_t* A; const bf16_t* Bt; int M, N, K; int lda = 0, ablk = 0; };

struct StaticOrder {
    int nM, nN, nwg, G, c;
    __host__ __device__ void init(int M, int N, int G_, int c_) { nM = M / BM; nN = N / BM; nwg = nM * nN; G = G_; c = c_; }
    __host__ __device__ bool next(int i, Unit& u) const {
        const long L = (long)i * G + c; if (L >= nwg) return false;
        int wgid = (int)L; { const int q = nwg / NXCD, r = nwg % NXCD, xcd = wgid % NXCD, off = wgid / NXCD; wgid = (xcd < r ? xcd * (q + 1) : r * (q + 1) + (xcd - r) * q) + off; }
        const int nig = WGM * nN, gid = wgid / nig, fm = gid * WGM, gsz = (nM - fm) < WGM ? (nM - fm) : WGM;
        u.pm = fm + ((wgid % nig) % gsz); u.pn = (wgid % nig) / gsz; return true;
    }
    __device__ __forceinline__ void a_ready(const Unit&) const {}
    __device__ __forceinline__ void done(const Unit&) const {}
};
template <class Epi, class Sched, bool ALIGN_EPI = false, bool SP2 = false, int LDA = 0, int ABLK = 0>
__device__ __forceinline__ void gemm_phase(PG8_LAS unsigned char* lds, const Gemm g, const Sched& S, const Epi& E) {
    int tid_ = threadIdx.x; asm volatile("" : "+v"(tid_));
    const int tid = tid_, wid = __builtin_amdgcn_readfirstlane(tid >> 6), lane = tid & 63, wr = wid >> 2, wc = wid & 3, fr = lane & 15, fq = lane >> 4;
    const int K = g.K, nt = K / BK, lda = LDA ? LDA : g.K;
    unsigned voffA[2], voffB[2];
#pragma unroll
    for (int i = 0; i < 2; ++i) { int R, C; stage_rc(tid * 16 + i * 8192, R, C); const int Rb = Epi::PERM ? ((R & ~31) + perm32(R & 31)) : R;
        voffA[i] = (unsigned)(R * lda + C) * 2u; voffB[i] = (unsigned)(Rb * K + C) * 2u; }
    const size_t kstep = (size_t)(BK * 2);
    const size_t hstep = (size_t)HALF * K * 2;
    const size_t tstep = 2 * hstep;
    const size_t hstepA = (size_t)HALF * lda * 2, tstepA = 2 * hstepA;
    auto akoff = [&](int pn) -> size_t { if constexpr (ABLK > 0) return (size_t)((pn * BM) / ABLK) * K * 2; else return (size_t)0; };
    const unsigned ldsw = (unsigned)wid * 1024u;
    const int aoff = lds_byte(wr * 64 + fr, fq * 8), boff = lds_byte(wc * 32 + fr, fq * 8);
#define PG8_SA(b, h) (((b) * 2 + (h)) * HTB)
#define PG8_SB(b, h) ((4 + (b) * 2 + (h)) * HTB)
#define PG8_STAGE(bufoff, gbase, voff) do { _Pragma("unroll") for (int _i = 0; _i < 2; ++_i) \
        __builtin_amdgcn_global_load_lds((const __attribute__((address_space(1))) unsigned*)((const char*)(gbase) + (voff)[_i]), (PG8_LAS unsigned*)(lds + (bufoff) + ldsw + _i * 8192), 16, 0, 0); } while (0)
#define PG8_LDA(dst, b, h) do { _Pragma("unroll") for (int m = 0; m < 4; ++m) _Pragma("unroll") for (int k = 0; k < 2; ++k) dst[m][k] = *(const PG8_LAS bf16x8*)(lds + PG8_SA(b, h) + aoff + m * 2048 + k * 1024); } while (0)
#define PG8_LDB(dst, b, h) do { _Pragma("unroll") for (int n = 0; n < 2; ++n) _Pragma("unroll") for (int k = 0; k < 2; ++k) dst[n][k] = *(const PG8_LAS bf16x8*)(lds + PG8_SB(b, h) + boff + n * 2048 + k * 1024); } while (0)
#define PG8_MMA(ai, bj, At, Bt) do { __builtin_amdgcn_s_setprio(1); _Pragma("unroll") for (int m = 0; m < 4; ++m) _Pragma("unroll") for (int n = 0; n < 2; ++n) _Pragma("unroll") for (int k = 0; k < 2; ++k) \
        acc[ai][bj][m][n] = __builtin_amdgcn_mfma_f32_16x16x32_bf16(Bt[n][k], At[m][k], acc[ai][bj][m][n], 0, 0, 0); __builtin_amdgcn_s_setprio(0); } while (0)
#define PG8_WAIT_V(n) asm volatile("s_waitcnt vmcnt(" #n ")" ::: "memory")
#define PG8_WAIT_L(n) asm volatile("s_waitcnt lgkmcnt(" #n ")" ::: "memory")
#define PG8_BAR __builtin_amdgcn_s_barrier()
#define PG8_SCHED __builtin_amdgcn_sched_barrier(0)
    Unit cur, nxt; int ui = 0;
    if (!S.next(0, cur)) return;
    f32x4 acc[2][2][4][2];
#pragma unroll
    for (int a = 0; a < 2; ++a)
#pragma unroll
        for (int b = 0; b < 2; ++b)
#pragma unroll
            for (int m = 0; m < 4; ++m)
#pragma unroll
                for (int n = 0; n < 2; ++n) acc[a][b][m][n] = (f32x4){0.f, 0.f, 0.f, 0.f};
    bf16x8 At[4][2], B0[2][2], B1[2][2];
    const char* cA = (const char*)g.A + (size_t)cur.pm * tstepA + akoff(cur.pn); const char* cB = (const char*)g.Bt + (size_t)cur.pn * tstep;
    S.a_ready(cur);
    if constexpr (SP2) {
        PG8_STAGE(PG8_SB(0, 0), cB, voffB); PG8_STAGE(PG8_SB(0, 1), cB + hstep, voffB); PG8_STAGE(PG8_SA(0, 0), cA, voffA); PG8_STAGE(PG8_SA(0, 1), cA + hstepA, voffA);
        if (wr == 1) PG8_BAR;
        PG8_WAIT_V(2); PG8_BAR;
        PG8_STAGE(PG8_SB(1, 0), cB + kstep, voffB); PG8_STAGE(PG8_SA(1, 0), cA + kstep, voffA); PG8_STAGE(PG8_SB(1, 1), cB + hstep + kstep, voffB);
        PG8_WAIT_V(6); PG8_BAR;
    } else {
        PG8_STAGE(PG8_SB(0, 0), cB, voffB); PG8_STAGE(PG8_SA(0, 0), cA, voffA); PG8_STAGE(PG8_SB(0, 1), cB + hstep, voffB); PG8_STAGE(PG8_SA(0, 1), cA + hstepA, voffA);
        if (wr == 1) PG8_BAR;
        PG8_WAIT_V(4); PG8_BAR;
        PG8_STAGE(PG8_SB(1, 0), cB + kstep, voffB); PG8_STAGE(PG8_SA(1, 0), cA + kstep, voffA); PG8_STAGE(PG8_SB(1, 1), cB + hstep + kstep, voffB);
        PG8_WAIT_V(6); PG8_BAR;
    }
    for (;;) {
        const bool has_next = S.next(ui + 1, nxt);
        const char* nA = has_next ? (const char*)g.A + (size_t)nxt.pm * tstepA + akoff(nxt.pn) : cA; const char* nB = has_next ? (const char*)g.Bt + (size_t)nxt.pn * tstep : cB;
#pragma unroll 1
        for (int t = 0; t < nt; t += 2) {
            const bool last = (t == nt - 2);
            const char* a1 = cA + (size_t)(t + 1) * kstep;
            const char* a2 = last ? nA : cA + (size_t)(t + 2) * kstep; const char* b2 = last ? nB : cB + (size_t)(t + 2) * kstep;
            const char* a3 = a2 + kstep; const char* b3 = b2 + kstep;
            if (last && has_next) S.a_ready(nxt);
            if constexpr (SP2) {
            PG8_LDB(B0, 0, 0); PG8_LDB(B1, 0, 1); PG8_SCHED; PG8_LDA(At, 0, 0); PG8_STAGE(PG8_SA(1, 1), a1 + hstepA, voffA);
            PG8_WAIT_V(8); PG8_WAIT_L(0); PG8_BAR; PG8_MMA(0, 0, At, B0); PG8_MMA(0, 1, At, B1); PG8_BAR; PG8_SCHED;
            PG8_LDA(At, 0, 1); PG8_STAGE(PG8_SB(0, 0), b2, voffB); PG8_STAGE(PG8_SB(0, 1), b2 + hstep, voffB); PG8_STAGE(PG8_SA(0, 0), a2, voffA);
            PG8_WAIT_V(8); PG8_WAIT_L(0); PG8_BAR; PG8_MMA(1, 0, At, B0); PG8_MMA(1, 1, At, B1); PG8_BAR; PG8_SCHED;
            PG8_LDB(B0, 1, 0); PG8_LDB(B1, 1, 1); PG8_SCHED; PG8_LDA(At, 1, 0); PG8_STAGE(PG8_SA(0, 1), a2 + hstepA, voffA);
            PG8_WAIT_V(8); PG8_WAIT_L(0); PG8_BAR; PG8_MMA(0, 0, At, B0); PG8_MMA(0, 1, At, B1); PG8_BAR; PG8_SCHED;
            PG8_LDA(At, 1, 1); PG8_STAGE(PG8_SB(1, 0), b3, voffB); PG8_STAGE(PG8_SB(1, 1), b3 + hstep, voffB); PG8_STAGE(PG8_SA(1, 0), a3, voffA);
            PG8_WAIT_V(8); PG8_WAIT_L(0); PG8_BAR; PG8_MMA(1, 0, At, B0); PG8_MMA(1, 1, At, B1); PG8_BAR; PG8_SCHED;
            } else {
            PG8_LDB(B0, 0, 0); PG8_SCHED; PG8_LDA(At, 0, 0); PG8_STAGE(PG8_SA(1, 1), a1 + hstepA, voffA);
            PG8_WAIT_L(8); PG8_BAR; PG8_WAIT_L(0); PG8_MMA(0, 0, At, B0); PG8_BAR; PG8_SCHED;
            PG8_LDB(B1, 0, 1); PG8_STAGE(PG8_SB(0, 0), b2, voffB);
            PG8_BAR; PG8_WAIT_L(0); PG8_MMA(0, 1, At, B1); PG8_BAR;
            PG8_LDA(At, 0, 1); PG8_STAGE(PG8_SA(0, 0), a2, voffA);
            PG8_BAR; PG8_WAIT_L(0); PG8_MMA(1, 0, At, B0); PG8_BAR; PG8_SCHED;
            PG8_STAGE(PG8_SB(0, 1), b2 + hstep, voffB);
            PG8_WAIT_V(6); PG8_BAR; PG8_MMA(1, 1, At, B1); PG8_BAR;
            PG8_LDB(B0, 1, 0); PG8_SCHED; PG8_LDA(At, 1, 0); PG8_STAGE(PG8_SA(0, 1), a2 + hstepA, voffA);
            PG8_WAIT_L(8); PG8_BAR; PG8_WAIT_L(0); PG8_MMA(0, 0, At, B0); PG8_BAR; PG8_SCHED;
            PG8_LDB(B1, 1, 1); PG8_STAGE(PG8_SB(1, 0), b3, voffB);
            PG8_BAR; PG8_WAIT_L(0); PG8_MMA(0, 1, At, B1); PG8_BAR;
            PG8_LDA(At, 1, 1); PG8_STAGE(PG8_SA(1, 0), a3, voffA);
            PG8_BAR; PG8_WAIT_L(0); PG8_MMA(1, 0, At, B0); PG8_BAR; PG8_SCHED;
            PG8_STAGE(PG8_SB(1, 1), b3 + hstep, voffB);
            PG8_WAIT_V(6); PG8_BAR; PG8_MMA(1, 1, At, B1); PG8_BAR;
            }
        }
        if constexpr (ALIGN_EPI) { if (wr == 0) PG8_BAR; }
        if constexpr (!Epi::AFTER_DRAIN) { E(acc, cur, wr, wc, fr, fq); S.done(cur); }
        if (!has_next) break;
#pragma unroll
        for (int a = 0; a < 2; ++a)
#pragma unroll
            for (int b = 0; b < 2; ++b)
#pragma unroll
                for (int m = 0; m < 4; ++m)
#pragma unroll
                    for (int n = 0; n < 2; ++n) acc[a][b][m][n] = (f32x4){0.f, 0.f, 0.f, 0.f};
        cur = nxt; cA = nA; cB = nB; ++ui;
        if constexpr (ALIGN_EPI) { if (wr == 1) PG8_BAR; }
    }
    PG8_WAIT_V(0);
    if constexpr (!ALIGN_EPI) { if (wr == 0) PG8_BAR; }
    PG8_BAR;
    if constexpr (Epi::AFTER_DRAIN) { E.fused(acc, cur, wr, wc, fr, fq, lds, wid, lane); S.done(cur); }
#undef PG8_SA
#undef PG8_SB
#undef PG8_STAGE
#undef PG8_LDA
#undef PG8_LDB
#undef PG8_MMA
#undef PG8_WAIT_V
#undef PG8_WAIT_L
#undef PG8_BAR
#undef PG8_SCHED
}
}


struct EpiResidAt { static constexpr bool GU = false; float* X;
    __device__ __forceinline__ void st(int row, int col, f32x4 v) const { float* px = X + (size_t)row * D + col;
        unsafeAtomicAdd(px, v[0]); unsafeAtomicAdd(px + 1, v[1]); unsafeAtomicAdd(px + 2, v[2]); unsafeAtomicAdd(px + 3, v[3]); } };
template <bool XN, class Epi>
__device__ __forceinline__ void gemm_small(const bf16_t* A, int lda, const bf16_t* Bt, int K, int N, int row0, int nrt, int S, const Epi& epi, LAS char* smem, const float* Xf = nullptr, int ablk = 0) {
    constexpr int AP = 72;
    LAS bf16_t* As = (LAS bf16_t*)smem;
    LAS bf16_t* Bs = (LAS bf16_t*)(smem + 2 * 64 * AP * 2);
    LAS float* rsS = (LAS float*)(smem + 2 * 64 * AP * 2 + 2 * 128 * AP * 2);
    int tid_ = threadIdx.x; asm volatile("" : "+v"(tid_));
    const int tid = tid_, lane = tid & 63, wid = tid >> 6, wm = wid >> 2, wn = wid & 3, li = lane & 15, lg = lane >> 4;
    const int nN = N >> 7, kper = (K >> 6) / S, nU = nrt * nN * S;
    const int lrow = tid >> 3, lkc = (tid & 7) * 8;
    const int G = (int)gridDim.x, nmain = (MMAIN / 256) * (N >> 8), first = nmain % G;
    for (int u = ((int)blockIdx.x - first + G) % G; u < nU; u += G) {
        const int ksp = u % S, t = u / S, pn = t % nN, rt = t / nN, m0 = row0 + rt * 64, n0 = pn << 7, k0 = ksp * kper * 64;
        const bf16_t* Ab = A + (ablk ? (size_t)(n0 / ablk) * MP * K : (size_t)0) + (size_t)(m0 + lrow) * lda + k0 + lkc;
        const bf16_t* Bb = Bt + (size_t)(n0 + lrow) * K + k0 + lkc;
        f32x4 acc[2][2];
#pragma unroll
        for (int a = 0; a < 2; ++a)
#pragma unroll
            for (int b = 0; b < 2; ++b) acc[a][b] = (f32x4){0.f, 0.f, 0.f, 0.f};
        u32x4 ra, rb[2];
        const float* Xb = XN ? Xf + (size_t)(m0 + lrow) * D + k0 + lkc : nullptr;
        auto loadA = [&](int ks) { if constexpr (XN) { const float4 a = *(const float4*)(Xb + ks * 64), c = *(const float4*)(Xb + ks * 64 + 4); ra = (u32x4){cvt_pk(a.x, a.y), cvt_pk(a.z, a.w), cvt_pk(c.x, c.y), cvt_pk(c.z, c.w)}; } else ra = *(const u32x4*)(Ab + ks * 64); };
        if constexpr (XN) {
#pragma unroll
            for (int r = 0; r < 8; ++r) { const float4* xr = (const float4*)(Xf + (size_t)(m0 + wid * 8 + r) * D); float ss = 0.f;
#pragma unroll
                for (int i = 0; i < 4; ++i) { const float4 v = xr[lane + 64 * i]; ss += v.x * v.x + v.y * v.y + v.z * v.z + v.w * v.w; }
                ss = wave_sum(ss); if (lane == 0) rsS[wid * 8 + r] = rsqrtf(ss * (1.0f / D) + RMS_EPS); }
        }
        loadA(0);
#pragma unroll
        for (int i = 0; i < 2; ++i) rb[i] = *(const u32x4*)(Bb + (size_t)(64 * i) * K);
        *(LAS u32x4*)(As + lrow * AP + lkc) = ra;
#pragma unroll
        for (int i = 0; i < 2; ++i) *(LAS u32x4*)(Bs + (lrow + 64 * i) * AP + lkc) = rb[i];
        __syncthreads();
#pragma unroll 1
        for (int ks = 0; ks < kper; ++ks) {
            const int st = ks & 1;
            if (ks + 1 < kper) { loadA(ks + 1);
#pragma unroll
                for (int i = 0; i < 2; ++i) rb[i] = *(const u32x4*)(Bb + (size_t)(64 * i) * K + (ks + 1) * 64); }
            const LAS bf16_t* as = As + st * 64 * AP + (wm * 32 + li) * AP + lg * 8;
            const LAS bf16_t* bs = Bs + st * 128 * AP + (wn * 32 + li) * AP + lg * 8;
#pragma unroll
            for (int kk = 0; kk < 2; ++kk) {
                bf16x8 xf[2], wf[2];
#pragma unroll
                for (int t2 = 0; t2 < 2; ++t2) { xf[t2] = *(const LAS bf16x8*)(as + t2 * 16 * AP + kk * 32); wf[t2] = *(const LAS bf16x8*)(bs + t2 * 16 * AP + kk * 32); }
#pragma unroll
                for (int nt = 0; nt < 2; ++nt)
#pragma unroll
                    for (int mt = 0; mt < 2; ++mt) acc[nt][mt] = mfma16(wf[nt], xf[mt], acc[nt][mt]);
            }
            if (ks + 1 < kper) { *(LAS u32x4*)(As + (st ^ 1) * 64 * AP + lrow * AP + lkc) = ra;
#pragma unroll
                for (int i = 0; i < 2; ++i) *(LAS u32x4*)(Bs + (st ^ 1) * 128 * AP + (lrow + 64 * i) * AP + lkc) = rb[i]; }
            __syncthreads();
        }
#pragma unroll
        for (int mt = 0; mt < 2; ++mt) { const int row = m0 + wm * 32 + 16 * mt + li, colb = n0 + wn * 32 + 4 * lg;
            if constexpr (XN) { const float r = rsS[wm * 32 + 16 * mt + li]; acc[0][mt] *= r; acc[1][mt] *= r; }
            if constexpr (Epi::GU) epi.st2(row, colb, acc[0][mt], acc[1][mt]);
            else { epi.st(row, colb, acc[0][mt]); epi.st(row, colb + 16, acc[1][mt]); } }
        if constexpr (XN) __syncthreads();
    }
}

template <class T> struct is_scaled : std::false_type {};
template <class E> struct is_scaled<EpiScaled<E>> : std::true_type {};
template <class E> struct PgEpi {
    static constexpr bool PERM = false, AFTER_DRAIN = false; E e;
    __device__ __forceinline__ void operator()(const f32x4 (&acc)[2][2][4][2], const pg8::Unit& u, int wr, int wc, int fr, int fq) const {
#pragma unroll
        for (int ai = 0; ai < 2; ++ai)
#pragma unroll
            for (int m = 0; m < 4; ++m) { const int row = u.pm * 256 + ai * 128 + wr * 64 + m * 16 + fr; float r = 1.f;
                if constexpr (is_scaled<E>::value) r = e.rs(row);
#pragma unroll
                for (int bj = 0; bj < 2; ++bj) { const int colb = u.pn * 256 + bj * 128 + wc * 32 + 4 * fq;
                    if constexpr (is_scaled<E>::value) {
                        if constexpr (E::GU) e.e.st2(row, colb, acc[ai][bj][m][0] * r, acc[ai][bj][m][1] * r);
                        else { e.e.st(row, colb, acc[ai][bj][m][0] * r); e.e.st(row, colb + 16, acc[ai][bj][m][1] * r); } }
                    else {
                        if constexpr (E::GU) e.st2(row, colb, acc[ai][bj][m][0], acc[ai][bj][m][1]);
                        else { e.st(row, colb, acc[ai][bj][m][0]); e.st(row, colb + 16, acc[ai][bj][m][1]); } } }
                asm volatile("" ::: "memory"); }
    }
};
struct GateOrder { int G, c;
    __device__ __forceinline__ bool next(int i, pg8::Unit& u) const { const int L = i * G + c; if (L >= 512) return false;
        const int half = L & 1, pm = (L >> 1) & 63, blk = L >> 7; u.pm = blk * NPANEL + pm; u.pn = 2 * blk + half; return true; }
    __device__ __forceinline__ void a_ready(const pg8::Unit&) const {}
    __device__ __forceinline__ void done(const pg8::Unit&) const {} };
struct PgEpiGate { static constexpr bool PERM = false, AFTER_DRAIN = false; EpiGate e;
    __device__ __forceinline__ void operator()(const f32x4 (&acc)[2][2][4][2], const pg8::Unit& u, int wr, int wc, int fr, int fq) const {
        const int pm = u.pm % NPANEL;
#pragma unroll
        for (int ai = 0; ai < 2; ++ai)
#pragma unroll
            for (int m = 0; m < 4; ++m) { const int row = pm * 256 + ai * 128 + wr * 64 + m * 16 + fr;
#pragma unroll
                for (int bj = 0; bj < 2; ++bj) { const int colb = u.pn * 256 + bj * 128 + wc * 32 + 4 * fq; e.st(row, colb, acc[ai][bj][m][0]); e.st(row, colb + 16, acc[ai][bj][m][1]); asm volatile("" ::: "memory"); } }
    } };
template <class E>
__device__ __forceinline__ void big_gemm(const bf16_t* A, const bf16_t* Bt, int N, int K, const E& e, LAS char* smem) {
    A = uni(A); Bt = uni(Bt);
    pg8::Gemm g{A, Bt, MMAIN, N, K}; pg8::StaticOrder S; S.init(MMAIN, N, (int)gridDim.x, (int)blockIdx.x);
    PgEpi<E> pe{e};
    pg8::gemm_phase<PgEpi<E>, pg8::StaticOrder, true, true>((LAS unsigned char*)smem, g, S, pe);
    __syncthreads();
    gemm_small<false>(A, K, Bt, K, N, MMAIN, 3, 1, e, smem);
}
template <class E>
__device__ __forceinline__ void norm_gemm(const P& p, const bf16_t* Bt, int N, int site, const E& e, LAS char* smem) {
    const bf16_t* A = uni((const bf16_t*)p.H); Bt = uni(Bt); const float* ss = uni((const float*)p.SS) + (size_t)site * MP * 16;
    pg8::Gemm g{A, Bt, MMAIN, N, D}; pg8::StaticOrder S; S.init(MMAIN, N, (int)gridDim.x, (int)blockIdx.x);
    PgEpi<EpiScaled<E>> pe{EpiScaled<E>{e, ss}};
    pg8::gemm_phase<PgEpi<EpiScaled<E>>, pg8::StaticOrder, true, true>((LAS unsigned char*)smem, g, S, pe);
    __syncthreads();
    gemm_small<true>(A, D, Bt, D, N, MMAIN, 3, 1, e, smem, uni((const float*)p.X));
}
struct PgEpiResidN { static constexpr bool PERM = false, AFTER_DRAIN = false; float* X; bf16_t* XB; float* SSo;
    __device__ __forceinline__ void operator()(const f32x4 (&acc)[2][2][4][2], const pg8::Unit& u, int wr, int wc, int fr, int fq) const {
#pragma unroll
        for (int ai = 0; ai < 2; ++ai)
#pragma unroll
            for (int m = 0; m < 4; ++m) { const int row = u.pm * 256 + ai * 128 + wr * 64 + m * 16 + fr; float ssum = 0.f;
#pragma unroll
                for (int bj = 0; bj < 2; ++bj)
#pragma unroll
                    for (int n = 0; n < 2; ++n) { const int col = u.pn * 256 + bj * 128 + wc * 32 + 16 * n + 4 * fq; const f32x4 v = acc[ai][bj][m][n];
                        float4* px = (float4*)(X + (size_t)row * D + col); float4 x = *px; x.x += v[0]; x.y += v[1]; x.z += v[2]; x.w += v[3]; *px = x;
                        if (SSo) { *(u32x2*)(XB + (size_t)row * D + col) = (u32x2){cvt_pk(x.x, x.y), cvt_pk(x.z, x.w)}; ssum += x.x * x.x + x.y * x.y + x.z * x.z + x.w * x.w; } }
                if (SSo) { ssum = sum_x32(sum_x16(ssum)); if (fq == 0) SSo[(size_t)row * 16 + u.pn * 4 + wc] = ssum; } }
    }
};
__device__ __forceinline__ void resid_gemm(const P& p, const bf16_t* A, const bf16_t* Bt, int K, int site_out, LAS char* smem) {
    A = uni(A); Bt = uni(Bt); float* X = uni(p.X);
    pg8::Gemm g{A, Bt, MMAIN, D, K}; pg8::StaticOrder S; S.init(MMAIN, D, (int)gridDim.x, (int)blockIdx.x);
    PgEpiResidN pe{X, uni(p.H), site_out >= 0 ? uni(p.SS) + (size_t)site_out * MP * 16 : nullptr};
    pg8::gemm_phase<PgEpiResidN, pg8::StaticOrder, true, true>((LAS unsigned char*)smem, g, S, pe);
    __syncthreads();
    gemm_small<false>(A, K, Bt, K, D, MMAIN, 3, (K == DFF) ? 11 : 8, EpiResidAt{X}, smem);
}

template <int J>
__device__ __forceinline__ void ph_lru_conv(const P& p) {
    const float* cw = p.in[14] + J * 4 * 1024; const float* cb = p.in[15] + J * 1024;
    const float* sbuf = p.in[3] + (size_t)J * NS * 3 * 1024;
    float* pconv = p.out + O_PLC + (size_t)J * NB * 3 * 1024; float* sconv = p.out + O_SLC + (size_t)J * NS * 3 * 1024;
    const int gt = blockIdx.x * NTHREADS + ltid(), nth = gridDim.x * NTHREADS;
    constexpr int RUN = 16, RPS = LP / RUN;
    for (int it = gt; it < NB * RPS * 128; it += nth) {
        const int run = it >> 7, c0 = (it & 127) * 8, b = run / RPS, t0 = (run - b * RPS) * RUN;
        float w[4][8], bias[8];
#pragma unroll
        for (int e = 0; e < 8; ++e) { bias[e] = cb[c0 + e];
#pragma unroll
            for (int j = 0; j < 4; ++j) w[j][e] = cw[j * 1024 + c0 + e]; }
        const bf16_t* src = p.G1 + ((size_t)b * LP + t0) * 2048 + 1024 + c0;
        float x[4][8];
#pragma unroll
        for (int j = 0; j < 3; ++j) { const int back = 3 - j;
            if (t0 >= back) { const u32x4 q = *(const u32x4*)(src - (size_t)back * 2048);
#pragma unroll
                for (int e = 0; e < 4; ++e) { x[j][2 * e] = bflo(q[e]); x[j][2 * e + 1] = bfhi(q[e]); } }
            else {
#pragma unroll
                for (int e = 0; e < 8; ++e) x[j][e] = 0.f; } }
        bf16_t* dst = p.XC + ((size_t)(c0 >> 8) * MP + (size_t)b * LP + t0) * 256 + (c0 & 255);
#pragma unroll 4
        for (int r = 0; r < RUN; ++r) {
            const u32x4 q = *(const u32x4*)(src + (size_t)r * 2048);
#pragma unroll
            for (int e = 0; e < 4; ++e) { x[3][2 * e] = bflo(q[e]); x[3][2 * e + 1] = bfhi(q[e]); }
            float y[8];
#pragma unroll
            for (int e = 0; e < 8; ++e) y[e] = bias[e] + x[0][e] * w[0][e] + x[1][e] * w[1][e] + x[2][e] * w[2][e] + x[3][e] * w[3][e];
            *(u32x4*)(dst + (size_t)r * 256) = (u32x4){cvt_pk(y[0], y[1]), cvt_pk(y[2], y[3]), cvt_pk(y[4], y[5]), cvt_pk(y[6], y[7])};
            const int t = t0 + r;
            if (t >= LP - 3) { float* d = pconv + (size_t)(b * 3 + (t - (LP - 3))) * 1024 + c0;
                *(float4*)d = make_float4(x[3][0], x[3][1], x[3][2], x[3][3]); *(float4*)(d + 4) = make_float4(x[3][4], x[3][5], x[3][6], x[3][7]); }
#pragma unroll
            for (int e = 0; e < 8; ++e) { x[0][e] = x[1][e]; x[1][e] = x[2][e]; x[2][e] = x[3][e]; }
        }
    }
    for (int it = gt; it < NS * 128; it += nth) {
        const int s = it >> 7, c0 = (it & 127) * 8; const size_t row = (size_t)NTOK + s;
        float x[4][8];
        { const u32x4 q = *(const u32x4*)(p.G1 + row * 2048 + 1024 + c0);
#pragma unroll
          for (int e = 0; e < 4; ++e) { x[3][2 * e] = bflo(q[e]); x[3][2 * e + 1] = bfhi(q[e]); } }
#pragma unroll
        for (int j = 0; j < 3; ++j) { const float* bsrc = sbuf + (size_t)(s * 3 + j) * 1024 + c0; const float4 a = *(const float4*)bsrc, bq = *(const float4*)(bsrc + 4);
            x[j][0] = a.x; x[j][1] = a.y; x[j][2] = a.z; x[j][3] = a.w; x[j][4] = bq.x; x[j][5] = bq.y; x[j][6] = bq.z; x[j][7] = bq.w; }
#pragma unroll
        for (int j = 0; j < 3; ++j) { float* d = sconv + (size_t)(s * 3 + j) * 1024 + c0;
            *(float4*)d = make_float4(x[j + 1][0], x[j + 1][1], x[j + 1][2], x[j + 1][3]); *(float4*)(d + 4) = make_float4(x[j + 1][4], x[j + 1][5], x[j + 1][6], x[j + 1][7]); }
        float y[8];
#pragma unroll
        for (int e = 0; e < 8; ++e) { y[e] = cb[c0 + e];
#pragma unroll
            for (int j = 0; j < 4; ++j) y[e] += x[j][e] * cw[j * 1024 + c0 + e]; }
        *(u32x4*)(p.XC + ((size_t)(c0 >> 8) * MP + row) * 256 + (c0 & 255)) = (u32x4){cvt_pk(y[0], y[1]), cvt_pk(y[2], y[3]), cvt_pk(y[4], y[5]), cvt_pk(y[6], y[7])};
    }
}

__device__ __forceinline__ void lru_au(float cla, float r, float ig, float xc, float& a, float& u) {
    const float la = cla * r, x2 = 2.0f * la; a = __builtin_amdgcn_exp2f(1.4426950408889634f * la);
    const float om = (x2 > -0.02f) ? -x2 * (1.0f + x2 * (0.5f + x2 * (1.0f / 6.0f))) : 1.0f - a * a;
    u = __builtin_amdgcn_sqrtf(om) * (ig * xc);
}
template <int J>
__device__ __forceinline__ void ph_scan1(const P& p) {
    const float* lam = p.in[20] + J * 1024;
    const int tid = ltid(), sub = tid >> 8, ch = (tid & 255) * 4, blk = ch >> 8, cc = ch & 255;
    float cla[4];
#pragma unroll
    for (int e = 0; e < 4; ++e) cla[e] = -8.0f * softplusf_(-lam[ch + e]);
    for (int u = blockIdx.x; u < NB * SCH / 2; u += gridDim.x) {
        const int pr_ = 2 * u + sub, b = pr_ / SCH, ci = pr_ - b * SCH;
        const size_t row0 = (size_t)b * LP + ci * SCL;
        const bf16_t* pr = p.RI + row0 * 2048 + blk * 512 + cc; const bf16_t* px = p.XC + ((size_t)blk * MP + row0) * 256 + cc;
        float Pp[4] = {1.f, 1.f, 1.f, 1.f}, h[4] = {0.f, 0.f, 0.f, 0.f};
#pragma unroll 8
        for (int t = 0; t < SCL; ++t) {
            const u32x2 rw = *(const u32x2*)(pr + (size_t)t * 2048), iw = *(const u32x2*)(pr + (size_t)t * 2048 + 256), xw = *(const u32x2*)(px + (size_t)t * 256);
            const float r[4] = {bflo(rw.x), bfhi(rw.x), bflo(rw.y), bfhi(rw.y)}, ig[4] = {bflo(iw.x), bfhi(iw.x), bflo(iw.y), bfhi(iw.y)}, xc[4] = {bflo(xw.x), bfhi(xw.x), bflo(xw.y), bfhi(xw.y)};
#pragma unroll
            for (int e = 0; e < 4; ++e) { float a, uu; lru_au(cla[e], r[e], ig[e], xc[e], a, uu); h[e] = a * h[e] + uu; Pp[e] *= a; }
        }
        *(float4*)(p.CP + (size_t)(b * SCH + ci) * 1024 + ch) = make_float4(Pp[0], Pp[1], Pp[2], Pp[3]);
        *(float4*)(p.CH + (size_t)(b * SCH + ci) * 1024 + ch) = make_float4(h[0], h[1], h[2], h[3]);
    }
}
template <int J>
__device__ __forceinline__ void ph_scan2(const P& p) {
    const float* lam = p.in[20] + J * 1024;
    const int tid = ltid(), sub = tid >> 8, ch = (tid & 255) * 4, blk = ch >> 8, cc = ch & 255;
    float cla[4];
#pragma unroll
    for (int e = 0; e < 4; ++e) cla[e] = -8.0f * softplusf_(-lam[ch + e]);
    for (int u = blockIdx.x; u < NB * SCH / 2 + NS / 2; u += gridDim.x) {
        if (u < NB * SCH / 2) {
            const int pr_ = 2 * u + sub, b = pr_ / SCH, ci = pr_ - b * SCH;
            float h[4] = {0.f, 0.f, 0.f, 0.f};
            for (int cj = 0; cj < ci; ++cj) { const float4 cp = *(const float4*)(p.CP + (size_t)(b * SCH + cj) * 1024 + ch), chv = *(const float4*)(p.CH + (size_t)(b * SCH + cj) * 1024 + ch);
                h[0] = cp.x * h[0] + chv.x; h[1] = cp.y * h[1] + chv.y; h[2] = cp.z * h[2] + chv.z; h[3] = cp.w * h[3] + chv.w; }
            const size_t row0 = (size_t)b * LP + ci * SCL;
            const bf16_t* pr = p.RI + row0 * 2048 + blk * 512 + cc; const bf16_t* px = p.XC + ((size_t)blk * MP + row0) * 256 + cc; const bf16_t* pg = p.G1 + row0 * 2048 + ch;
            bf16_t* po = p.HG + row0 * 1024 + ch;
#pragma unroll 8
            for (int t = 0; t < SCL; ++t) {
                const u32x2 rw = *(const u32x2*)(pr + (size_t)t * 2048), iw = *(const u32x2*)(pr + (size_t)t * 2048 + 256), xw = *(const u32x2*)(px + (size_t)t * 256), gw = *(const u32x2*)(pg + (size_t)t * 2048);
                const float r[4] = {bflo(rw.x), bfhi(rw.x), bflo(rw.y), bfhi(rw.y)}, ig[4] = {bflo(iw.x), bfhi(iw.x), bflo(iw.y), bfhi(iw.y)}, xc[4] = {bflo(xw.x), bfhi(xw.x), bflo(xw.y), bfhi(xw.y)};
                const float gt[4] = {bflo(gw.x), bfhi(gw.x), bflo(gw.y), bfhi(gw.y)};
#pragma unroll
                for (int e = 0; e < 4; ++e) { float a, uu; lru_au(cla[e], r[e], ig[e], xc[e], a, uu); h[e] = a * h[e] + uu; }
                *(u32x2*)(po + (size_t)t * 1024) = (u32x2){cvt_pk(h[0] * gt[0], h[1] * gt[1]), cvt_pk(h[2] * gt[2], h[3] * gt[3])};
            }
            if (ci == SCH - 1) *(float4*)(p.out + O_PLH + (size_t)(J * NB + b) * 1024 + ch) = make_float4(h[0], h[1], h[2], h[3]);
        } else {
            const int s = 2 * (u - NB * SCH / 2) + sub; const size_t row = (size_t)NTOK + s;
            const u32x2 rw = *(const u32x2*)(p.RI + row * 2048 + blk * 512 + cc), iw = *(const u32x2*)(p.RI + row * 2048 + blk * 512 + 256 + cc), xw = *(const u32x2*)(p.XC + ((size_t)blk * MP + row) * 256 + cc), gw = *(const u32x2*)(p.G1 + row * 2048 + ch);
            const float r[4] = {bflo(rw.x), bfhi(rw.x), bflo(rw.y), bfhi(rw.y)}, ig[4] = {bflo(iw.x), bfhi(iw.x), bflo(iw.y), bfhi(iw.y)}, xc[4] = {bflo(xw.x), bfhi(xw.x), bflo(xw.y), bfhi(xw.y)};
            const float gt[4] = {bflo(gw.x), bfhi(gw.x), bflo(gw.y), bfhi(gw.y)};
            const float4 h0 = *(const float4*)(p.in[2] + (size_t)(J * NS + s) * 1024 + ch); const float h0v[4] = {h0.x, h0.y, h0.z, h0.w}; float h[4];
#pragma unroll
            for (int e = 0; e < 4; ++e) { float a, uu; lru_au(cla[e], r[e], ig[e], xc[e], a, uu); h[e] = a * h0v[e] + uu; }
            *(float4*)(p.out + O_SLH + (size_t)(J * NS + s) * 1024 + ch) = make_float4(h[0], h[1], h[2], h[3]);
            *(u32x2*)(p.HG + row * 1024 + ch) = (u32x2){cvt_pk(h[0] * gt[0], h[1] * gt[1]), cvt_pk(h[2] * gt[2], h[3] * gt[3])};
        }
    }
}

__device__ __forceinline__ void ph_dn_conv(const P& p) {
    const float* cw = p.in[23]; const float* sbuf = p.in[5];
    const int gt = blockIdx.x * NTHREADS + ltid(), nth = gridDim.x * NTHREADS;
    constexpr int RUN = 16, RPS = LP / RUN, NCG = DNQKV / 8;
    for (int it = gt; it < NB * RPS * NCG; it += nth) {
        const int run = it / NCG, cg = it - run * NCG, c0 = cg * 8, b = run / RPS, t0 = (run - b * RPS) * RUN; const bool nrm = c0 < 2048;
        float w[4][8];
#pragma unroll
        for (int e = 0; e < 8; ++e)
#pragma unroll
            for (int j = 0; j < 4; ++j) w[j][e] = cw[j * DNQKV + c0 + e];
        const bf16_t* src = p.PROJ + ((size_t)b * LP + t0) * DNPROJP + c0;
        float x[4][8];
#pragma unroll
        for (int j = 0; j < 3; ++j) { const int back = 3 - j;
            if (t0 >= back) { const u32x4 q = *(const u32x4*)(src - (size_t)back * DNPROJP);
#pragma unroll
                for (int e = 0; e < 4; ++e) { x[j][2 * e] = bflo(q[e]); x[j][2 * e + 1] = bfhi(q[e]); } }
            else {
#pragma unroll
                for (int e = 0; e < 8; ++e) x[j][e] = 0.f; } }
        bf16_t* dst = p.QKVN + ((size_t)b * LP + t0) * DNQKV + c0;
#pragma unroll 4
        for (int r = 0; r < RUN; ++r) {
            const u32x4 q = *(const u32x4*)(src + (size_t)r * DNPROJP);
#pragma unroll
            for (int e = 0; e < 4; ++e) { x[3][2 * e] = bflo(q[e]); x[3][2 * e + 1] = bfhi(q[e]); }
            float y[8]; float ss = 0.f;
#pragma unroll
            for (int e = 0; e < 8; ++e) { y[e] = siluf_(x[0][e] * w[0][e] + x[1][e] * w[1][e] + x[2][e] * w[2][e] + x[3][e] * w[3][e]); ss += y[e] * y[e]; }
            ss += __shfl_xor(ss, 1); ss += __shfl_xor(ss, 2); ss += __shfl_xor(ss, 4); ss += __shfl_xor(ss, 8);
            const float rn = nrm ? rsqrtf(ss + 1e-6f) : 1.0f;
            *(u32x4*)(dst + (size_t)r * DNQKV) = (u32x4){cvt_pk(y[0] * rn, y[1] * rn), cvt_pk(y[2] * rn, y[3] * rn), cvt_pk(y[4] * rn, y[5] * rn), cvt_pk(y[6] * rn, y[7] * rn)};
            const int t = t0 + r;
            if (t >= LP - 3) { float* d = p.out + O_PDC + (size_t)(b * 3 + (t - (LP - 3))) * DNQKV + c0;
                *(float4*)d = make_float4(x[3][0], x[3][1], x[3][2], x[3][3]); *(float4*)(d + 4) = make_float4(x[3][4], x[3][5], x[3][6], x[3][7]); }
#pragma unroll
            for (int e = 0; e < 8; ++e) { x[0][e] = x[1][e]; x[1][e] = x[2][e]; x[2][e] = x[3][e]; }
        }
    }
    for (int it = gt; it < NS * NCG; it += nth) {
        const int s = it / NCG, cg = it - s * NCG, c0 = cg * 8; const size_t row = (size_t)NTOK + s;
        float x[4][8];
        { const u32x4 q = *(const u32x4*)(p.PROJ + row * DNPROJP + c0);
#pragma unroll
          for (int e = 0; e < 4; ++e) { x[3][2 * e] = bflo(q[e]); x[3][2 * e + 1] = bfhi(q[e]); } }
#pragma unroll
        for (int j = 0; j < 3; ++j) { const float* bsrc = sbuf + (size_t)(s * 3 + j) * DNQKV + c0; const float4 a = *(const float4*)bsrc, bq = *(const float4*)(bsrc + 4);
            x[j][0] = a.x; x[j][1] = a.y; x[j][2] = a.z; x[j][3] = a.w; x[j][4] = bq.x; x[j][5] = bq.y; x[j][6] = bq.z; x[j][7] = bq.w; }
#pragma unroll
        for (int j = 0; j < 3; ++j) { float* d = p.out + O_SDC + (size_t)(s * 3 + j) * DNQKV + c0;
            *(float4*)d = make_float4(x[j + 1][0], x[j + 1][1], x[j + 1][2], x[j + 1][3]); *(float4*)(d + 4) = make_float4(x[j + 1][4], x[j + 1][5], x[j + 1][6], x[j + 1][7]); }
        float y[8]; float ss = 0.f;
#pragma unroll
        for (int e = 0; e < 8; ++e) { float a = 0.f;
#pragma unroll
            for (int j = 0; j < 4; ++j) a += x[j][e] * cw[j * DNQKV + c0 + e];
            y[e] = siluf_(a); ss += y[e] * y[e]; }
        ss += __shfl_xor(ss, 1); ss += __shfl_xor(ss, 2); ss += __shfl_xor(ss, 4); ss += __shfl_xor(ss, 8);
        const float rn = (c0 < 2048) ? rsqrtf(ss + 1e-6f) : 1.0f;
        *(u32x4*)(p.QKVN + row * DNQKV + c0) = (u32x4){cvt_pk(y[0] * rn, y[1] * rn), cvt_pk(y[2] * rn, y[3] * rn), cvt_pk(y[4] * rn, y[5] * rn), cvt_pk(y[6] * rn, y[7] * rn)};
    }
    for (int it = gt; it < (NTOK + NS) * 8; it += nth) {
        const int row = it >> 3, hh = it & 7;
        const float bb = p.BA[(size_t)row * 16 + hh], aa = p.BA[(size_t)row * 16 + 8 + hh];
        p.BG[(size_t)row * 16 + hh] = sigmoidf_(bb);
        p.BG[(size_t)row * 16 + 8 + hh] = -__expf(p.in[24][hh]) * softplusf_(aa + p.in[25][hh]);
    }
}

typedef float f32x2 __attribute__((ext_vector_type(2)));
template <int J>
__device__ __forceinline__ void solve_step(f32x2 (&s2)[32], const LAS float* Am) {
    const float sj = (J & 1) ? s2[J >> 1].y : s2[J >> 1].x;
    if constexpr ((J & 1) == 0) s2[J >> 1].y -= Am[J * 64 + J + 1] * sj;
    const f32x2 sjj = {sj, sj};
#pragma unroll
    for (int q = (J >> 1) + 1; q < 32; ++q) s2[q] -= *(const LAS f32x2*)(Am + J * 64 + 2 * q) * sjj;
    if constexpr ((J & 3) == 3) asm volatile("" ::: "memory");
    if constexpr (J + 1 < 63) solve_step<J + 1>(s2, Am);
}
__device__ __forceinline__ void ph_dn_chunk(const P& p, LAS char* smem) {
    constexpr int TP = 136;
    LAS float* Gs = (LAS float*)smem; LAS float* Bsh = Gs + 64; LAS float* gS = Bsh + 64;
    LAS float* Am = gS + 64;
    LAS bf16_t* Qs = (LAS bf16_t*)(Am + 4096); LAS bf16_t* Ks = Qs + 64 * TP; LAS bf16_t* Vs = Ks + 64 * TP;
    LAS bf16_t* SolS = Vs + 64 * TP;
    constexpr int NU3 = NB * NCHUNK * 8;
    for (int u = blockIdx.x; u < NU3; u += gridDim.x) {
        int tid = threadIdx.x; asm volatile("" : "+v"(tid));
        const int lane = tid & 63, wid = tid >> 6, li = lane & 15, lg = lane >> 4;
        {
            const int b = u / (NCHUNK * 8), rem = u - b * (NCHUNK * 8), c = rem >> 3, h = rem & 7;
            const int tbase = (c == 0) ? 0 : 16 + 64 * (c - 1), nvalid = (c == 0) ? 16 : 64;
            const size_t grow0 = (size_t)b * LP + tbase;
#pragma unroll
            for (int i = 0; i < 6; ++i) { const int cidx = tid + NTHREADS * i, which = cidx >> 10, r = (cidx >> 4) & 63, part = cidx & 15;
                u32x4 w = {0u, 0u, 0u, 0u};
                if (r < nvalid) w = *(const u32x4*)(p.QKVN + (grow0 + r) * DNQKV + which * 1024 + h * 128 + part * 8);
                *(LAS u32x4*)(Qs + which * 64 * TP + r * TP + part * 8) = w; }
            if (tid < 64) { const bool v = tid < nvalid; gS[tid] = v ? p.BG[(grow0 + tid) * 16 + 8 + h] : 0.f; Bsh[tid] = v ? p.BG[(grow0 + tid) * 16 + h] : 0.f; }
            __syncthreads();
            if (tid < 64) {
                float a = gS[tid];
#pragma unroll
                for (int o = 1; o < 64; o <<= 1) { const float t = __shfl_up(a, o); if (tid >= o) a += t; }
                Gs[tid] = a; }
            __syncthreads();
            {
#pragma unroll
                for (int tt = 0; tt < 4; ++tt) { const int tl = wid * 4 + tt, isQ = tl >> 4, it = (tl >> 2) & 3, jt = tl & 3;
                    const LAS bf16_t* Ap = (isQ ? Qs : Ks) + (16 * it + li) * TP + lg * 8; const LAS bf16_t* Bp = Ks + (16 * jt + li) * TP + lg * 8;
                    f32x4 acc = {0.f, 0.f, 0.f, 0.f};
#pragma unroll
                    for (int ks = 0; ks < 4; ++ks) acc = mfma16(*(const LAS bf16x8*)(Ap + ks * 32), *(const LAS bf16x8*)(Bp + ks * 32), acc);
                    const int j = 16 * jt + li; const float Gj = Gs[j];
#pragma unroll
                    for (int r = 0; r < 4; ++r) { const int i = 16 * it + 4 * lg + r; const float dec = __expf(Gs[i] - Gj);
                        if (isQ) p.DATT[(size_t)u * 4096 + i * 64 + j] = (bf16_t)(cvt_pk((j <= i) ? acc[r] * 0.08838834764831845f * dec : 0.f, 0.f) & 0xffffu);
                        else Am[j * 64 + i] = (j < i) ? Bsh[i] * acc[r] * dec : 0.f; } }
            }
            __syncthreads();
            if (tid < 256) {
                const int cidx = tid; f32x2 s2[32];
#pragma unroll
                for (int q = 0; q < 32; ++q) {
                    const int i0 = 2 * q, i1 = 2 * q + 1;
                    s2[q].x = (cidx < 128) ? bf2f(Vs[i0 * TP + cidx]) * Bsh[i0] : bf2f(Ks[i0 * TP + cidx - 128]) * Bsh[i0] * __expf(Gs[i0]);
                    s2[q].y = (cidx < 128) ? bf2f(Vs[i1 * TP + cidx]) * Bsh[i1] : bf2f(Ks[i1 * TP + cidx - 128]) * Bsh[i1] * __expf(Gs[i1]); }
                solve_step<0>(s2, Am);
#pragma unroll
                for (int q = 0; q < 32; ++q) { SolS[(2 * q) * 256 + cidx] = (bf16_t)(cvt_pk(s2[q].x, 0.f) & 0xffffu); SolS[(2 * q + 1) * 256 + cidx] = (bf16_t)(cvt_pk(s2[q].y, 0.f) & 0xffffu); }
            } else {
                const int t2 = tid - 256;
                {
                    const int part = t2 & 15, i0 = t2 >> 4;
#pragma unroll
                    for (int k = 0; k < 4; ++k) { const int i = i0 + 16 * k; const float sc = 0.08838834764831845f * __expf(Gs[i]); const u32x4 w = *(const LAS u32x4*)(Qs + i * TP + part * 8); u32x4 o;
#pragma unroll
                        for (int e = 0; e < 4; ++e) o[e] = cvt_pk(bflo(w[e]) * sc, bfhi(w[e]) * sc);
                        *(u32x4*)(p.DQD + (size_t)u * 8192 + i * 128 + part * 8) = o; }
                }
                {
                    const int dk = t2 & 127, half = t2 >> 7; const float Gl = Gs[63]; bf16_t* d = p.DKDt + (size_t)u * 8192 + dk * 64 + half * 32;
#pragma unroll
                    for (int q = 0; q < 4; ++q) { float v[8];
#pragma unroll
                        for (int e = 0; e < 8; ++e) { const int rr = half * 32 + q * 8 + e; v[e] = bf2f(Ks[rr * TP + dk]) * __expf(Gl - Gs[rr]); }
                        u32x4 w; w.x = cvt_pk(v[0], v[1]); w.y = cvt_pk(v[2], v[3]); w.z = cvt_pk(v[4], v[5]); w.w = cvt_pk(v[6], v[7]); *(u32x4*)(d + q * 8) = w; }
                }
                if (t2 == 0) p.DGL[u] = Gs[63];
            }
            __syncthreads();
            {
                const int dv = tid & 127, q = tid >> 7; unsigned w[8];
#pragma unroll
                for (int e = 0; e < 8; ++e) w[e] = (unsigned)SolS[(16 * q + 2 * e) * 256 + dv] | ((unsigned)SolS[(16 * q + 2 * e + 1) * 256 + dv] << 16);
                bf16_t* d = p.DUt + (size_t)u * 8192 + dv * 64 + 16 * q;
                *(u32x4*)d = (u32x4){w[0], w[1], w[2], w[3]}; *(u32x4*)(d + 8) = (u32x4){w[4], w[5], w[6], w[7]};
#pragma unroll
                for (int k = 0; k < 2; ++k) { const int c = tid + NTHREADS * k, row = c >> 4, part = c & 15;
                    *(u32x4*)(p.DW + (size_t)u * 8192 + row * 128 + part * 8) = *(const LAS u32x4*)(SolS + row * 256 + 128 + part * 8); }
            }
            __syncthreads();
        }
    }
    for (int v = ((int)blockIdx.x - NU3 % (int)gridDim.x + (int)gridDim.x) % (int)gridDim.x; v < NS * 8; v += gridDim.x) {
        const int tid = ltid();
        {
            const int s = v >> 3, h = v & 7; const size_t row = (size_t)NTOK + s;
            LAS float* qv = (LAS float*)smem; LAS float* kv = qv + 128; LAS float* red = kv + 128;
            LAS float* dl = red + 1024;
            if (tid < 128) { qv[tid] = bf2f(p.QKVN[row * DNQKV + h * 128 + tid]) * 0.08838834764831845f; kv[tid] = bf2f(p.QKVN[row * DNQKV + 1024 + h * 128 + tid]); }
            __syncthreads();
            const int dv = tid & 127, qd = tid >> 7;
            const float* S0 = p.in[4] + ((size_t)(s * 8 + h) * 128) * 128;
            float sreg[32]; float ks_ = 0.f, qs_ = 0.f;
#pragma unroll
            for (int k = 0; k < 32; ++k) { const int dk = qd * 32 + k; sreg[k] = S0[(size_t)dk * 128 + dv]; ks_ += kv[dk] * sreg[k]; qs_ += qv[dk] * sreg[k]; }
            red[(qd * 128 + dv) * 2] = ks_; red[(qd * 128 + dv) * 2 + 1] = qs_;
            __syncthreads();
            const float beta = p.BG[row * 16 + h], eg = __expf(p.BG[row * 16 + 8 + h]);
            if (tid < 128) {
                float kS = 0.f, qS = 0.f, qk = 0.f;
#pragma unroll
                for (int q = 0; q < 4; ++q) { kS += red[(q * 128 + dv) * 2]; qS += red[(q * 128 + dv) * 2 + 1]; }
                for (int k = 0; k < 128; ++k) qk += qv[k] * kv[k];
                const float vv = bf2f(p.QKVN[row * DNQKV + 2048 + h * 128 + dv]);
                const float delta = beta * (vv - eg * kS);
                p.ORAW[row * 1024 + h * 128 + dv] = eg * qS + qk * delta;
                dl[dv] = delta;
            }
            __syncthreads();
            const float delta = dl[dv];
            float* Sout = p.out + O_SDS + ((size_t)(s * 8 + h) * 128) * 128;
#pragma unroll
            for (int k = 0; k < 32; ++k) { const int dk = qd * 32 + k; Sout[(size_t)dk * 128 + dv] = sreg[k] * eg + kv[dk] * delta; }
            __syncthreads();
        }
    }
}

__device__ __forceinline__ void ph_dn_seq(const P& p, LAS char* smem) {
    constexpr int SP = 136, DP = 72;
    LAS bf16_t* St = (LAS bf16_t*)smem;
    LAS bf16_t* Dt = St + 32 * SP;
    const int tid = ltid(), lane = tid & 63, wid = tid >> 6, li = lane & 15, lg = lane >> 4;
    const int rt = wid >> 1, dt = wid & 1;
    for (int u0 = blockIdx.x; u0 < NB * 8 * 4; u0 += gridDim.x) {
        const int u = (gridDim.x == 256) ? (((u0 & 7) * 8 + (u0 >> 5)) * 4 + ((u0 >> 3) & 3)) : u0;
        const int b = u >> 5, h = (u >> 2) & 7, ds = u & 3;
        f32x4 sacc[2] = {{0.f, 0.f, 0.f, 0.f}, {0.f, 0.f, 0.f, 0.f}};
#pragma unroll
        for (int kk = 0; kk < 2; ++kk) { const int kt = 2 * rt + kk; *(LAS u32x2*)(St + (16 * dt + li) * SP + 16 * kt + 4 * lg) = (u32x2){0u, 0u}; }
        __syncthreads();
        struct Ops { bf16x8 wf[4], qf[4], af[2], kf[2][2]; u32x2 uu; float gl; };
        Ops R0, R1;
        auto fetch = [&](int c, Ops& o) {
            const size_t u3 = (size_t)(b * NCHUNK + c) * 8 + h;
            const bf16_t* Wp = p.DW + u3 * 8192 + (16 * rt + li) * 128 + 8 * lg;
            const bf16_t* Qp = p.DQD + u3 * 8192 + (16 * rt + li) * 128 + 8 * lg;
            const bf16_t* Ap = p.DATT + u3 * 4096 + (16 * rt + li) * 64 + 8 * lg;
            const bf16_t* Kp = p.DKDt + u3 * 8192 + (16 * (2 * rt) + li) * 64 + 8 * lg;
#pragma unroll
            for (int ks = 0; ks < 4; ++ks) { o.wf[ks] = *(const bf16x8*)(Wp + 32 * ks); o.qf[ks] = *(const bf16x8*)(Qp + 32 * ks); }
#pragma unroll
            for (int s2 = 0; s2 < 2; ++s2) { o.af[s2] = *(const bf16x8*)(Ap + 32 * s2); o.kf[0][s2] = *(const bf16x8*)(Kp + 32 * s2); o.kf[1][s2] = *(const bf16x8*)(Kp + 16 * 64 + 32 * s2); }
            o.uu = *(const u32x2*)(p.DUt + u3 * 8192 + (32 * ds + 16 * dt + li) * 64 + 16 * rt + 4 * lg);
            o.gl = p.DGL[u3];
        };
        auto step = [&](int c, const Ops& o) {
            const float eg = __expf(o.gl);
            f32x4 dacc = {0.f, 0.f, 0.f, 0.f}, oacc = {0.f, 0.f, 0.f, 0.f};
#pragma unroll
            for (int ks = 0; ks < 4; ++ks) { const bf16x8 sf = *(const LAS bf16x8*)(St + (16 * dt + li) * SP + 32 * ks + 8 * lg); dacc = mfma16(o.wf[ks], sf, dacc); oacc = mfma16(o.qf[ks], sf, oacc); }
            const float d0 = bflo(o.uu.x) - dacc[0], d1 = bfhi(o.uu.x) - dacc[1], d2 = bflo(o.uu.y) - dacc[2], d3 = bfhi(o.uu.y) - dacc[3];
            *(LAS u32x2*)(Dt + (16 * dt + li) * DP + 16 * rt + 4 * lg) = (u32x2){cvt_pk(d0, d1), cvt_pk(d2, d3)};
            __syncthreads();
            bf16x8 df[2];
#pragma unroll
            for (int s2 = 0; s2 < 2; ++s2) df[s2] = *(const LAS bf16x8*)(Dt + (16 * dt + li) * DP + 32 * s2 + 8 * lg);
#pragma unroll
            for (int s2 = 0; s2 < 2; ++s2) oacc = mfma16(o.af[s2], df[s2], oacc);
#pragma unroll
            for (int kk = 0; kk < 2; ++kk) { sacc[kk] *= eg;
#pragma unroll
                for (int s2 = 0; s2 < 2; ++s2) sacc[kk] = mfma16(o.kf[kk][s2], df[s2], sacc[kk]); }
            {
                const int nvalid = (c == 0) ? 16 : 64, tbase = (c == 0) ? 0 : 16 + 64 * (c - 1);
#pragma unroll
                for (int r = 0; r < 4; ++r) { const int i = 16 * rt + 4 * lg + r; if (i < nvalid) p.ORAW[((size_t)b * LP + tbase + i) * 1024 + h * 128 + 32 * ds + 16 * dt + li] = oacc[r]; }
            }
#pragma unroll
            for (int kk = 0; kk < 2; ++kk) { const int kt = 2 * rt + kk; *(LAS u32x2*)(St + (16 * dt + li) * SP + 16 * kt + 4 * lg) = (u32x2){cvt_pk(sacc[kk][0], sacc[kk][1]), cvt_pk(sacc[kk][2], sacc[kk][3])}; }
            __syncthreads();
        };
        static_assert(NCHUNK % 2 == 1, "dn_seq ring");
        fetch(0, R0); fetch(1, R1);
#pragma unroll 1
        for (int c = 0; c + 1 < NCHUNK; c += 2) {
            step(c, R0);     fetch(c + 2, R0);
            step(c + 1, R1); if (c + 3 < NCHUNK) fetch(c + 3, R1);
        }
        step(NCHUNK - 1, R0);
        float* So = p.out + O_PDS + ((size_t)(b * 8 + h) * 128) * 128;
#pragma unroll
        for (int kk = 0; kk < 2; ++kk)
#pragma unroll
            for (int r = 0; r < 4; ++r) So[(size_t)(16 * (2 * rt + kk) + 4 * lg + r) * 128 + 32 * ds + 16 * dt + li] = sacc[kk][r];
    }
}

__device__ __forceinline__ void ph_dn_onorm(const P& p) {
    const int tid = ltid(), lane = tid & 63, wid = tid >> 6; const float* ng = p.in[26];
    for (int row = blockIdx.x * 8 + wid; row < NTOK + NS; row += gridDim.x * 8) {
#pragma unroll
        for (int it = 0; it < 2; ++it) {
            const int c0 = it * 512 + lane * 8, dv0 = c0 & 127;
            const float4 a = *(const float4*)(p.ORAW + (size_t)row * 1024 + c0), bq = *(const float4*)(p.ORAW + (size_t)row * 1024 + c0 + 4);
            float o[8] = {a.x, a.y, a.z, a.w, bq.x, bq.y, bq.z, bq.w}; float ss = 0.f;
#pragma unroll
            for (int e = 0; e < 8; ++e) ss += o[e] * o[e];
            ss += __shfl_xor(ss, 1); ss += __shfl_xor(ss, 2); ss += __shfl_xor(ss, 4); ss += __shfl_xor(ss, 8);
            const float r = rsqrtf(ss * (1.0f / 128.0f) + RMS_EPS);
            const u32x4 zw = *(const u32x4*)(p.PROJ + (size_t)row * DNPROJP + DNQKV + c0);
            float y[8];
#pragma unroll
            for (int e = 0; e < 4; ++e) { y[2 * e] = o[2 * e] * r * ng[dv0 + 2 * e] * siluf_(bflo(zw[e])); y[2 * e + 1] = o[2 * e + 1] * r * ng[dv0 + 2 * e + 1] * siluf_(bfhi(zw[e])); }
            u32x4 w; w.x = cvt_pk(y[0], y[1]); w.y = cvt_pk(y[2], y[3]); w.z = cvt_pk(y[4], y[5]); w.w = cvt_pk(y[6], y[7]);
            *(u32x4*)(p.ON + (size_t)row * 1024 + c0) = w;
        }
    }
}

__device__ __forceinline__ float rope_freq(int i) { return powf(10000.0f, -(float)i * (1.0f / 32.0f)); }
__device__ __forceinline__ void ph_mla_rows(const P& p) {
    const int tid = ltid(), lane = tid & 63, wid = tid >> 6; const float* qn = p.in[29]; const float* kn = p.in[32];
    for (int row = blockIdx.x * 8 + wid; row < MP; row += gridDim.x * 8) {
        if (row >= NTOK + NS) {
            const u32x4 z = {0u, 0u, 0u, 0u};
            *(u32x4*)(p.CQ + (size_t)row * 512 + lane * 8) = z; if (lane < 32) *(u32x4*)(p.CKVb + (size_t)row * 256 + lane * 8) = z; if (lane < 8) *(u32x4*)(p.KPEb + (size_t)row * 64 + lane * 8) = z;
            continue;
        }
        const float* src = p.DQKV + (size_t)row * 1024;
        {
            const float4 a = *(const float4*)(src + 4 * lane), bq = *(const float4*)(src + 256 + 4 * lane);
            float ss = a.x * a.x + a.y * a.y + a.z * a.z + a.w * a.w + bq.x * bq.x + bq.y * bq.y + bq.z * bq.z + bq.w * bq.w;
            ss = wave_sum(ss); const float r = rsqrtf(ss * (1.0f / 512.0f) + RMS_EPS);
            const float4 g0 = *(const float4*)(qn + 4 * lane), g1 = *(const float4*)(qn + 256 + 4 * lane);
            *(u32x2*)(p.CQ + (size_t)row * 512 + 4 * lane) = (u32x2){cvt_pk(a.x * r * g0.x, a.y * r * g0.y), cvt_pk(a.z * r * g0.z, a.w * r * g0.w)};
            *(u32x2*)(p.CQ + (size_t)row * 512 + 256 + 4 * lane) = (u32x2){cvt_pk(bq.x * r * g1.x, bq.y * r * g1.y), cvt_pk(bq.z * r * g1.z, bq.w * r * g1.w)};
        }
        const bool prompt = row < NTOK; const int b = prompt ? row / LP : 0, t = prompt ? row - b * LP : 0;
        {
            const float4 a = *(const float4*)(src + 512 + 4 * lane);
            float ss = a.x * a.x + a.y * a.y + a.z * a.z + a.w * a.w; ss = wave_sum(ss); const float r = rsqrtf(ss * (1.0f / 256.0f) + RMS_EPS);
            const float4 g0 = *(const float4*)(kn + 4 * lane); const float4 o = make_float4(a.x * r * g0.x, a.y * r * g0.y, a.z * r * g0.z, a.w * r * g0.w);
            float* dst = prompt ? p.out + O_PCKV + (size_t)row * 256 : p.out + O_SCKV + (size_t)(row - NTOK) * 256;
            *(float4*)(dst + 4 * lane) = o;
            *(u32x2*)(p.CKVb + (size_t)row * 256 + 4 * lane) = (u32x2){cvt_pk(o.x, o.y), cvt_pk(o.z, o.w)};
        }
        if (lane < 32) {
            const float x1 = src[768 + lane], x2 = src[800 + lane]; const float pos = prompt ? (float)t : 16384.0f;
            float sn, cs; sincosf(pos * rope_freq(lane), &sn, &cs);
            const float o1 = x1 * cs - x2 * sn, o2 = x1 * sn + x2 * cs;
            float* dst = prompt ? p.out + O_PKPE + (size_t)row * 64 : p.out + O_SKPE + (size_t)(row - NTOK) * 64;
            dst[lane] = o1; dst[32 + lane] = o2;
            p.KPEb[(size_t)row * 64 + lane] = (bf16_t)(cvt_pk(o1, 0.f) & 0xffffu); p.KPEb[(size_t)row * 64 + 32 + lane] = (bf16_t)(cvt_pk(o2, 0.f) & 0xffffu);
        }
    }
}

__device__ __forceinline__ void ph_mla_qlat(const P& p, LAS char* smem) {
    LAS float* Qn = (LAS float*)smem;
    const int tid = ltid(); const float* wuk = p.in[33];
    for (int u = blockIdx.x; u < 32; u += gridDim.x) {
        const int h = u >> 2, cq = u & 3;
        for (int i = tid; i < 32 * 128; i += NTHREADS) { const int s = i >> 7, n = i & 127; Qn[i] = bf2f(p.Q[((size_t)NTOK + s) * 1536 + h * 192 + n]); }
        __syncthreads();
        const int c = cq * 64 + (tid & 63), bg = tid >> 6; float acc[4] = {0.f, 0.f, 0.f, 0.f};
        const float* wr = wuk + (size_t)c * 1024 + h * 128;
#pragma unroll 8
        for (int n4 = 0; n4 < 32; ++n4) { const float4 w = *(const float4*)(wr + 4 * n4);
#pragma unroll
            for (int r = 0; r < 4; ++r) { const LAS float* qr = Qn + (bg * 4 + r) * 128 + 4 * n4; acc[r] += w.x * qr[0] + w.y * qr[1] + w.z * qr[2] + w.w * qr[3]; } }
#pragma unroll
        for (int r = 0; r < 4; ++r) p.QLAT[(size_t)(bg * 4 + r) * 2048 + h * 256 + c] = acc[r];
        if (cq == 0) {
            for (int i = tid; i < 32 * 32; i += NTHREADS) { const int s = i >> 5, d = i & 31; const bf16_t* q = p.Q + ((size_t)NTOK + s) * 1536 + h * 192 + 128;
                const float x1 = bf2f(q[d]), x2 = bf2f(q[32 + d]); float sn, cs; sincosf(16384.0f * rope_freq(d), &sn, &cs);
                p.QPE[(size_t)s * 512 + h * 64 + d] = x1 * cs - x2 * sn; p.QPE[(size_t)s * 512 + h * 64 + 32 + d] = x1 * sn + x2 * cs; }
        }
        __syncthreads();
    }
}

template <int N>
__device__ __forceinline__ void tr_step(float (&v)[32], int lane, int mask) {
    const bool up = (lane & mask) != 0;
#pragma unroll
    for (int i = 0; i < N; ++i) { const float send = up ? v[i] : v[i + N]; const float keep = up ? v[i + N] : v[i]; v[i] = keep + __shfl_xor(send, mask); }
}
__device__ __forceinline__ float readlane_f(float v, int l) { return __int_as_float(__builtin_amdgcn_readlane(__float_as_int(v), l)); }
__device__ __forceinline__ void ph_mla_decode(const P& p, LAS char* smem) {
    LAS float* Om = (LAS float*)smem;
    LAS float* MLs = Om + 8 * 8 * 256;
    const int tid = ltid(), lane = tid & 63, wid = tid >> 6;
    const int* pt = (const int*)p.in[8]; const float* pool_c = p.in[6]; const float* pool_k = p.in[7];
    const float sc = MLA_SCALE * LOG2E;
    for (int u = blockIdx.x; u < NS * 8; u += gridDim.x) {
        const int bq = u >> 3, sp = u & 7;
        f32x2 qlp[4][4], qpp[4];
#pragma unroll
        for (int hp = 0; hp < 4; ++hp) { const float4 a = *(const float4*)(p.QLAT + (size_t)bq * 2048 + (2 * hp) * 256 + 4 * lane), b4 = *(const float4*)(p.QLAT + (size_t)bq * 2048 + (2 * hp + 1) * 256 + 4 * lane);
            qlp[hp][0] = (f32x2){a.x, b4.x}; qlp[hp][1] = (f32x2){a.y, b4.y}; qlp[hp][2] = (f32x2){a.z, b4.z}; qlp[hp][3] = (f32x2){a.w, b4.w};
            qpp[hp] = (f32x2){p.QPE[(size_t)bq * 512 + (2 * hp) * 64 + lane], p.QPE[(size_t)bq * 512 + (2 * hp + 1) * 64 + lane]}; }
        f32x2 O2[8][2];
#pragma unroll
        for (int h = 0; h < 8; ++h) { O2[h][0] = (f32x2){0.f, 0.f}; O2[h][1] = (f32x2){0.f, 0.f}; }
        float m_run = -INFINITY, l_run = 0.f;
        const int pg0 = pt[bq * 128 + sp * 16 + 2 * wid], pg1 = pt[bq * 128 + sp * 16 + 2 * wid + 1];
        float4 cn[4]; float en[4];
        {   const float* cb = pool_c + (size_t)pg0 * 128 * 256; const float* kb = pool_k + (size_t)pg0 * 128 * 64;
#pragma unroll
            for (int k = 0; k < 4; ++k) { cn[k] = *(const float4*)(cb + k * 256 + 4 * lane); en[k] = kb[k * 64 + lane]; } }
        for (int it = 0; it < 64; ++it) {
            float4 c[4]; float e[4];
#pragma unroll
            for (int k = 0; k < 4; ++k) { c[k] = cn[k]; e[k] = en[k]; }
            if (it + 1 < 64) { const int nit = it + 1, pg = (nit < 32) ? pg0 : pg1, kb4 = (nit & 31) * 4;
                const float* cb = pool_c + ((size_t)pg * 128 + kb4) * 256; const float* kb = pool_k + ((size_t)pg * 128 + kb4) * 64;
#pragma unroll
                for (int k = 0; k < 4; ++k) { cn[k] = *(const float4*)(cb + k * 256 + 4 * lane); en[k] = kb[k * 64 + lane]; } }
            float part[32];
#pragma unroll
            for (int k = 0; k < 4; ++k)
#pragma unroll
                for (int hp = 0; hp < 4; ++hp) { const f32x2 t2 = qlp[hp][0] * c[k].x + qlp[hp][1] * c[k].y + qlp[hp][2] * c[k].z + qlp[hp][3] * c[k].w + qpp[hp] * e[k];
                    part[k * 8 + 2 * hp] = t2.x; part[k * 8 + 2 * hp + 1] = t2.y; }
#pragma unroll
            for (int i = 0; i < 16; ++i) { swap32(part[i], part[i + 16]); part[i] += part[i + 16]; }
#pragma unroll
            for (int i = 0; i < 8; ++i) { swap16(part[i], part[i + 8]); part[i] += part[i + 8]; }
            tr_step<4>(part, lane, 8); tr_step<2>(part, lane, 4); tr_step<1>(part, lane, 2);
            float s = (part[0] + __shfl_xor(part[0], 1)) * sc;
            float m4 = max_x32(max_x16(s));
            const float m_new = fmaxf(m_run, m4), alpha = __builtin_amdgcn_exp2f(m_run - m_new), pr = __builtin_amdgcn_exp2f(s - m_new);
            const float ps = sum_x32(sum_x16(pr));
            l_run = l_run * alpha + ps; m_run = m_new;
#pragma unroll
            for (int h = 0; h < 8; ++h) {
                const float al = readlane_f(alpha, 2 * h);
                f32x2 o0 = O2[h][0] * al, o1 = O2[h][1] * al;
#pragma unroll
                for (int k = 0; k < 4; ++k) { const float pk = readlane_f(pr, 16 * k + 2 * h); o0 += (f32x2){c[k].x, c[k].y} * pk; o1 += (f32x2){c[k].z, c[k].w} * pk; }
                O2[h][0] = o0; O2[h][1] = o1;
            }
        }
#pragma unroll
        for (int h = 0; h < 8; ++h) *(LAS f32x4*)(Om + (wid * 8 + h) * 256 + 4 * lane) = (f32x4){O2[h][0].x, O2[h][0].y, O2[h][1].x, O2[h][1].y};
        if (lane < 16 && (lane & 1) == 0) { MLs[(wid * 8 + (lane >> 1)) * 2] = m_run; MLs[(wid * 8 + (lane >> 1)) * 2 + 1] = l_run; }
        __syncthreads();
#pragma unroll
        for (int i = 0; i < 4; ++i) { const int idx = tid + NTHREADS * i, h = idx >> 8, c = idx & 255;
            float M = -INFINITY;
#pragma unroll
            for (int w = 0; w < 8; ++w) M = fmaxf(M, MLs[(w * 8 + h) * 2]);
            float val = 0.f, L = 0.f;
#pragma unroll
            for (int w = 0; w < 8; ++w) { const float f = __builtin_amdgcn_exp2f(MLs[(w * 8 + h) * 2] - M); val += f * Om[(w * 8 + h) * 256 + c]; L += f * MLs[(w * 8 + h) * 2 + 1]; }
            p.PART[((size_t)(bq * 8 + sp) * 8 + h) * 256 + c] = val;
            if (c == 0) { p.ML[((size_t)(bq * 8 + sp) * 8 + h) * 2] = M; p.ML[((size_t)(bq * 8 + sp) * 8 + h) * 2 + 1] = L; }
        }
        __syncthreads();
    }
}

__device__ __forceinline__ void ph_mla_combine(const P& p, LAS char* smem) {
    LAS float* OL = (LAS float*)smem;
    const int tid = ltid(), lane = tid & 63, wid = tid >> 6; const float sc = MLA_SCALE * LOG2E;
    for (int bq = blockIdx.x; bq < NS; bq += gridDim.x) {
        const int h = wid;
        const float4 cnew = *(const float4*)(p.out + O_SCKV + (size_t)bq * 256 + 4 * lane); const float knew = p.out[O_SKPE + (size_t)bq * 64 + lane];
        const float4 ql = *(const float4*)(p.QLAT + (size_t)bq * 2048 + h * 256 + 4 * lane); const float qp = p.QPE[(size_t)bq * 512 + h * 64 + lane];
        float ss = cnew.x * ql.x + cnew.y * ql.y + cnew.z * ql.z + cnew.w * ql.w + knew * qp; ss = wave_sum(ss) * sc;
        float M = ss;
#pragma unroll
        for (int s = 0; s < 8; ++s) M = fmaxf(M, p.ML[((size_t)(bq * 8 + s) * 8 + h) * 2]);
        const float fs = __builtin_amdgcn_exp2f(ss - M); float L = fs; float4 o = make_float4(fs * cnew.x, fs * cnew.y, fs * cnew.z, fs * cnew.w);
#pragma unroll
        for (int s = 0; s < 8; ++s) { const float f = __builtin_amdgcn_exp2f(p.ML[((size_t)(bq * 8 + s) * 8 + h) * 2] - M); L += f * p.ML[((size_t)(bq * 8 + s) * 8 + h) * 2 + 1];
            const float4 pv = *(const float4*)(p.PART + ((size_t)(bq * 8 + s) * 8 + h) * 256 + 4 * lane); o.x += f * pv.x; o.y += f * pv.y; o.z += f * pv.z; o.w += f * pv.w; }
        const float inv = 1.0f / L;
        *(LAS f32x4*)(OL + h * 256 + 4 * lane) = (f32x4){o.x * inv, o.y * inv, o.z * inv, o.w * inv};
        __syncthreads();
        const float* wuv = p.in[34];
#pragma unroll
        for (int i = 0; i < 2; ++i) { const int idx = tid + NTHREADS * i, hh = idx >> 7, v = idx & 127; float acc = 0.f;
#pragma unroll 16
            for (int c = 0; c < 256; ++c) acc += OL[hh * 256 + c] * wuv[(size_t)c * 1024 + hh * 128 + v];
            p.AO[((size_t)NTOK + bq) * 1024 + hh * 128 + v] = (bf16_t)(cvt_pk(acc, 0.f) & 0xffffu); }
        __syncthreads();
    }
}

__device__ __forceinline__ void ph_mla_attn(const P& p, LAS char* smem) {
    constexpr int KP = 200, VP = 144;
    constexpr int KT_BYTES = 64 * KP * 2, VT_BYTES = 64 * VP * 2, STG = KT_BYTES + VT_BYTES;
    const int tid = ltid(), lane = tid & 63, wid = tid >> 6, li = lane & 15, lg = lane >> 4;
    const int G = gridDim.x; const float sc = MLA_SCALE * LOG2E;
    constexpr int NQB = 9, NUNITS = NB * 8 * NQB;
    for (int j = 0;; ++j) {
        const int idx = j * G + ((j & 1) ? (G - 1 - (int)blockIdx.x) : (int)blockIdx.x);
        if (j * G >= NUNITS) break;
        if (idx >= NUNITS) continue;
        const int qb = (NQB - 1) - idx / 64, bh = idx & 63, b = bh >> 3, h = bh & 7;
        const int t0 = qb * 256, nq = (LP - t0) < 256 ? (LP - t0) : 256, kend = t0 + nq, nkt = (kend + 63) >> 6;
        const int tq0 = t0 + 32 * wid + li;
        bf16x8 qf[2][6];
#pragma unroll
        for (int rt = 0; rt < 2; ++rt) { const int tq = tq0 + 16 * rt, tqc = tq < LP ? tq : LP - 1;
            const bf16_t* qsrc = p.Q + ((size_t)b * LP + tqc) * 1536 + h * 192 + 8 * lg;
#pragma unroll
            for (int ks = 0; ks < 6; ++ks) qf[rt][ks] = *(const bf16x8*)(qsrc + 32 * ks);
#pragma unroll
            for (int e = 0; e < 8; ++e) { const float x1 = bf2f((unsigned short)qf[rt][4][e]), x2 = bf2f((unsigned short)qf[rt][5][e]);
                const float ang_ = (float)tqc * __builtin_amdgcn_exp2f(-0.41524101186092033f * (float)(8 * lg + e)); const float sn = __sinf(ang_), cs = __cosf(ang_);
                qf[rt][4][e] = (short)(cvt_pk(x1 * cs - x2 * sn, 0.f) & 0xffffu); qf[rt][5][e] = (short)(cvt_pk(x1 * sn + x2 * cs, 0.f) & 0xffffu); } }
        f32x4 oacc[2][8];
#pragma unroll
        for (int rt = 0; rt < 2; ++rt)
#pragma unroll
            for (int ct = 0; ct < 8; ++ct) oacc[rt][ct] = (f32x4){0.f, 0.f, 0.f, 0.f};
        float m_run[2] = {-INFINITY, -INFINITY}, l_run[2] = {0.f, 0.f};
        u32x4 rgA[5];
        auto gload = [&](int kt, u32x4 (&rg)[5]) {
            int tl = tid; asm volatile("" : "+v"(tl));
#pragma unroll
            for (int i = 0; i < 5; ++i) { const int c = tl + NTHREADS * i; int key, part; const bf16_t* src;
                if (c < 1024) { key = c >> 4; part = c & 15; } else if (c < 1536) { key = (c - 1024) >> 3; part = (c - 1024) & 7; } else { key = (c - 1536) >> 4; part = (c - 1536) & 15; }
                int kr = kt * 64 + key; kr = kr < LP ? kr : LP - 1; const size_t grow = (size_t)b * LP + kr;
                if (c < 1024) src = p.KV + grow * 2048 + h * 128 + part * 8; else if (c < 1536) src = p.KPEb + grow * 64 + part * 8; else src = p.KV + grow * 2048 + 1024 + h * 128 + part * 8;
                rg[i] = *(const u32x4*)src; } };
        auto sstore = [&](int st, const u32x4 (&rg)[5]) {
            LAS bf16_t* Kt = (LAS bf16_t*)(smem + st * STG); LAS bf16_t* Vt = (LAS bf16_t*)(smem + st * STG + KT_BYTES);
            int tl = tid; asm volatile("" : "+v"(tl));
#pragma unroll
            for (int i = 0; i < 5; ++i) { const int c = tl + NTHREADS * i;
                if (c < 1024) *(LAS u32x4*)(Kt + (c >> 4) * KP + (c & 15) * 8) = rg[i];
                else if (c < 1536) *(LAS u32x4*)(Kt + ((c - 1024) >> 3) * KP + 128 + ((c - 1024) & 7) * 8) = rg[i];
                else *(LAS u32x4*)(Vt + ((c - 1536) >> 4) * VP + ((c - 1536) & 15) * 8) = rg[i]; } };
        auto compute = [&](int kt, int st) {
            if (kt * 64 > t0 + 32 * wid + 31) return;
            const LAS bf16_t* Kt = (const LAS bf16_t*)(smem + st * STG); const LAS bf16_t* Vt = (const LAS bf16_t*)(smem + st * STG + KT_BYTES);
            f32x4 sacc[2][4];
#pragma unroll
            for (int rt = 0; rt < 2; ++rt)
#pragma unroll
                for (int k4 = 0; k4 < 4; ++k4) sacc[rt][k4] = (f32x4){0.f, 0.f, 0.f, 0.f};
#pragma unroll
            for (int ks = 0; ks < 6; ++ks)
#pragma unroll
                for (int k4 = 0; k4 < 4; ++k4) { const bf16x8 kf = *(const LAS bf16x8*)(Kt + (16 * k4 + li) * KP + 32 * ks + 8 * lg);
                    sacc[0][k4] = mfma16(kf, qf[0][ks], sacc[0][k4]); sacc[1][k4] = mfma16(kf, qf[1][ks], sacc[1][k4]);
                    if (k4 == 3 && (ks & 1)) asm volatile("" ::: "memory"); }
            bf16x8 pf[2][2];
#pragma unroll
            for (int rt = 0; rt < 2; ++rt) {
                const int tq = tq0 + 16 * rt;
                const bool diag = kt * 64 + 63 > t0 + 32 * wid + 16 * rt;
                float mx = -INFINITY;
                if (diag) {
#pragma unroll
                    for (int k4 = 0; k4 < 4; ++k4)
#pragma unroll
                        for (int r = 0; r < 4; ++r) { const int key = kt * 64 + 16 * k4 + 4 * lg + r; const float sv = (key <= tq) ? sacc[rt][k4][r] * sc : -INFINITY; sacc[rt][k4][r] = sv; mx = fmaxf(mx, sv); }
                } else {
#pragma unroll
                    for (int k4 = 0; k4 < 4; ++k4) { sacc[rt][k4] *= sc; mx = fmaxf(fmaxf(mx, fmaxf(sacc[rt][k4][0], sacc[rt][k4][1])), fmaxf(sacc[rt][k4][2], sacc[rt][k4][3])); }
                }
                mx = max_x32(max_x16(mx));
                const float m_new = fmaxf(m_run[rt], mx), alpha = __builtin_amdgcn_exp2f(m_run[rt] - m_new); float rs = 0.f;
#pragma unroll
                for (int k4 = 0; k4 < 4; ++k4)
#pragma unroll
                    for (int r = 0; r < 4; ++r) { const float pv = __builtin_amdgcn_exp2f(sacc[rt][k4][r] - m_new); sacc[rt][k4][r] = pv; rs += pv; }
                rs = sum_x32(sum_x16(rs));
                l_run[rt] = l_run[rt] * alpha + rs; m_run[rt] = m_new;
                if (__any(alpha != 1.0f)) {
#pragma unroll
                    for (int ct = 0; ct < 8; ++ct) oacc[rt][ct] *= alpha; }
#pragma unroll
                for (int s2 = 0; s2 < 2; ++s2) { const u32x4 w = {cvt_pk(sacc[rt][2 * s2][0], sacc[rt][2 * s2][1]), cvt_pk(sacc[rt][2 * s2][2], sacc[rt][2 * s2][3]), cvt_pk(sacc[rt][2 * s2 + 1][0], sacc[rt][2 * s2 + 1][1]), cvt_pk(sacc[rt][2 * s2 + 1][2], sacc[rt][2 * s2 + 1][3])};
                    pf[rt][s2] = __builtin_bit_cast(bf16x8, w); }
            }
#pragma unroll
            for (int ct = 0; ct < 8; ++ct)
#pragma unroll
                for (int s2 = 0; s2 < 2; ++s2) {
                    const s16x4 lo = __builtin_amdgcn_ds_read_tr16_b64_v4i16((LAS s16x4*)(Vt + (32 * s2 + 4 * lg + (li >> 2)) * VP + 16 * ct + 4 * (li & 3)));
                    const s16x4 hi = __builtin_amdgcn_ds_read_tr16_b64_v4i16((LAS s16x4*)(Vt + (32 * s2 + 16 + 4 * lg + (li >> 2)) * VP + 16 * ct + 4 * (li & 3)));
                    const bf16x8 vf = {lo[0], lo[1], lo[2], lo[3], hi[0], hi[1], hi[2], hi[3]};
                    oacc[0][ct] = mfma16(vf, pf[0][s2], oacc[0][ct]); oacc[1][ct] = mfma16(vf, pf[1][s2], oacc[1][ct]);
                    if (s2 == 1 && (ct & 1)) asm volatile("" ::: "memory");
                }
        };
        gload(0, rgA); sstore(0, rgA);
        __syncthreads();
#pragma unroll 1
        for (int kt = 0; kt < nkt; ++kt) {
            const int st = kt & 1;
            if (kt + 1 < nkt) gload(kt + 1, rgA);
            compute(kt, st);
            if (kt + 1 < nkt) sstore(st ^ 1, rgA);
            __syncthreads();
        }
#pragma unroll
        for (int rt = 0; rt < 2; ++rt) { const int tq = tq0 + 16 * rt;
            if (tq < LP) { const float inv = 1.0f / l_run[rt]; bf16_t* dst = p.AO + ((size_t)b * LP + tq) * 1024 + h * 128 + 4 * lg;
#pragma unroll
                for (int ct = 0; ct < 8; ++ct) *(u32x2*)(dst + 16 * ct) = (u32x2){cvt_pk(oacc[rt][ct][0] * inv, oacc[rt][ct][1] * inv), cvt_pk(oacc[rt][ct][2] * inv, oacc[rt][ct][3] * inv)}; } }
    }
}

constexpr int NPHASES = 43;
template <int PH>
__device__ __forceinline__ void run_phase(const LAS PG* pl, LAS char* smem) {
    const P p = glob(pl);
    if constexpr (PH == 0) { ph_init(p, smem); return; }
    if constexpr (PH == 42) {
        ph_final_norm(p);
        return; }
    constexpr int layer = PH <= 10 ? 0 : PH <= 20 ? 1 : PH <= 31 ? 2 : 3;
    constexpr int base = layer == 0 ? 1 : layer == 1 ? 11 : layer == 2 ? 21 : 32;
    constexpr int sub = PH - base;
    constexpr int nmix = layer == 2 ? 8 : 7;
    if constexpr (sub == 0 || sub == nmix) return;
    if constexpr (sub == nmix + 1) { norm_gemm(p, p.Wgu + (size_t)layer * 5632 * 1024, 5632, 2 * layer + 1, EpiGU{uni(p.HF)}, smem); return; }
    if constexpr (sub == nmix + 2) { resid_gemm(p, p.HF, p.Wdown + (size_t)layer * 1024 * DFF, DFF, layer < 3 ? 2 * layer + 2 : -1, smem); return; }
    if constexpr (layer == 0 || layer == 3) {
        constexpr int J = layer == 0 ? 0 : 1;
        if constexpr (sub == 1) { norm_gemm(p, p.Wlru_in + (size_t)J * 2048 * 1024, 2048, 2 * layer, EpiLruIn{uni(p.G1)}, smem); }
        if constexpr (sub == 2) ph_lru_conv<J>(p);
        if constexpr (sub == 3) {
            const bf16_t* A = uni((const bf16_t*)p.XC); const bf16_t* Bt = uni((const bf16_t*)(p.Wlru_gate + (size_t)J * 2048 * 256));
            const EpiGate e{uni(p.RI), uni((const float*)p.BCAT) + J * 2048};
            pg8::Gemm g{A, Bt, 4 * MP, 2048, 256}; GateOrder S{(int)gridDim.x, (int)blockIdx.x};
            PgEpiGate pe{e};
            pg8::gemm_phase<PgEpiGate, GateOrder, true, true>((LAS unsigned char*)smem, g, S, pe);
            __syncthreads();
            gemm_small<false>(A, 256, Bt, 256, 2048, MMAIN, 3, 1, e, smem, nullptr, 512); }
        if constexpr (sub == 4) ph_scan1<J>(p);
        if constexpr (sub == 5) ph_scan2<J>(p);
        if constexpr (sub == 6) { resid_gemm(p, p.HG, p.Wlru_out + (size_t)J * 1048576, 1024, 2 * layer + 1, smem); }
    }
    if constexpr (layer == 1) {
        if constexpr (sub == 1) { norm_gemm(p, p.Wdn_in, DNPROJP, 2 * layer, EpiDnIn{uni(p.PROJ), uni(p.BA)}, smem); }
        if constexpr (sub == 2) ph_dn_conv(p);
        if constexpr (sub == 3) ph_dn_chunk(p, smem);
        if constexpr (sub == 4) ph_dn_seq(p, smem);
        if constexpr (sub == 5) ph_dn_onorm(p);
        if constexpr (sub == 6) { resid_gemm(p, p.ON, p.Wdn_out, 1024, 2 * layer + 1, smem); }
    }
    if constexpr (layer == 2) {
        if constexpr (sub == 1) { norm_gemm(p, p.Wmla_d, 1024, 2 * layer, EpiF32{uni(p.DQKV), 1024}, smem); }
        if constexpr (sub == 2) ph_mla_rows(p);
        if constexpr (sub == 3) { big_gemm(p.CQ, p.Wmla_uq, 1536, 512, EpiBf16{uni(p.Q), 1536}, smem); __syncthreads();
                                  big_gemm(p.CKVb, p.Wmla_kvup, 2048, 256, EpiBf16{uni(p.KV), 2048}, smem); }
        if constexpr (sub == 4) ph_mla_qlat(p, smem);
        if constexpr (sub == 5) { ph_mla_decode(p, smem);
            ph_mla_attn(p, smem); }
        if constexpr (sub == 6) ph_mla_combine(p, smem);
        if constexpr (sub == 7) { resid_gemm(p, p.AO, p.Wmla_o, 1024, 2 * layer + 1, smem); }
    }
}

extern __shared__ __attribute__((aligned(16))) char smem_raw[];

constexpr bool phase_active(int ph) {
    if (ph == 0 || ph == 42) return true;
    const int layer = ph <= 10 ? 0 : ph <= 20 ? 1 : ph <= 31 ? 2 : 3, base = layer == 0 ? 1 : layer == 1 ? 11 : layer == 2 ? 21 : 32, sub = ph - base, nmix = layer == 2 ? 8 : 7;
    return !(sub == 0 || sub == nmix);
}
template <int PH>
__device__ __forceinline__ void run_all(const LAS PG* p, LAS char* smem, const XcdBarrier& bar) {
    if constexpr (phase_active(PH)) { run_phase<PH>(p, smem); if constexpr (PH + 1 < NPHASES) xcd_barrier(bar); }
    if constexpr (PH + 1 < NPHASES) run_all<PH + 1>(p, smem, bar);
}
__global__ void __launch_bounds__(NTHREADS, 2) k_mega(P p) {
    LAS char* smem = (LAS char*)smem_raw;
    LAS unsigned long long* lp = (LAS unsigned long long*)(smem + LDS_BYTES - 2048);
    { const unsigned long long* src = (const unsigned long long*)&p; for (int i = threadIdx.x; i < (int)(sizeof(P) / 8); i += NTHREADS) lp[i] = src[i]; }
    LAS unsigned* xbw = (LAS unsigned*)(smem + LDS_BYTES - 16);
    if (threadIdx.x == 0) { xbw[0] = 0u; xbw[1] = 0u; xbw[2] = 0u; xbw[3] = 0u; }
    __syncthreads();
    const LAS PG* q = (const LAS PG*)lp;
    XcdBarrier bar = xcd_barrier_post((unsigned*)q->bar, (volatile LAS unsigned*)xbw);
    run_all<0>(q, smem, bar);
}

extern "C" void kernel_launch(void* const* d_in, const int* in_sizes, int n_in, void* d_out, int out_size, void* d_ws, size_t ws_size, hipStream_t stream) {
    (void)in_sizes; (void)n_in; (void)out_size;
    P p{};
    for (int i = 0; i < 38; ++i) p.in[i] = (const float*)d_in[i];
    p.out = (float*)d_out;
    char* w = (char*)d_ws; size_t off = 0;
    auto take = [&](size_t bytes) { void* r = w + off; off += (bytes + 255) & ~(size_t)255; return r; };
    p.bar = (unsigned*)take(XCD_BAR_WORDS * 4);
    p.X = (float*)take((size_t)MP * D * 4); p.H = (bf16_t*)take((size_t)MP * D * 2); p.SS = (float*)take((size_t)8 * MP * 16 * 4);
    p.G1 = (bf16_t*)take((size_t)MP * 2048 * 2); p.XC = (bf16_t*)take((size_t)MP * 1024 * 2); p.RI = (bf16_t*)take((size_t)MP * 2048 * 2); p.HG = (bf16_t*)take((size_t)MP * 1024 * 2);
    p.CP = (float*)take((size_t)NB * SCH * 1024 * 4); p.CH = (float*)take((size_t)NB * SCH * 1024 * 4); p.BCAT = (float*)take((size_t)2 * 2048 * 4);
    p.PROJ = (bf16_t*)take((size_t)MP * DNPROJP * 2); p.BA = (float*)take((size_t)MP * 16 * 4); p.BG = (float*)take((size_t)MP * 16 * 4); p.QKVN = (bf16_t*)take((size_t)MP * DNQKV * 2);
    const size_t nu3 = (size_t)NB * NCHUNK * 8;
    p.DW = (bf16_t*)take(nu3 * 8192 * 2); p.DUt = (bf16_t*)take(nu3 * 8192 * 2); p.DQD = (bf16_t*)take(nu3 * 8192 * 2); p.DKDt = (bf16_t*)take(nu3 * 8192 * 2); p.DATT = (bf16_t*)take(nu3 * 4096 * 2);
    p.DGL = (float*)take(nu3 * 4); p.ORAW = (float*)take((size_t)MP * 1024 * 4); p.ON = (bf16_t*)take((size_t)MP * 1024 * 2);
    p.DQKV = (float*)take((size_t)MP * 1024 * 4); p.CQ = (bf16_t*)take((size_t)MP * 512 * 2); p.CKVb = (bf16_t*)take((size_t)MP * 256 * 2); p.KPEb = (bf16_t*)take((size_t)MP * 64 * 2);
    p.Q = (bf16_t*)take((size_t)MP * 1536 * 2); p.KV = (bf16_t*)take((size_t)MP * 2048 * 2); p.AO = (bf16_t*)take((size_t)MP * 1024 * 2);
    p.QLAT = (float*)take((size_t)NS * 2048 * 4); p.QPE = (float*)take((size_t)NS * 512 * 4); p.PART = (float*)take((size_t)NS * 8 * 8 * 256 * 4); p.ML = (float*)take((size_t)NS * 8 * 8 * 2 * 4);
    p.HF = (bf16_t*)take((size_t)MP * DFF * 2);
    p.Wlru_in = (bf16_t*)take((size_t)2 * 2048 * 1024 * 2); p.Wlru_gate = (bf16_t*)take((size_t)2 * 2048 * 256 * 2); p.Wlru_out = (bf16_t*)take((size_t)2 * 1048576 * 2);
    p.Wdn_in = (bf16_t*)take((size_t)DNPROJP * 1024 * 2); p.Wdn_out = (bf16_t*)take((size_t)1048576 * 2);
    p.Wmla_d = (bf16_t*)take((size_t)1024 * 1024 * 2); p.Wmla_uq = (bf16_t*)take((size_t)1536 * 512 * 2); p.Wmla_kvup = (bf16_t*)take((size_t)2048 * 256 * 2); p.Wmla_o = (bf16_t*)take((size_t)1048576 * 2);
    p.Wgu = (bf16_t*)take((size_t)4 * 5632 * 1024 * 2); p.Wdown = (bf16_t*)take((size_t)4 * 1024 * DFF * 2);
    if (off > ws_size) return;
    static int grid = 0;
    if (!grid) { int dev = 0, cus = 0; (void)hipGetDevice(&dev); (void)hipDeviceGetAttribute(&cus, hipDeviceAttributeMultiprocessorCount, dev); grid = (cus > 0 && cus < 256) ? cus : 256; }
    static bool attr_done = false;
    if (!attr_done) { (void)hipFuncSetAttribute((const void*)k_mega, hipFuncAttributeMaxDynamicSharedMemorySize, LDS_BYTES); attr_done = true; }
    (void)hipMemsetAsync(p.bar, 0, XCD_BAR_WORDS * 4, stream);
    hipLaunchKernelGGL(k_mega, dim3(grid), dim3(NTHREADS), LDS_BYTES, stream, p);
}
```

```cpp
#include <hip/hip_runtime.h>
#include <stdint.h>
#include <stdio.h>
#include <type_traits>


#define LAS __attribute__((address_space(3)))
typedef unsigned short bf16_t;
typedef short bf16x8 __attribute__((ext_vector_type(8)));
typedef short s16x4 __attribute__((ext_vector_type(4)));
typedef float f32x4 __attribute__((ext_vector_type(4)));
typedef unsigned u32x2 __attribute__((ext_vector_type(2)));
typedef unsigned u32x4 __attribute__((ext_vector_type(4)));

constexpr int D = 1024, NB = 8, NMETA = 16, LP = 2064, NTOK = NB * LP  , NS = 32, MP = 16640, NPANEL = 65;
constexpr int DFF = 2816, DNQKV = 3072, DNPROJ = 4112, DNPROJP = 4352;
constexpr int NCHUNK = 33;
constexpr int SCH = 48, SCL = 43;
constexpr int NTHREADS = 512;
constexpr int MMAIN = 16384;
constexpr int LDS_BYTES = 135168;
constexpr float RMS_EPS = 1e-6f;
constexpr float LOG2E = 1.4426950408889634f;
constexpr float MLA_SCALE = 0.07216878364870322f;

constexpr size_t O_YP = 0, O_YS = 16777216, O_PLH = O_YS + 32768, O_PLC = O_PLH + 16384, O_PDS = O_PLC + 49152, O_PDC = O_PDS + 1048576,
                 O_PCKV = O_PDC + 73728, O_PKPE = O_PCKV + 4227072, O_SLH = O_PKPE + 1056768, O_SLC = O_SLH + 65536, O_SDS = O_SLC + 196608,
                 O_SDC = O_SDS + 4194304, O_SCKV = O_SDC + 294912, O_SKPE = O_SCKV + 8192;

struct P {
    const float* in[38];
    float* out;
    unsigned* bar;
    float* X; bf16_t* H; float* SS;
    bf16_t *G1, *XC, *RI, *HG; float *CP, *CH; float* BCAT;
    bf16_t* PROJ; float *BA, *BG; bf16_t* QKVN; bf16_t *DW, *DUt, *DQD, *DKDt, *DATT; float* DGL; float* ORAW; bf16_t* ON;
    float* DQKV; bf16_t *CQ, *CKVb, *KPEb, *Q, *KV, *AO; float *QLAT, *QPE, *PART, *ML;
    bf16_t* HF;
    bf16_t *Wlru_in, *Wlru_gate, *Wlru_out, *Wdn_in, *Wdn_out, *Wmla_d, *Wmla_uq, *Wmla_kvup, *Wmla_o, *Wgu, *Wdown;
};

#define GASP __attribute__((address_space(1)))
struct PG {
    GASP const float* in[38];
    GASP float* out;
    GASP unsigned* bar;
    GASP float* X; GASP bf16_t* H; GASP float* SS;
    GASP bf16_t *G1, *XC, *RI, *HG; GASP float *CP, *CH; GASP float* BCAT;
    GASP bf16_t* PROJ; GASP float *BA, *BG; GASP bf16_t* QKVN; GASP bf16_t *DW, *DUt, *DQD, *DKDt, *DATT; GASP float* DGL; GASP float* ORAW; GASP bf16_t* ON;
    GASP float* DQKV; GASP bf16_t *CQ, *CKVb, *KPEb, *Q, *KV, *AO; GASP float *QLAT, *QPE, *PART, *ML;
    GASP bf16_t* HF;
    GASP bf16_t *Wlru_in, *Wlru_gate, *Wlru_out, *Wdn_in, *Wdn_out, *Wmla_d, *Wmla_uq, *Wmla_kvup, *Wmla_o, *Wgu, *Wdown;
};
static_assert(sizeof(PG) == sizeof(P), "PG layout");
__device__ __forceinline__ P glob(const LAS PG* gp) {
    const LAS PG& g = *gp; P q;
#pragma unroll
    for (int i = 0; i < 38; ++i) q.in[i] = (const float*)g.in[i];
    q.out = (decltype(q.out))g.out;
    q.bar = (decltype(q.bar))g.bar;
    q.X = (decltype(q.X))g.X;
    q.H = (decltype(q.H))g.H;
    q.SS = (decltype(q.SS))g.SS;
    q.G1 = (decltype(q.G1))g.G1;
    q.XC = (decltype(q.XC))g.XC;
    q.RI = (decltype(q.RI))g.RI;
    q.HG = (decltype(q.HG))g.HG;
    q.CP = (decltype(q.CP))g.CP;
    q.CH = (decltype(q.CH))g.CH;
    q.BCAT = (decltype(q.BCAT))g.BCAT;
    q.PROJ = (decltype(q.PROJ))g.PROJ;
    q.BA = (decltype(q.BA))g.BA;
    q.BG = (decltype(q.BG))g.BG;
    q.QKVN = (decltype(q.QKVN))g.QKVN;
    q.DW = (decltype(q.DW))g.DW;
    q.DUt = (decltype(q.DUt))g.DUt;
    q.DQD = (decltype(q.DQD))g.DQD;
    q.DKDt = (decltype(q.DKDt))g.DKDt;
    q.DATT = (decltype(q.DATT))g.DATT;
    q.DGL = (decltype(q.DGL))g.DGL;
    q.ORAW = (decltype(q.ORAW))g.ORAW;
    q.ON = (decltype(q.ON))g.ON;
    q.DQKV = (decltype(q.DQKV))g.DQKV;
    q.CQ = (decltype(q.CQ))g.CQ;
    q.CKVb = (decltype(q.CKVb))g.CKVb;
    q.KPEb = (decltype(q.KPEb))g.KPEb;
    q.Q = (decltype(q.Q))g.Q;
    q.KV = (decltype(q.KV))g.KV;
    q.AO = (decltype(q.AO))g.AO;
    q.QLAT = (decltype(q.QLAT))g.QLAT;
    q.QPE = (decltype(q.QPE))g.QPE;
    q.PART = (decltype(q.PART))g.PART;
    q.ML = (decltype(q.ML))g.ML;
    q.HF = (decltype(q.HF))g.HF;
    q.Wlru_in = (decltype(q.Wlru_in))g.Wlru_in;
    q.Wlru_gate = (decltype(q.Wlru_gate))g.Wlru_gate;
    q.Wlru_out = (decltype(q.Wlru_out))g.Wlru_out;
    q.Wdn_in = (decltype(q.Wdn_in))g.Wdn_in;
    q.Wdn_out = (decltype(q.Wdn_out))g.Wdn_out;
    q.Wmla_d = (decltype(q.Wmla_d))g.Wmla_d;
    q.Wmla_uq = (decltype(q.Wmla_uq))g.Wmla_uq;
    q.Wmla_kvup = (decltype(q.Wmla_kvup))g.Wmla_kvup;
    q.Wmla_o = (decltype(q.Wmla_o))g.Wmla_o;
    q.Wgu = (decltype(q.Wgu))g.Wgu;
    q.Wdown = (decltype(q.Wdown))g.Wdown;
    return q;
}
typedef float f32x2c __attribute__((ext_vector_type(2)));
typedef __bf16 bf16x2c __attribute__((ext_vector_type(2)));
__device__ __forceinline__ unsigned cvt_pk(float lo, float hi) { const f32x2c v = {lo, hi}; return __builtin_bit_cast(unsigned, __builtin_convertvector(v, bf16x2c)); }
__device__ __forceinline__ float bf2f(unsigned short h) { return __uint_as_float(((unsigned)h) << 16); }
__device__ __forceinline__ float bflo(unsigned w) { return __uint_as_float(w << 16); }
__device__ __forceinline__ float bfhi(unsigned w) { return __uint_as_float(w & 0xffff0000u); }
__device__ __forceinline__ float sigmoidf_(float x) { return __builtin_amdgcn_rcpf(1.0f + __builtin_amdgcn_exp2f(-1.4426950408889634f * x)); }
__device__ __forceinline__ float siluf_(float x) { return x * sigmoidf_(x); }
__device__ __forceinline__ float softplusf_(float x) { return x > 20.f ? x : log1pf(__expf(x)); }
__device__ __forceinline__ float gelu_tanh(float x) { const float y = 0.7978845608028654f * (x + 0.044715f * x * x * x); const float t = 1.0f - 2.0f * __builtin_amdgcn_rcpf(__builtin_amdgcn_exp2f(2.885390081777927f * y) + 1.0f); return 0.5f * x * (1.0f + t); }
__device__ __forceinline__ void swap32(float& a, float& b) { const auto r = __builtin_amdgcn_permlane32_swap(__float_as_uint(a), __float_as_uint(b), false, false); a = __uint_as_float(r[0]); b = __uint_as_float(r[1]); }
__device__ __forceinline__ void swap16(float& a, float& b) { const auto r = __builtin_amdgcn_permlane16_swap(__float_as_uint(a), __float_as_uint(b), false, false); a = __uint_as_float(r[0]); b = __uint_as_float(r[1]); }
__device__ __forceinline__ float sum_x32(float x) { float a = x, b = x; swap32(a, b); return a + b; }
__device__ __forceinline__ float sum_x16(float x) { float a = x, b = x; swap16(a, b); return a + b; }
__device__ __forceinline__ float max_x32(float x) { float a = x, b = x; swap32(a, b); return fmaxf(a, b); }
__device__ __forceinline__ float max_x16(float x) { float a = x, b = x; swap16(a, b); return fmaxf(a, b); }
__device__ __forceinline__ float wave_sum(float v) { v = sum_x32(v); v = sum_x16(v); v += __shfl_xor(v, 8); v += __shfl_xor(v, 4); v += __shfl_xor(v, 2); v += __shfl_xor(v, 1); return v; }
__device__ __forceinline__ int ltid() { int t = threadIdx.x; asm volatile("" : "+v"(t)); return t; }
template <class T> __device__ __forceinline__ T* uni(T* p) {
    const unsigned long long v = (unsigned long long)p; const unsigned lo = __builtin_amdgcn_readfirstlane((unsigned)v), hi = __builtin_amdgcn_readfirstlane((unsigned)(v >> 32));
    return (T*)(__attribute__((address_space(1))) T*)(((unsigned long long)hi << 32) | lo); }
__device__ __forceinline__ f32x4 mfma16(bf16x8 a, bf16x8 b, f32x4 c) { return __builtin_amdgcn_mfma_f32_16x16x32_bf16(a, b, c, 0, 0, 0); }

#define XB_TMO      128
#define XB_XCNT(j)  (256  + 64 * (j))
#define XB_XSUB(j)  (1280 + 64 * (j))
#define XB_XGEN(j)  (2304 + 64 * (j))
#define XB_TOP      3328
#define XB_TOPGEN   3392
#define XCD_BAR_WORDS 3456
#define XB_SPIN_CAP (1u << 18)
__device__ __forceinline__ unsigned xb_ld(unsigned* p)              { return __hip_atomic_load(p, __ATOMIC_RELAXED, __HIP_MEMORY_SCOPE_AGENT); }
__device__ __forceinline__ unsigned xb_add(unsigned* p, unsigned v) { return __hip_atomic_fetch_add(p, v, __ATOMIC_RELAXED, __HIP_MEMORY_SCOPE_AGENT); }
__device__ __forceinline__ unsigned xb_xcc_id() { return (unsigned)__builtin_amdgcn_s_getreg((3 << 11) | 20) & 0xFu; }
#define XB_SPIN(cond, bar) do { unsigned _sp = 0; while (cond) { __builtin_amdgcn_s_sleep(1); \
    if ((++_sp & 255u) == 0u) { if (xb_ld(&(bar)[XB_TMO])) break; if (_sp > XB_SPIN_CAP) { atomicAdd(&(bar)[XB_TMO], 1u); break; } } } } while (0)
struct XcdBarrier { unsigned* bar; unsigned x; volatile LAS unsigned* st; };
__device__ __forceinline__ XcdBarrier xcd_barrier_post(unsigned* bar, volatile LAS unsigned* st) {
    XcdBarrier b; b.bar = bar; b.x = xb_xcc_id(); b.st = st;
    if (threadIdx.x == 0) (void)xb_add(&bar[XB_XCNT(b.x)], 1u);
    return b;
}
__device__ __forceinline__ void xcd_barrier_complete(unsigned* bar, unsigned x, unsigned& nloc, unsigned& nx) {
    const unsigned G = gridDim.x * gridDim.y * gridDim.z;
    unsigned sum, cnt, mine, sp = 0u;
    for (;;) {
        sum = 0u; cnt = 0u; mine = 0u;
#pragma unroll
        for (unsigned j = 0; j < 16; ++j) { const unsigned c = xb_ld(&bar[XB_XCNT(j)]); sum += c; cnt += (c > 0u) ? 1u : 0u; mine = (j == x) ? c : mine; }
        if (sum == G) break;
        __builtin_amdgcn_s_sleep(1);
        if ((++sp & 255u) == 0u) { if (xb_ld(&bar[XB_TMO])) break; if (sp > XB_SPIN_CAP) { atomicAdd(&bar[XB_TMO], 1u); break; } }
    }
    nloc = mine > 0u ? mine : 1u; nx = cnt > 0u ? cnt : 1u;
}
__device__ __forceinline__ void xcd_barrier(const XcdBarrier& b) {
    asm volatile("s_waitcnt vmcnt(0)" ::: "memory");
    __syncthreads();
    if (threadIdx.x == 0) {
        unsigned* bar = b.bar;
        __builtin_amdgcn_s_waitcnt(0);
        unsigned nloc = b.st[0], nx = b.st[1];
        if (nloc == 0u) { xcd_barrier_complete(bar, b.x, nloc, nx); b.st[0] = nloc; b.st[1] = nx; }
        const unsigned old = xb_add(&bar[XB_XSUB(b.x)], 1u);
        const unsigned gen = old / nloc;
        if (old + 1u == (gen + 1u) * nloc) {
            __builtin_amdgcn_fence(__ATOMIC_RELEASE, "agent");
            asm volatile("s_waitcnt vmcnt(0)" ::: "memory");
            const unsigned og = xb_add(&bar[XB_TOP], 1u);
            const unsigned tg = og / nx;
            if (og + 1u == (tg + 1u) * nx) xb_add(&bar[XB_TOPGEN], 1u);
            else XB_SPIN(xb_ld(&bar[XB_TOPGEN]) == tg, bar);
            __builtin_amdgcn_fence(__ATOMIC_ACQUIRE, "agent");
            xb_add(&bar[XB_XGEN(b.x)], 1u);
            asm volatile("s_waitcnt vmcnt(0)" ::: "memory");
        } else {
            XB_SPIN(xb_ld(&bar[XB_XGEN(b.x)]) == gen, bar);
            __builtin_amdgcn_fence(__ATOMIC_ACQUIRE, "agent");
            asm volatile("s_waitcnt vmcnt(0)" ::: "memory");
        }
    }
    __syncthreads();
}

struct Job { const float* src; int ld, K; bf16_t* dst; int nrows, nvalid, mode; const float* gain; };
__device__ __forceinline__ Job get_job(const P& p, int idx) {
    Job j; j.mode = 0; j.gain = nullptr;
    if (idx < 2)        { j.src = p.in[13] + (size_t)idx * 1024 * 2048; j.ld = 2048; j.K = 1024; j.dst = p.Wlru_in + (size_t)idx * 2048 * 1024; j.nrows = 2048; j.nvalid = 2048; j.gain = p.in[10] + (idx == 0 ? 0 : 3) * D; }
    else if (idx < 18)  { const int r = idx - 2, l = r >> 3, q = r & 7, blk = q >> 1, isI = q & 1;
                          j.src = (isI ? p.in[18] : p.in[16]) + (size_t)(l * 4 + blk) * 65536; j.ld = 256; j.K = 256;
                          j.dst = p.Wlru_gate + (size_t)l * 2048 * 256 + (size_t)(blk * 512 + isI * 256) * 256; j.nrows = 256; j.nvalid = 256; }
    else if (idx < 20)  { const int l = idx - 18; j.src = p.in[21] + (size_t)l * 1048576; j.ld = 1024; j.K = 1024; j.dst = p.Wlru_out + (size_t)l * 1048576; j.nrows = 1024; j.nvalid = 1024; }
    else if (idx == 20) { j.src = p.in[22]; j.ld = DNPROJ; j.K = 1024; j.dst = p.Wdn_in; j.nrows = DNPROJP; j.nvalid = DNPROJ; j.gain = p.in[10] + 1 * D; }
    else if (idx == 21) { j.src = p.in[27]; j.ld = 1024; j.K = 1024; j.dst = p.Wdn_out; j.nrows = 1024; j.nvalid = 1024; }
    else if (idx == 22) { j.src = p.in[28]; j.ld = 512; j.K = 1024; j.dst = p.Wmla_d; j.nrows = 512; j.nvalid = 512; j.gain = p.in[10] + 2 * D; }
    else if (idx == 23) { j.src = p.in[31]; j.ld = 320; j.K = 1024; j.dst = p.Wmla_d + (size_t)512 * 1024; j.nrows = 512; j.nvalid = 320; j.gain = p.in[10] + 2 * D; }
    else if (idx == 24) { j.src = p.in[30]; j.ld = 1536; j.K = 512; j.dst = p.Wmla_uq; j.nrows = 1536; j.nvalid = 1536; }
    else if (idx == 25) { j.src = p.in[33]; j.ld = 1024; j.K = 256; j.dst = p.Wmla_kvup; j.nrows = 1024; j.nvalid = 1024; }
    else if (idx == 26) { j.src = p.in[34]; j.ld = 1024; j.K = 256; j.dst = p.Wmla_kvup + (size_t)1024 * 256; j.nrows = 1024; j.nvalid = 1024; }
    else if (idx == 27) { j.src = p.in[35]; j.ld = 1024; j.K = 1024; j.dst = p.Wmla_o; j.nrows = 1024; j.nvalid = 1024; }
    else if (idx < 32)  { const int l = idx - 28; j.src = p.in[36] + (size_t)l * 1024 * 5632; j.ld = 5632; j.K = 1024; j.dst = p.Wgu + (size_t)l * 5632 * 1024; j.nrows = 5632; j.nvalid = 5632; j.mode = 1; j.gain = p.in[11] + l * D; }
    else                { const int l = idx - 32; j.src = p.in[37] + (size_t)l * DFF * 1024; j.ld = 1024; j.K = DFF; j.dst = p.Wdown + (size_t)l * 1024 * DFF; j.nrows = 1024; j.nvalid = 1024; }
    return j;
}
constexpr int NJOBS = 36;
__device__ __forceinline__ void ph_init(const P& p, LAS char* smem) {
    const int tid = ltid();
    {
        const float4* meta = (const float4*)p.in[9]; const float4* xp = (const float4*)p.in[0]; const float4* xs = (const float4*)p.in[1];
        const int lane = tid & 63, wid = tid >> 6;
        for (int row = blockIdx.x * 8 + wid; row < MP; row += gridDim.x * 8) {
            const float4* src = nullptr;
            if (row < NTOK) { const int b = row / LP, t = row - b * LP; src = (t < NMETA) ? meta + t * 256 : xp + (size_t)(b * 2048 + t - NMETA) * 256; }
            else if (row < NTOK + NS) src = xs + (row - NTOK) * 256;
            float ss = 0.f;
#pragma unroll
            for (int i = 0; i < 4; ++i) { const float4 v = src ? src[lane + 64 * i] : make_float4(0.f, 0.f, 0.f, 0.f);
                ((float4*)(p.X + (size_t)row * D))[lane + 64 * i] = v; ss += v.x * v.x + v.y * v.y + v.z * v.z + v.w * v.w;
                *(u32x2*)(p.H + (size_t)row * D + 4 * (lane + 64 * i)) = (u32x2){cvt_pk(v.x, v.y), cvt_pk(v.z, v.w)}; }
            ss = wave_sum(ss);
            if (lane < 16) p.SS[(size_t)row * 16 + lane] = (lane == 0) ? ss : 0.f;
        }
        for (int i = blockIdx.x * NTHREADS + tid; i < 2 * 2048; i += gridDim.x * NTHREADS) { const int l = i >> 11, col = i & 2047, blk = col >> 9, isI = (col >> 8) & 1, c = col & 255;
            p.BCAT[i] = (isI ? p.in[19] : p.in[17])[l * 1024 + blk * 256 + c]; }
        const int npad = (MP - NTOK - NS) * 1024 / 8;
        for (int i = blockIdx.x * NTHREADS + tid; i < npad; i += gridDim.x * NTHREADS) {
            const size_t off = (size_t)(NTOK + NS) * 1024 + (size_t)i * 8; const u32x4 z = {0u, 0u, 0u, 0u};
            *(u32x4*)(p.HG + off) = z; *(u32x4*)(p.ON + off) = z; *(u32x4*)(p.AO + off) = z;
            { const int e = i * 8, prow = e >> 10, c = e & 1023; *(u32x4*)(p.XC + ((size_t)(c >> 8) * MP + (NTOK + NS) + prow) * 256 + (c & 255)) = z; }
        }
    }
    LAS int* jstart = (LAS int*)smem;
    LAS float* tile = (LAS float*)(smem + 256);
    if (tid == 0) { int acc = 0; for (int j = 0; j < NJOBS; ++j) { jstart[j] = acc; const Job jb = get_job(p, j); acc += (jb.nrows >> 6) * (jb.K >> 8); } jstart[NJOBS] = acc; }
    __syncthreads();
    const int total = jstart[NJOBS];
    struct TileRef { const float* src; bf16_t* dst; int ld, K, k0, n0; bool valid; const float* gain; };
    auto locate = [&](int t, TileRef& r, int& col) {
        int ji = 0; while (jstart[ji + 1] <= t) ++ji;
        const Job jb = get_job(p, ji);
        const int lt = t - jstart[ji], nkt = jb.K >> 8, tn = lt / nkt, tk = lt - tn * nkt;
        r.src = jb.src; r.dst = jb.dst; r.ld = jb.ld; r.K = jb.K; r.k0 = tk << 8; r.n0 = tn << 6; r.gain = jb.gain;
        const int nq = (tid & 15) * 4, n = r.n0 + nq; col = n; r.valid = n < jb.nvalid;
        if (jb.mode == 1) { const int q = n >> 5, sgu = (n >> 4) & 1, e = n & 15; col = sgu * DFF + q * 16 + e; } };
    auto fetch = [&](const TileRef& r, int col, float4 (&v)[8]) {
#pragma unroll
        for (int i = 0; i < 8; ++i) { const int kl = (tid >> 4) + 32 * i;
            v[i] = r.valid ? *(const float4*)(r.src + (size_t)(r.k0 + kl) * r.ld + col) : make_float4(0.f, 0.f, 0.f, 0.f);
            if (r.gain) { const float gk = r.gain[r.k0 + kl]; v[i].x *= gk; v[i].y *= gk; v[i].z *= gk; v[i].w *= gk; } } };
    TileRef cur, nxt; int ccol = 0, ncol = 0; float4 cv[8], nv[8];
    int t = blockIdx.x;
    if (t < total) { locate(t, cur, ccol); fetch(cur, ccol, cv); }
    for (; t < total; t += gridDim.x) {
        const bool has_next = t + (int)gridDim.x < total;
        if (has_next) { locate(t + gridDim.x, nxt, ncol); fetch(nxt, ncol, nv); }
        {   const int nq = (tid & 15) * 4;
#pragma unroll
            for (int i = 0; i < 8; ++i) { const int kl = (tid >> 4) + 32 * i;
                tile[kl * 65 + nq] = cv[i].x; tile[kl * 65 + nq + 1] = cv[i].y; tile[kl * 65 + nq + 2] = cv[i].z; tile[kl * 65 + nq + 3] = cv[i].w; }
        }
        __syncthreads();
        {
            const int j = tid & 7, nl = tid >> 3;
#pragma unroll
            for (int q = 0; q < 4; ++q) { float v[8];
#pragma unroll
                for (int e = 0; e < 8; ++e) v[e] = tile[(64 * q + 8 * j + e) * 65 + nl];
                u32x4 w; w.x = cvt_pk(v[0], v[1]); w.y = cvt_pk(v[2], v[3]); w.z = cvt_pk(v[4], v[5]); w.w = cvt_pk(v[6], v[7]);
                *(u32x4*)(cur.dst + (size_t)(cur.n0 + nl) * cur.K + cur.k0 + 64 * q + 8 * j) = w; }
        }
        __syncthreads();
        if (has_next) { cur = nxt; ccol = ncol;
#pragma unroll
            for (int i = 0; i < 8; ++i) cv[i] = nv[i]; }
    }
}

__device__ __forceinline__ void ph_norm(const float* X, const float* g, bf16_t* H) {
    const int tid = ltid(), lane = tid & 63, wid = tid >> 6;
    for (int row = blockIdx.x * 8 + wid; row < MP; row += gridDim.x * 8) {
        const float4* xr = (const float4*)(X + (size_t)row * D); float4 v[4]; float ss = 0.f;
#pragma unroll
        for (int i = 0; i < 4; ++i) { v[i] = xr[lane + 64 * i]; ss += v[i].x * v[i].x + v[i].y * v[i].y + v[i].z * v[i].z + v[i].w * v[i].w; }
        ss = wave_sum(ss); const float r = rsqrtf(ss * (1.0f / D) + RMS_EPS);
#pragma unroll
        for (int i = 0; i < 4; ++i) { const int c = 4 * (lane + 64 * i); const float4 gv = *(const float4*)(g + c);
            u32x2 w; w.x = cvt_pk(v[i].x * r * gv.x, v[i].y * r * gv.y); w.y = cvt_pk(v[i].z * r * gv.z, v[i].w * r * gv.w);
            *(u32x2*)(H + (size_t)row * D + c) = w; }
    }
}
__device__ __forceinline__ void ph_final_norm(const P& p) {
    const int tid = ltid(), lane = tid & 63, wid = tid >> 6; const float* g = p.in[12];
    for (int row = blockIdx.x * 8 + wid; row < NTOK + NS; row += gridDim.x * 8) {
        float* dst;
        if (row < NTOK) { const int b = row / LP, t = row - b * LP; if (t < NMETA) continue; dst = p.out + O_YP + (size_t)(b * 2048 + t - NMETA) * D; }
        else dst = p.out + O_YS + (size_t)(row - NTOK) * D;
        const float4* xr = (const float4*)(p.X + (size_t)row * D); float4 v[4]; float ss = 0.f;
#pragma unroll
        for (int i = 0; i < 4; ++i) { v[i] = xr[lane + 64 * i]; ss += v[i].x * v[i].x + v[i].y * v[i].y + v[i].z * v[i].z + v[i].w * v[i].w; }
        ss = wave_sum(ss); const float r = rsqrtf(ss * (1.0f / D) + RMS_EPS);
#pragma unroll
        for (int i = 0; i < 4; ++i) { const int c = 4 * (lane + 64 * i); const float4 gv = *(const float4*)(g + c);
            *(float4*)(dst + c) = make_float4(v[i].x * r * gv.x, v[i].y * r * gv.y, v[i].z * r * gv.z, v[i].w * r * gv.w); }
    }
}

struct GemmDesc { const bf16_t* A; int lda; const bf16_t* Bt; int K, N, ablk, pm0, npm; };
struct EpiLruIn { static constexpr bool GU = false; bf16_t* G1;
    __device__ __forceinline__ void st(int row, int col, f32x4 v) const {
        u32x2 w; if (col < 1024) { w.x = cvt_pk(gelu_tanh(v[0]), gelu_tanh(v[1])); w.y = cvt_pk(gelu_tanh(v[2]), gelu_tanh(v[3])); } else { w.x = cvt_pk(v[0], v[1]); w.y = cvt_pk(v[2], v[3]); }
        *(u32x2*)(G1 + (size_t)row * 2048 + col) = w; } };
struct EpiGate { static constexpr bool GU = false; bf16_t* RI; const float* bc;
    __device__ __forceinline__ void st(int row, int col, f32x4 v) const {
        const float4 bv = *(const float4*)(bc + col);
        *(u32x2*)(RI + (size_t)row * 2048 + col) = (u32x2){cvt_pk(sigmoidf_(v[0] + bv.x), sigmoidf_(v[1] + bv.y)), cvt_pk(sigmoidf_(v[2] + bv.z), sigmoidf_(v[3] + bv.w))}; } };
struct EpiResid { static constexpr bool GU = false; float* X;
    __device__ __forceinline__ void st(int row, int col, f32x4 v) const {
        float4* px = (float4*)(X + (size_t)row * D + col); float4 x = *px; x.x += v[0]; x.y += v[1]; x.z += v[2]; x.w += v[3]; *px = x; } };
struct EpiBf16 { static constexpr bool GU = false; bf16_t* O; int ld;
    __device__ __forceinline__ void st(int row, int col, f32x4 v) const { u32x2 w; w.x = cvt_pk(v[0], v[1]); w.y = cvt_pk(v[2], v[3]); *(u32x2*)(O + (size_t)row * ld + col) = w; } };
struct EpiDnIn { static constexpr bool GU = false; bf16_t* PROJ; float* BA;
    __device__ __forceinline__ void st(int row, int col, f32x4 v) const {
        u32x2 w; w.x = cvt_pk(v[0], v[1]); w.y = cvt_pk(v[2], v[3]); *(u32x2*)(PROJ + (size_t)row * DNPROJP + col) = w;
        if (col >= 4096 && col < DNPROJ) *(float4*)(BA + (size_t)row * 16 + (col - 4096)) = make_float4(v[0], v[1], v[2], v[3]); } };
struct EpiF32 { static constexpr bool GU = false; float* O; int ld;
    __device__ __forceinline__ void st(int row, int col, f32x4 v) const { *(float4*)(O + (size_t)row * ld + col) = make_float4(v[0], v[1], v[2], v[3]); } };
template <class E> struct EpiScaled { static constexpr bool GU = E::GU; E e; const float* ss;
    __device__ __forceinline__ float rs(int row) const {
        const __attribute__((address_space(1))) f32x4* q = (const __attribute__((address_space(1))) f32x4*)(ss + (size_t)row * 16); const f32x4 a = q[0], b = q[1], c = q[2], d = q[3];
        const float t = ((a[0] + a[1]) + (a[2] + a[3])) + ((b[0] + b[1]) + (b[2] + b[3])) + ((c[0] + c[1]) + (c[2] + c[3])) + ((d[0] + d[1]) + (d[2] + d[3]));
        return rsqrtf(t * (1.0f / D) + RMS_EPS); }
    __device__ __forceinline__ void st(int row, int col, f32x4 v) const { e.st(row, col, v * rs(row)); }
    __device__ __forceinline__ void st2(int row, int colg, f32x4 g, f32x4 u) const { const float r = rs(row); e.st2(row, colg, g * r, u * r); } };
struct EpiGU { static constexpr bool GU = true; bf16_t* HF;
    __device__ __forceinline__ void st2(int row, int colg, f32x4 g, f32x4 u) const {
        const int ff = (colg >> 5) * 16 + (colg & 15);
        u32x2 w; w.x = cvt_pk(siluf_(g[0]) * u[0], siluf_(g[1]) * u[1]); w.y = cvt_pk(siluf_(g[2]) * u[2], siluf_(g[3]) * u[3]);
        *(u32x2*)(HF + (size_t)row * DFF + ff) = w; } };

template <class Epi>
__device__ __forceinline__ void gemm_phase(const GemmDesc g, const Epi& epi, LAS char* smem) {
    constexpr int AP = 72;
    LAS bf16_t* As = (LAS bf16_t*)smem;
    LAS bf16_t* Bs = (LAS bf16_t*)(smem + 2 * 256 * AP * 2);
    int tid_ = threadIdx.x; asm volatile("" : "+v"(tid_));
    const int tid = tid_, lane = tid & 63, wid = tid >> 6, wm = wid >> 1, wn = wid & 1, li = lane & 15, lg = lane >> 4;
    const int nN = g.N >> 7, nU = (g.npm - g.pm0) * nN, nk = g.K >> 6;
    const int lrow = tid >> 3, lkc = (tid & 7) * 8;
    for (int u = blockIdx.x; u < nU; u += gridDim.x) {
        const int pq = u / nN, pn = u - pq * nN, pm = pq + g.pm0, m0 = pm << 8, n0 = pn << 7;
        const bf16_t* Ab = g.A + (size_t)m0 * g.lda + (g.ablk ? (n0 / g.ablk) * g.K : 0) + (size_t)lrow * g.lda + lkc;
        const bf16_t* Bb = g.Bt + (size_t)n0 * g.K + (size_t)lrow * g.K + lkc;
        f32x4 acc[4][4];
#pragma unroll
        for (int a = 0; a < 4; ++a)
#pragma unroll
            for (int b = 0; b < 4; ++b) acc[a][b] = (f32x4){0.f, 0.f, 0.f, 0.f};
        u32x4 ra[4], rb[2];
#pragma unroll
        for (int i = 0; i < 4; ++i) ra[i] = *(const u32x4*)(Ab + (size_t)(64 * i) * g.lda);
#pragma unroll
        for (int i = 0; i < 2; ++i) rb[i] = *(const u32x4*)(Bb + (size_t)(64 * i) * g.K);
#pragma unroll
        for (int i = 0; i < 4; ++i) *(LAS u32x4*)(As + (lrow + 64 * i) * AP + lkc) = ra[i];
#pragma unroll
        for (int i = 0; i < 2; ++i) *(LAS u32x4*)(Bs + (lrow + 64 * i) * AP + lkc) = rb[i];
        __syncthreads();
#pragma unroll 1
        for (int ks = 0; ks < nk; ++ks) {
            const int st = ks & 1;
            if (ks + 1 < nk) {
#pragma unroll
                for (int i = 0; i < 4; ++i) ra[i] = *(const u32x4*)(Ab + (size_t)(64 * i) * g.lda + (ks + 1) * 64);
#pragma unroll
                for (int i = 0; i < 2; ++i) rb[i] = *(const u32x4*)(Bb + (size_t)(64 * i) * g.K + (ks + 1) * 64);
            }
            const LAS bf16_t* as = As + st * 256 * AP + (wm * 64 + li) * AP + lg * 8;
            const LAS bf16_t* bs = Bs + st * 128 * AP + (wn * 64 + li) * AP + lg * 8;
#pragma unroll
            for (int kk = 0; kk < 2; ++kk) {
                bf16x8 xf[4], wf[4];
#pragma unroll
                for (int t = 0; t < 4; ++t) { xf[t] = *(const LAS bf16x8*)(as + t * 16 * AP + kk * 32); wf[t] = *(const LAS bf16x8*)(bs + t * 16 * AP + kk * 32); }
#pragma unroll
                for (int nt = 0; nt < 4; ++nt)
#pragma unroll
                    for (int mt = 0; mt < 4; ++mt) acc[nt][mt] = mfma16(wf[nt], xf[mt], acc[nt][mt]);
            }
            if (ks + 1 < nk) {
#pragma unroll
                for (int i = 0; i < 4; ++i) *(LAS u32x4*)(As + (st ^ 1) * 256 * AP + (lrow + 64 * i) * AP + lkc) = ra[i];
#pragma unroll
                for (int i = 0; i < 2; ++i) *(LAS u32x4*)(Bs + (st ^ 1) * 128 * AP + (lrow + 64 * i) * AP + lkc) = rb[i];
            }
            __syncthreads();
        }
        {   const int rowbase = m0 + wm * 64, colbase = n0 + wn * 64;
#pragma unroll
            for (int mt = 0; mt < 4; ++mt) { const int row = rowbase + 16 * mt + li;
                if constexpr (Epi::GU) {
#pragma unroll
                    for (int qq = 0; qq < 2; ++qq) epi.st2(row, colbase + 32 * qq + 4 * lg, acc[2 * qq][mt], acc[2 * qq + 1][mt]);
                } else {
#pragma unroll
                    for (int nt = 0; nt < 4; ++nt) epi.st(row, colbase + 16 * nt + 4 * lg, acc[nt][mt]);
                } } }
    }
}

namespace pg8 {
#define PG8_LAS __attribute__((address_space(3)))
constexpr int BM = 256, BK = 64, HALF = 128, HTB = HALF * BK * 2  , STAGE_BYTES = 8 * HTB, NXCD = 8, WGM = 8;

__host__ __device__ __forceinline__ int lds_byte(int r, int c) { const int st = (r >> 4) * 2 + (c >> 5), rr = r & 15, cc = c & 31, ob = rr * 64 + cc * 2; return st * 1024 + (ob ^ (((ob >> 9) & 1) << 5)); }
__host__ __device__ __forceinline__ void stage_rc(int b, int& R, int& C) { const int st = b / 1024, sb = b % 1024, swz = sb ^ (((sb >> 9) & 1) << 5); R = (st >> 1) * 16 + swz / 64; C = (st & 1) * 32 + (swz % 64) / 2; }
__host__ __device__ __forceinline__ int perm32(int rho) { const int n = rho >> 4, i = rho & 15; return 8 * (i >> 2) + 4 * n + (i & 3); }

struct Unit { int pm, pn; };
struct Gemm { const bf16_t* A; const bf16_t* Bt; int M, N, K; int lda = 0, ablk = 0; };

struct StaticOrder {
    int nM, nN, nwg, G, c;
    __host__ __device__ void init(int M, int N, int G_, int c_) { nM = M / BM; nN = N / BM; nwg = nM * nN; G = G_; c = c_; }
    __host__ __device__ bool next(int i, Unit& u) const {
        const long L = (long)i * G + c; if (L >= nwg) return false;
        int wgid = (int)L; { const int q = nwg / NXCD, r = nwg % NXCD, xcd = wgid % NXCD, off = wgid / NXCD; wgid = (xcd < r ? xcd * (q + 1) : r * (q + 1) + (xcd - r) * q) + off; }
        const int nig = WGM * nN, gid = wgid / nig, fm = gid * WGM, gsz = (nM - fm) < WGM ? (nM - fm) : WGM;
        u.pm = fm + ((wgid % nig) % gsz); u.pn = (wgid % nig) / gsz; return true;
    }
    __device__ __forceinline__ void a_ready(const Unit&) const {}
    __device__ __forceinline__ void done(const Unit&) const {}
};
template <class Epi, class Sched, bool ALIGN_EPI = false, bool SP2 = false, int LDA = 0, int ABLK = 0>
__device__ __forceinline__ void gemm_phase(PG8_LAS unsigned char* lds, const Gemm g, const Sched& S, const Epi& E) {
    int tid_ = threadIdx.x; asm volatile("" : "+v"(tid_));
    const int tid = tid_, wid = __builtin_amdgcn_readfirstlane(tid >> 6), lane = tid & 63, wr = wid >> 2, wc = wid & 3, fr = lane & 15, fq = lane >> 4;
    const int K = g.K, nt = K / BK, lda = LDA ? LDA : g.K;
    unsigned voffA[2], voffB[2];
#pragma unroll
    for (int i = 0; i < 2; ++i) { int R, C; stage_rc(tid * 16 + i * 8192, R, C); const int Rb = Epi::PERM ? ((R & ~31) + perm32(R & 31)) : R;
        voffA[i] = (unsigned)(R * lda + C) * 2u; voffB[i] = (unsigned)(Rb * K + C) * 2u; }
    const size_t kstep = (size_t)(BK * 2);
    const size_t hstep = (size_t)HALF * K * 2;
    const size_t tstep = 2 * hstep;
    const size_t hstepA = (size_t)HALF * lda * 2, tstepA = 2 * hstepA;
    auto akoff = [&](int pn) -> size_t { if constexpr (ABLK > 0) return (size_t)((pn * BM) / ABLK) * K * 2; else return (size_t)0; };
    const unsigned ldsw = (unsigned)wid * 1024u;
    const int aoff = lds_byte(wr * 64 + fr, fq * 8), boff = lds_byte(wc * 32 + fr, fq * 8);
#define PG8_SA(b, h) (((b) * 2 + (h)) * HTB)
#define PG8_SB(b, h) ((4 + (b) * 2 + (h)) * HTB)
#define PG8_STAGE(bufoff, gbase, voff) do { _Pragma("unroll") for (int _i = 0; _i < 2; ++_i) \
        __builtin_amdgcn_global_load_lds((const __attribute__((address_space(1))) unsigned*)((const char*)(gbase) + (voff)[_i]), (PG8_LAS unsigned*)(lds + (bufoff) + ldsw + _i * 8192), 16, 0, 0); } while (0)
#define PG8_LDA(dst, b, h) do { _Pragma("unroll") for (int m = 0; m < 4; ++m) _Pragma("unroll") for (int k = 0; k < 2; ++k) dst[m][k] = *(const PG8_LAS bf16x8*)(lds + PG8_SA(b, h) + aoff + m * 2048 + k * 1024); } while (0)
#define PG8_LDB(dst, b, h) do { _Pragma("unroll") for (int n = 0; n < 2; ++n) _Pragma("unroll") for (int k = 0; k < 2; ++k) dst[n][k] = *(const PG8_LAS bf16x8*)(lds + PG8_SB(b, h) + boff + n * 2048 + k * 1024); } while (0)
#define PG8_MMA(ai, bj, At, Bt) do { __builtin_amdgcn_s_setprio(1); _Pragma("unroll") for (int m = 0; m < 4; ++m) _Pragma("unroll") for (int n = 0; n < 2; ++n) _Pragma("unroll") for (int k = 0; k < 2; ++k) \
        acc[ai][bj][m][n] = __builtin_amdgcn_mfma_f32_16x16x32_bf16(Bt[n][k], At[m][k], acc[ai][bj][m][n], 0, 0, 0); __builtin_amdgcn_s_setprio(0); } while (0)
#define PG8_WAIT_V(n) asm volatile("s_waitcnt vmcnt(" #n ")" ::: "memory")
#define PG8_WAIT_L(n) asm volatile("s_waitcnt lgkmcnt(" #n ")" ::: "memory")
#define PG8_BAR __builtin_amdgcn_s_barrier()
#define PG8_SCHED __builtin_amdgcn_sched_barrier(0)
    Unit cur, nxt; int ui = 0;
    if (!S.next(0, cur)) return;
    f32x4 acc[2][2][4][2];
#pragma unroll
    for (int a = 0; a < 2; ++a)
#pragma unroll
        for (int b = 0; b < 2; ++b)
#pragma unroll
            for (int m = 0; m < 4; ++m)
#pragma unroll
                for (int n = 0; n < 2; ++n) acc[a][b][m][n] = (f32x4){0.f, 0.f, 0.f, 0.f};
    bf16x8 At[4][2], B0[2][2], B1[2][2];
    const char* cA = (const char*)g.A + (size_t)cur.pm * tstepA + akoff(cur.pn); const char* cB = (const char*)g.Bt + (size_t)cur.pn * tstep;
    S.a_ready(cur);
    if constexpr (SP2) {
        PG8_STAGE(PG8_SB(0, 0), cB, voffB); PG8_STAGE(PG8_SB(0, 1), cB + hstep, voffB); PG8_STAGE(PG8_SA(0, 0), cA, voffA); PG8_STAGE(PG8_SA(0, 1), cA + hstepA, voffA);
        if (wr == 1) PG8_BAR;
        PG8_WAIT_V(2); PG8_BAR;
        PG8_STAGE(PG8_SB(1, 0), cB + kstep, voffB); PG8_STAGE(PG8_SA(1, 0), cA + kstep, voffA); PG8_STAGE(PG8_SB(1, 1), cB + hstep + kstep, voffB);
        PG8_WAIT_V(6); PG8_BAR;
    } else {
        PG8_STAGE(PG8_SB(0, 0), cB, voffB); PG8_STAGE(PG8_SA(0, 0), cA, voffA); PG8_STAGE(PG8_SB(0, 1), cB + hstep, voffB); PG8_STAGE(PG8_SA(0, 1), cA + hstepA, voffA);
        if (wr == 1) PG8_BAR;
        PG8_WAIT_V(4); PG8_BAR;
        PG8_STAGE(PG8_SB(1, 0), cB + kstep, voffB); PG8_STAGE(PG8_SA(1, 0), cA + kstep, voffA); PG8_STAGE(PG8_SB(1, 1), cB + hstep + kstep, voffB);
        PG8_WAIT_V(6); PG8_BAR;
    }
    for (;;) {
        const bool has_next = S.next(ui + 1, nxt);
        const char* nA = has_next ? (const char*)g.A + (size_t)nxt.pm * tstepA + akoff(nxt.pn) : cA; const char* nB = has_next ? (const char*)g.Bt + (size_t)nxt.pn * tstep : cB;
#pragma unroll 1
        for (int t = 0; t < nt; t += 2) {
            const bool last = (t == nt - 2);
            const char* a1 = cA + (size_t)(t + 1) * kstep;
            const char* a2 = last ? nA : cA + (size_t)(t + 2) * kstep; const char* b2 = last ? nB : cB + (size_t)(t + 2) * kstep;
            const char* a3 = a2 + kstep; const char* b3 = b2 + kstep;
            if (last && has_next) S.a_ready(nxt);
            if constexpr (SP2) {
            PG8_LDB(B0, 0, 0); PG8_LDB(B1, 0, 1); PG8_SCHED; PG8_LDA(At, 0, 0); PG8_STAGE(PG8_SA(1, 1), a1 + hstepA, voffA);
            PG8_WAIT_V(8); PG8_WAIT_L(0); PG8_BAR; PG8_MMA(0, 0, At, B0); PG8_MMA(0, 1, At, B1); PG8_BAR; PG8_SCHED;
            PG8_LDA(At, 0, 1); PG8_STAGE(PG8_SB(0, 0), b2, voffB); PG8_STAGE(PG8_SB(0, 1), b2 + hstep, voffB); PG8_STAGE(PG8_SA(0, 0), a2, voffA);
            PG8_WAIT_V(8); PG8_WAIT_L(0); PG8_BAR; PG8_MMA(1, 0, At, B0); PG8_MMA(1, 1, At, B1); PG8_BAR; PG8_SCHED;
            PG8_LDB(B0, 1, 0); PG8_LDB(B1, 1, 1); PG8_SCHED; PG8_LDA(At, 1, 0); PG8_STAGE(PG8_SA(0, 1), a2 + hstepA, voffA);
            PG8_WAIT_V(8); PG8_WAIT_L(0); PG8_BAR; PG8_MMA(0, 0, At, B0); PG8_MMA(0, 1, At, B1); PG8_BAR; PG8_SCHED;
            PG8_LDA(At, 1, 1); PG8_STAGE(PG8_SB(1, 0), b3, voffB); PG8_STAGE(PG8_SB(1, 1), b3 + hstep, voffB); PG8_STAGE(PG8_SA(1, 0), a3, voffA);
            PG8_WAIT_V(8); PG8_WAIT_L(0); PG8_BAR; PG8_MMA(1, 0, At, B0); PG8_MMA(1, 1, At, B1); PG8_BAR; PG8_SCHED;
            } else {
            PG8_LDB(B0, 0, 0); PG8_SCHED; PG8_LDA(At, 0, 0); PG8_STAGE(PG8_SA(1, 1), a1 + hstepA, voffA);
            PG8_WAIT_L(8); PG8_BAR; PG8_WAIT_L(0); PG8_MMA(0, 0, At, B0); PG8_BAR; PG8_SCHED;
            PG8_LDB(B1, 0, 1); PG8_STAGE(PG8_SB(0, 0), b2, voffB);
            PG8_BAR; PG8_WAIT_L(0); PG8_MMA(0, 1, At, B1); PG8_BAR;
            PG8_LDA(At, 0, 1); PG8_STAGE(PG8_SA(0, 0), a2, voffA);
            PG8_BAR; PG8_WAIT_L(0); PG8_MMA(1, 0, At, B0); PG8_BAR; PG8_SCHED;
            PG8_STAGE(PG8_SB(0, 1), b2 + hstep, voffB);
            PG8_WAIT_V(6); PG8_BAR; PG8_MMA(1, 1, At, B1); PG8_BAR;
            PG8_LDB(B0, 1, 0); PG8_SCHED; PG8_LDA(At, 1, 0); PG8_STAGE(PG8_SA(0, 1), a2 + hstepA, voffA);
            PG8_WAIT_L(8); PG8_BAR; PG8_WAIT_L(0); PG8_MMA(0, 0, At, B0); PG8_BAR; PG8_SCHED;
            PG8_LDB(B1, 1, 1); PG8_STAGE(PG8_SB(1, 0), b3, voffB);
            PG8_BAR; PG8_WAIT_L(0); PG8_MMA(0, 1, At, B1); PG8_BAR;
            PG8_LDA(At, 1, 1); PG8_STAGE(PG8_SA(1, 0), a3, voffA);
            PG8_BAR; PG8_WAIT_L(0); PG8_MMA(1, 0, At, B0); PG8_BAR; PG8_SCHED;
            PG8_STAGE(PG8_SB(1, 1), b3 + hstep, voffB);
            PG8_WAIT_V(6); PG8_BAR; PG8_MMA(1, 1, At, B1); PG8_BAR;
            }
        }
        if constexpr (ALIGN_EPI) { if (wr == 0) PG8_BAR; }
        if constexpr (!Epi::AFTER_DRAIN) { E(acc, cur, wr, wc, fr, fq); S.done(cur); }
        if (!has_next) break;
#pragma unroll
        for (int a = 0; a < 2; ++a)
#pragma unroll
            for (int b = 0; b < 2; ++b)
#pragma unroll
                for (int m = 0; m < 4; ++m)
#pragma unroll
                    for (int n = 0; n < 2; ++n) acc[a][b][m][n] = (f32x4){0.f, 0.f, 0.f, 0.f};
        cur = nxt; cA = nA; cB = nB; ++ui;
        if constexpr (ALIGN_EPI) { if (wr == 1) PG8_BAR; }
    }
    PG8_WAIT_V(0);
    if constexpr (!ALIGN_EPI) { if (wr == 0) PG8_BAR; }
    PG8_BAR;
    if constexpr (Epi::AFTER_DRAIN) { E.fused(acc, cur, wr, wc, fr, fq, lds, wid, lane); S.done(cur); }
#undef PG8_SA
#undef PG8_SB
#undef PG8_STAGE
#undef PG8_LDA
#undef PG8_LDB
#undef PG8_MMA
#undef PG8_WAIT_V
#undef PG8_WAIT_L
#undef PG8_BAR
#undef PG8_SCHED
}
}


struct EpiResidAt { static constexpr bool GU = false; float* X;
    __device__ __forceinline__ void st(int row, int col, f32x4 v) const { float* px = X + (size_t)row * D + col;
        unsafeAtomicAdd(px, v[0]); unsafeAtomicAdd(px + 1, v[1]); unsafeAtomicAdd(px + 2, v[2]); unsafeAtomicAdd(px + 3, v[3]); } };
template <bool XN, class Epi>
__device__ __forceinline__ void gemm_small(const bf16_t* A, int lda, const bf16_t* Bt, int K, int N, int row0, int nrt, int S, const Epi& epi, LAS char* smem, const float* Xf = nullptr, int ablk = 0) {
    constexpr int AP = 72;
    LAS bf16_t* As = (LAS bf16_t*)smem;
    LAS bf16_t* Bs = (LAS bf16_t*)(smem + 2 * 64 * AP * 2);
    LAS float* rsS = (LAS float*)(smem + 2 * 64 * AP * 2 + 2 * 128 * AP * 2);
    int tid_ = threadIdx.x; asm volatile("" : "+v"(tid_));
    const int tid = tid_, lane = tid & 63, wid = tid >> 6, wm = wid >> 2, wn = wid & 3, li = lane & 15, lg = lane >> 4;
    const int nN = N >> 7, kper = (K >> 6) / S, nU = nrt * nN * S;
    const int lrow = tid >> 3, lkc = (tid & 7) * 8;
    const int G = (int)gridDim.x, nmain = (MMAIN / 256) * (N >> 8), first = nmain % G;
    for (int u = ((int)blockIdx.x - first + G) % G; u < nU; u += G) {
        const int ksp = u % S, t = u / S, pn = t % nN, rt = t / nN, m0 = row0 + rt * 64, n0 = pn << 7, k0 = ksp * kper * 64;
        const bf16_t* Ab = A + (ablk ? (size_t)(n0 / ablk) * MP * K : (size_t)0) + (size_t)(m0 + lrow) * lda + k0 + lkc;
        const bf16_t* Bb = Bt + (size_t)(n0 + lrow) * K + k0 + lkc;
        f32x4 acc[2][2];
#pragma unroll
        for (int a = 0; a < 2; ++a)
#pragma unroll
            for (int b = 0; b < 2; ++b) acc[a][b] = (f32x4){0.f, 0.f, 0.f, 0.f};
        u32x4 ra, rb[2];
        const float* Xb = XN ? Xf + (size_t)(m0 + lrow) * D + k0 + lkc : nullptr;
        auto loadA = [&](int ks) { if constexpr (XN) { const float4 a = *(const float4*)(Xb + ks * 64), c = *(const float4*)(Xb + ks * 64 + 4); ra = (u32x4){cvt_pk(a.x, a.y), cvt_pk(a.z, a.w), cvt_pk(c.x, c.y), cvt_pk(c.z, c.w)}; } else ra = *(const u32x4*)(Ab + ks * 64); };
        if constexpr (XN) {
#pragma unroll
            for (int r = 0; r < 8; ++r) { const float4* xr = (const float4*)(Xf + (size_t)(m0 + wid * 8 + r) * D); float ss = 0.f;
#pragma unroll
                for (int i = 0; i < 4; ++i) { const float4 v = xr[lane + 64 * i]; ss += v.x * v.x + v.y * v.y + v.z * v.z + v.w * v.w; }
                ss = wave_sum(ss); if (lane == 0) rsS[wid * 8 + r] = rsqrtf(ss * (1.0f / D) + RMS_EPS); }
        }
        loadA(0);
#pragma unroll
        for (int i = 0; i < 2; ++i) rb[i] = *(const u32x4*)(Bb + (size_t)(64 * i) * K);
        *(LAS u32x4*)(As + lrow * AP + lkc) = ra;
#pragma unroll
        for (int i = 0; i < 2; ++i) *(LAS u32x4*)(Bs + (lrow + 64 * i) * AP + lkc) = rb[i];
        __syncthreads();
#pragma unroll 1
        for (int ks = 0; ks < kper; ++ks) {
            const int st = ks & 1;
            if (ks + 1 < kper) { loadA(ks + 1);
#pragma unroll
                for (int i = 0; i < 2; ++i) rb[i] = *(const u32x4*)(Bb + (size_t)(64 * i) * K + (ks + 1) * 64); }
            const LAS bf16_t* as = As + st * 64 * AP + (wm * 32 + li) * AP + lg * 8;
            const LAS bf16_t* bs = Bs + st * 128 * AP + (wn * 32 + li) * AP + lg * 8;
#pragma unroll
            for (int kk = 0; kk < 2; ++kk) {
                bf16x8 xf[2], wf[2];
#pragma unroll
                for (int t2 = 0; t2 < 2; ++t2) { xf[t2] = *(const LAS bf16x8*)(as + t2 * 16 * AP + kk * 32); wf[t2] = *(const LAS bf16x8*)(bs + t2 * 16 * AP + kk * 32); }
#pragma unroll
                for (int nt = 0; nt < 2; ++nt)
#pragma unroll
                    for (int mt = 0; mt < 2; ++mt) acc[nt][mt] = mfma16(wf[nt], xf[mt], acc[nt][mt]);
            }
            if (ks + 1 < kper) { *(LAS u32x4*)(As + (st ^ 1) * 64 * AP + lrow * AP + lkc) = ra;
#pragma unroll
                for (int i = 0; i < 2; ++i) *(LAS u32x4*)(Bs + (st ^ 1) * 128 * AP + (lrow + 64 * i) * AP + lkc) = rb[i]; }
            __syncthreads();
        }
#pragma unroll
        for (int mt = 0; mt < 2; ++mt) { const int row = m0 + wm * 32 + 16 * mt + li, colb = n0 + wn * 32 + 4 * lg;
            if constexpr (XN) { const float r = rsS[wm * 32 + 16 * mt + li]; acc[0][mt] *= r; acc[1][mt] *= r; }
            if constexpr (Epi::GU) epi.st2(row, colb, acc[0][mt], acc[1][mt]);
            else { epi.st(row, colb, acc[0][mt]); epi.st(row, colb + 16, acc[1][mt]); } }
        if constexpr (XN) __syncthreads();
    }
}

template <class T> struct is_scaled : std::false_type {};
template <class E> struct is_scaled<EpiScaled<E>> : std::true_type {};
template <class E> struct PgEpi {
    static constexpr bool PERM = false, AFTER_DRAIN = false; E e;
    __device__ __forceinline__ void operator()(const f32x4 (&acc)[2][2][4][2], const pg8::Unit& u, int wr, int wc, int fr, int fq) const {
#pragma unroll
        for (int ai = 0; ai < 2; ++ai)
#pragma unroll
            for (int m = 0; m < 4; ++m) { const int row = u.pm * 256 + ai * 128 + wr * 64 + m * 16 + fr; float r = 1.f;
                if constexpr (is_scaled<E>::value) r = e.rs(row);
#pragma unroll
                for (int bj = 0; bj < 2; ++bj) { const int colb = u.pn * 256 + bj * 128 + wc * 32 + 4 * fq;
                    if constexpr (is_scaled<E>::value) {
                        if constexpr (E::GU) e.e.st2(row, colb, acc[ai][bj][m][0] * r, acc[ai][bj][m][1] * r);
                        else { e.e.st(row, colb, acc[ai][bj][m][0] * r); e.e.st(row, colb + 16, acc[ai][bj][m][1] * r); } }
                    else {
                        if constexpr (E::GU) e.st2(row, colb, acc[ai][bj][m][0], acc[ai][bj][m][1]);
                        else { e.st(row, colb, acc[ai][bj][m][0]); e.st(row, colb + 16, acc[ai][bj][m][1]); } } }
                asm volatile("" ::: "memory"); }
    }
};
struct GateOrder { int G, c;
    __device__ __forceinline__ bool next(int i, pg8::Unit& u) const { const int L = i * G + c; if (L >= 512) return false;
        const int half = L & 1, pm = (L >> 1) & 63, blk = L >> 7; u.pm = blk * NPANEL + pm; u.pn = 2 * blk + half; return true; }
    __device__ __forceinline__ void a_ready(const pg8::Unit&) const {}
    __device__ __forceinline__ void done(const pg8::Unit&) const {} };
struct PgEpiGate { static constexpr bool PERM = false, AFTER_DRAIN = false; EpiGate e;
    __device__ __forceinline__ void operator()(const f32x4 (&acc)[2][2][4][2], const pg8::Unit& u, int wr, int wc, int fr, int fq) const {
        const int pm = u.pm % NPANEL;
#pragma unroll
        for (int ai = 0; ai < 2; ++ai)
#pragma unroll
            for (int m = 0; m < 4; ++m) { const int row = pm * 256 + ai * 128 + wr * 64 + m * 16 + fr;
#pragma unroll
                for (int bj = 0; bj < 2; ++bj) { const int colb = u.pn * 256 + bj * 128 + wc * 32 + 4 * fq; e.st(row, colb, acc[ai][bj][m][0]); e.st(row, colb + 16, acc[ai][bj][m][1]); asm volatile("" ::: "memory"); } }
    } };
template <class E>
__device__ __forceinline__ void big_gemm(const bf16_t* A, const bf16_t* Bt, int N, int K, const E& e, LAS char* smem) {
    A = uni(A); Bt = uni(Bt);
    pg8::Gemm g{A, Bt, MMAIN, N, K}; pg8::StaticOrder S; S.init(MMAIN, N, (int)gridDim.x, (int)blockIdx.x);
    PgEpi<E> pe{e};
    pg8::gemm_phase<PgEpi<E>, pg8::StaticOrder, true, true>((LAS unsigned char*)smem, g, S, pe);
    __syncthreads();
    gemm_small<false>(A, K, Bt, K, N, MMAIN, 3, 1, e, smem);
}
template <class E>
__device__ __forceinline__ void norm_gemm(const P& p, const bf16_t* Bt, int N, int site, const E& e, LAS char* smem) {
    const bf16_t* A = uni((const bf16_t*)p.H); Bt = uni(Bt); const float* ss = uni((const float*)p.SS) + (size_t)site * MP * 16;
    pg8::Gemm g{A, Bt, MMAIN, N, D}; pg8::StaticOrder S; S.init(MMAIN, N, (int)gridDim.x, (int)blockIdx.x);
    PgEpi<EpiScaled<E>> pe{EpiScaled<E>{e, ss}};
    pg8::gemm_phase<PgEpi<EpiScaled<E>>, pg8::StaticOrder, true, true>((LAS unsigned char*)smem, g, S, pe);
    __syncthreads();
    gemm_small<true>(A, D, Bt, D, N, MMAIN, 3, 1, e, smem, uni((const float*)p.X));
}
struct PgEpiResidN { static constexpr bool PERM = false, AFTER_DRAIN = false; float* X; bf16_t* XB; float* SSo;
    __device__ __forceinline__ void operator()(const f32x4 (&acc)[2][2][4][2], const pg8::Unit& u, int wr, int wc, int fr, int fq) const {
#pragma unroll
        for (int ai = 0; ai < 2; ++ai)
#pragma unroll
            for (int m = 0; m < 4; ++m) { const int row = u.pm * 256 + ai * 128 + wr * 64 + m * 16 + fr; float ssum = 0.f;
#pragma unroll
                for (int bj = 0; bj < 2; ++bj)
#pragma unroll
                    for (int n = 0; n < 2; ++n) { const int col = u.pn * 256 + bj * 128 + wc * 32 + 16 * n + 4 * fq; const f32x4 v = acc[ai][bj][m][n];
                        float4* px = (float4*)(X + (size_t)row * D + col); float4 x = *px; x.x += v[0]; x.y += v[1]; x.z += v[2]; x.w += v[3]; *px = x;
                        if (SSo) { *(u32x2*)(XB + (size_t)row * D + col) = (u32x2){cvt_pk(x.x, x.y), cvt_pk(x.z, x.w)}; ssum += x.x * x.x + x.y * x.y + x.z * x.z + x.w * x.w; } }
                if (SSo) { ssum = sum_x32(sum_x16(ssum)); if (fq == 0) SSo[(size_t)row * 16 + u.pn * 4 + wc] = ssum; } }
    }
};
__device__ __forceinline__ void resid_gemm(const P& p, const bf16_t* A, const bf16_t* Bt, int K, int site_out, LAS char* smem) {
    A = uni(A); Bt = uni(Bt); float* X = uni(p.X);
    pg8::Gemm g{A, Bt, MMAIN, D, K}; pg8::StaticOrder S; S.init(MMAIN, D, (int)gridDim.x, (int)blockIdx.x);
    PgEpiResidN pe{X, uni(p.H), site_out >= 0 ? uni(p.SS) + (size_t)site_out * MP * 16 : nullptr};
    pg8::gemm_phase<PgEpiResidN, pg8::StaticOrder, true, true>((LAS unsigned char*)smem, g, S, pe);
    __syncthreads();
    gemm_small<false>(A, K, Bt, K, D, MMAIN, 3, (K == DFF) ? 11 : 8, EpiResidAt{X}, smem);
}

template <int J>
__device__ __forceinline__ void ph_lru_conv(const P& p) {
    const float* cw = p.in[14] + J * 4 * 1024; const float* cb = p.in[15] + J * 1024;
    const float* sbuf = p.in[3] + (size_t)J * NS * 3 * 1024;
    float* pconv = p.out + O_PLC + (size_t)J * NB * 3 * 1024; float* sconv = p.out + O_SLC + (size_t)J * NS * 3 * 1024;
    const int gt = blockIdx.x * NTHREADS + ltid(), nth = gridDim.x * NTHREADS;
    constexpr int RUN = 16, RPS = LP / RUN;
    for (int it = gt; it < NB * RPS * 128; it += nth) {
        const int run = it >> 7, c0 = (it & 127) * 8, b = run / RPS, t0 = (run - b * RPS) * RUN;
        float w[4][8], bias[8];
#pragma unroll
        for (int e = 0; e < 8; ++e) { bias[e] = cb[c0 + e];
#pragma unroll
            for (int j = 0; j < 4; ++j) w[j][e] = cw[j * 1024 + c0 + e]; }
        const bf16_t* src = p.G1 + ((size_t)b * LP + t0) * 2048 + 1024 + c0;
        float x[4][8];
#pragma unroll
        for (int j = 0; j < 3; ++j) { const int back = 3 - j;
            if (t0 >= back) { const u32x4 q = *(const u32x4*)(src - (size_t)back * 2048);
#pragma unroll
                for (int e = 0; e < 4; ++e) { x[j][2 * e] = bflo(q[e]); x[j][2 * e + 1] = bfhi(q[e]); } }
            else {
#pragma unroll
                for (int e = 0; e < 8; ++e) x[j][e] = 0.f; } }
        bf16_t* dst = p.XC + ((size_t)(c0 >> 8) * MP + (size_t)b * LP + t0) * 256 + (c0 & 255);
#pragma unroll 4
        for (int r = 0; r < RUN; ++r) {
            const u32x4 q = *(const u32x4*)(src + (size_t)r * 2048);
#pragma unroll
            for (int e = 0; e < 4; ++e) { x[3][2 * e] = bflo(q[e]); x[3][2 * e + 1] = bfhi(q[e]); }
            float y[8];
#pragma unroll
            for (int e = 0; e < 8; ++e) y[e] = bias[e] + x[0][e] * w[0][e] + x[1][e] * w[1][e] + x[2][e] * w[2][e] + x[3][e] * w[3][e];
            *(u32x4*)(dst + (size_t)r * 256) = (u32x4){cvt_pk(y[0], y[1]), cvt_pk(y[2], y[3]), cvt_pk(y[4], y[5]), cvt_pk(y[6], y[7])};
            const int t = t0 + r;
            if (t >= LP - 3) { float* d = pconv + (size_t)(b * 3 + (t - (LP - 3))) * 1024 + c0;
                *(float4*)d = make_float4(x[3][0], x[3][1], x[3][2], x[3][3]); *(float4*)(d + 4) = make_float4(x[3][4], x[3][5], x[3][6], x[3][7]); }
#pragma unroll
            for (int e = 0; e < 8; ++e) { x[0][e] = x[1][e]; x[1][e] = x[2][e]; x[2][e] = x[3][e]; }
        }
    }
    for (int it = gt; it < NS * 128; it += nth) {
        const int s = it >> 7, c0 = (it & 127) * 8; const size_t row = (size_t)NTOK + s;
        float x[4][8];
        { const u32x4 q = *(const u32x4*)(p.G1 + row * 2048 + 1024 + c0);
#pragma unroll
          for (int e = 0; e < 4; ++e) { x[3][2 * e] = bflo(q[e]); x[3][2 * e + 1] = bfhi(q[e]); } }
#pragma unroll
        for (int j = 0; j < 3; ++j) { const float* bsrc = sbuf + (size_t)(s * 3 + j) * 1024 + c0; const float4 a = *(const float4*)bsrc, bq = *(const float4*)(bsrc + 4);
            x[j][0] = a.x; x[j][1] = a.y; x[j][2] = a.z; x[j][3] = a.w; x[j][4] = bq.x; x[j][5] = bq.y; x[j][6] = bq.z; x[j][7] = bq.w; }
#pragma unroll
        for (int j = 0; j < 3; ++j) { float* d = sconv + (size_t)(s * 3 + j) * 1024 + c0;
            *(float4*)d = make_float4(x[j + 1][0], x[j + 1][1], x[j + 1][2], x[j + 1][3]); *(float4*)(d + 4) = make_float4(x[j + 1][4], x[j + 1][5], x[j + 1][6], x[j + 1][7]); }
        float y[8];
#pragma unroll
        for (int e = 0; e < 8; ++e) { y[e] = cb[c0 + e];
#pragma unroll
            for (int j = 0; j < 4; ++j) y[e] += x[j][e] * cw[j * 1024 + c0 + e]; }
        *(u32x4*)(p.XC + ((size_t)(c0 >> 8) * MP + row) * 256 + (c0 & 255)) = (u32x4){cvt_pk(y[0], y[1]), cvt_pk(y[2], y[3]), cvt_pk(y[4], y[5]), cvt_pk(y[6], y[7])};
    }
}

__device__ __forceinline__ void lru_au(float cla, float r, float ig, float xc, float& a, float& u) {
    const float la = cla * r, x2 = 2.0f * la; a = __builtin_amdgcn_exp2f(1.4426950408889634f * la);
    const float om = (x2 > -0.02f) ? -x2 * (1.0f + x2 * (0.5f + x2 * (1.0f / 6.0f))) : 1.0f - a * a;
    u = __builtin_amdgcn_sqrtf(om) * (ig * xc);
}
template <int J>
__device__ __forceinline__ void ph_scan1(const P& p) {
    const float* lam = p.in[20] + J * 1024;
    const int tid = ltid(), sub = tid >> 8, ch = (tid & 255) * 4, blk = ch >> 8, cc = ch & 255;
    float cla[4];
#pragma unroll
    for (int e = 0; e < 4; ++e) cla[e] = -8.0f * softplusf_(-lam[ch + e]);
    for (int u = blockIdx.x; u < NB * SCH / 2; u += gridDim.x) {
        const int pr_ = 2 * u + sub, b = pr_ / SCH, ci = pr_ - b * SCH;
        const size_t row0 = (size_t)b * LP + ci * SCL;
        const bf16_t* pr = p.RI + row0 * 2048 + blk * 512 + cc; const bf16_t* px = p.XC + ((size_t)blk * MP + row0) * 256 + cc;
        float Pp[4] = {1.f, 1.f, 1.f, 1.f}, h[4] = {0.f, 0.f, 0.f, 0.f};
#pragma unroll 8
        for (int t = 0; t < SCL; ++t) {
            const u32x2 rw = *(const u32x2*)(pr + (size_t)t * 2048), iw = *(const u32x2*)(pr + (size_t)t * 2048 + 256), xw = *(const u32x2*)(px + (size_t)t * 256);
            const float r[4] = {bflo(rw.x), bfhi(rw.x), bflo(rw.y), bfhi(rw.y)}, ig[4] = {bflo(iw.x), bfhi(iw.x), bflo(iw.y), bfhi(iw.y)}, xc[4] = {bflo(xw.x), bfhi(xw.x), bflo(xw.y), bfhi(xw.y)};
#pragma unroll
            for (int e = 0; e < 4; ++e) { float a, uu; lru_au(cla[e], r[e], ig[e], xc[e], a, uu); h[e] = a * h[e] + uu; Pp[e] *= a; }
        }
        *(float4*)(p.CP + (size_t)(b * SCH + ci) * 1024 + ch) = make_float4(Pp[0], Pp[1], Pp[2], Pp[3]);
        *(float4*)(p.CH + (size_t)(b * SCH + ci) * 1024 + ch) = make_float4(h[0], h[1], h[2], h[3]);
    }
}
template <int J>
__device__ __forceinline__ void ph_scan2(const P& p) {
    const float* lam = p.in[20] + J * 1024;
    const int tid = ltid(), sub = tid >> 8, ch = (tid & 255) * 4, blk = ch >> 8, cc = ch & 255;
    float cla[4];
#pragma unroll
    for (int e = 0; e < 4; ++e) cla[e] = -8.0f * softplusf_(-lam[ch + e]);
    for (int u = blockIdx.x; u < NB * SCH / 2 + NS / 2; u += gridDim.x) {
        if (u < NB * SCH / 2) {
            const int pr_ = 2 * u + sub, b = pr_ / SCH, ci = pr_ - b * SCH;
            float h[4] = {0.f, 0.f, 0.f, 0.f};
            for (int cj = 0; cj < ci; ++cj) { const float4 cp = *(const float4*)(p.CP + (size_t)(b * SCH + cj) * 1024 + ch), chv = *(const float4*)(p.CH + (size_t)(b * SCH + cj) * 1024 + ch);
                h[0] = cp.x * h[0] + chv.x; h[1] = cp.y * h[1] + chv.y; h[2] = cp.z * h[2] + chv.z; h[3] = cp.w * h[3] + chv.w; }
            const size_t row0 = (size_t)b * LP + ci * SCL;
            const bf16_t* pr = p.RI + row0 * 2048 + blk * 512 + cc; const bf16_t* px = p.XC + ((size_t)blk * MP + row0) * 256 + cc; const bf16_t* pg = p.G1 + row0 * 2048 + ch;
            bf16_t* po = p.HG + row0 * 1024 + ch;
#pragma unroll 8
            for (int t = 0; t < SCL; ++t) {
                const u32x2 rw = *(const u32x2*)(pr + (size_t)t * 2048), iw = *(const u32x2*)(pr + (size_t)t * 2048 + 256), xw = *(const u32x2*)(px + (size_t)t * 256), gw = *(const u32x2*)(pg + (size_t)t * 2048);
                const float r[4] = {bflo(rw.x), bfhi(rw.x), bflo(rw.y), bfhi(rw.y)}, ig[4] = {bflo(iw.x), bfhi(iw.x), bflo(iw.y), bfhi(iw.y)}, xc[4] = {bflo(xw.x), bfhi(xw.x), bflo(xw.y), bfhi(xw.y)};
                const float gt[4] = {bflo(gw.x), bfhi(gw.x), bflo(gw.y), bfhi(gw.y)};
#pragma unroll
                for (int e = 0; e < 4; ++e) { float a, uu; lru_au(cla[e], r[e], ig[e], xc[e], a, uu); h[e] = a * h[e] + uu; }
                *(u32x2*)(po + (size_t)t * 1024) = (u32x2){cvt_pk(h[0] * gt[0], h[1] * gt[1]), cvt_pk(h[2] * gt[2], h[3] * gt[3])};
            }
            if (ci == SCH - 1) *(float4*)(p.out + O_PLH + (size_t)(J * NB + b) * 1024 + ch) = make_float4(h[0], h[1], h[2], h[3]);
        } else {
            const int s = 2 * (u - NB * SCH / 2) + sub; const size_t row = (size_t)NTOK + s;
            const u32x2 rw = *(const u32x2*)(p.RI + row * 2048 + blk * 512 + cc), iw = *(const u32x2*)(p.RI + row * 2048 + blk * 512 + 256 + cc), xw = *(const u32x2*)(p.XC + ((size_t)blk * MP + row) * 256 + cc), gw = *(const u32x2*)(p.G1 + row * 2048 + ch);
            const float r[4] = {bflo(rw.x), bfhi(rw.x), bflo(rw.y), bfhi(rw.y)}, ig[4] = {bflo(iw.x), bfhi(iw.x), bflo(iw.y), bfhi(iw.y)}, xc[4] = {bflo(xw.x), bfhi(xw.x), bflo(xw.y), bfhi(xw.y)};
            const float gt[4] = {bflo(gw.x), bfhi(gw.x), bflo(gw.y), bfhi(gw.y)};
            const float4 h0 = *(const float4*)(p.in[2] + (size_t)(J * NS + s) * 1024 + ch); const float h0v[4] = {h0.x, h0.y, h0.z, h0.w}; float h[4];
#pragma unroll
            for (int e = 0; e < 4; ++e) { float a, uu; lru_au(cla[e], r[e], ig[e], xc[e], a, uu); h[e] = a * h0v[e] + uu; }
            *(float4*)(p.out + O_SLH + (size_t)(J * NS + s) * 1024 + ch) = make_float4(h[0], h[1], h[2], h[3]);
            *(u32x2*)(p.HG + row * 1024 + ch) = (u32x2){cvt_pk(h[0] * gt[0], h[1] * gt[1]), cvt_pk(h[2] * gt[2], h[3] * gt[3])};
        }
    }
}

__device__ __forceinline__ void ph_dn_conv(const P& p) {
    const float* cw = p.in[23]; const float* sbuf = p.in[5];
    const int gt = blockIdx.x * NTHREADS + ltid(), nth = gridDim.x * NTHREADS;
    constexpr int RUN = 16, RPS = LP / RUN, NCG = DNQKV / 8;
    for (int it = gt; it < NB * RPS * NCG; it += nth) {
        const int run = it / NCG, cg = it - run * NCG, c0 = cg * 8, b = run / RPS, t0 = (run - b * RPS) * RUN; const bool nrm = c0 < 2048;
        float w[4][8];
#pragma unroll
        for (int e = 0; e < 8; ++e)
#pragma unroll
            for (int j = 0; j < 4; ++j) w[j][e] = cw[j * DNQKV + c0 + e];
        const bf16_t* src = p.PROJ + ((size_t)b * LP + t0) * DNPROJP + c0;
        float x[4][8];
#pragma unroll
        for (int j = 0; j < 3; ++j) { const int back = 3 - j;
            if (t0 >= back) { const u32x4 q = *(const u32x4*)(src - (size_t)back * DNPROJP);
#pragma unroll
                for (int e = 0; e < 4; ++e) { x[j][2 * e] = bflo(q[e]); x[j][2 * e + 1] = bfhi(q[e]); } }
            else {
#pragma unroll
                for (int e = 0; e < 8; ++e) x[j][e] = 0.f; } }
        bf16_t* dst = p.QKVN + ((size_t)b * LP + t0) * DNQKV + c0;
#pragma unroll 4
        for (int r = 0; r < RUN; ++r) {
            const u32x4 q = *(const u32x4*)(src + (size_t)r * DNPROJP);
#pragma unroll
            for (int e = 0; e < 4; ++e) { x[3][2 * e] = bflo(q[e]); x[3][2 * e + 1] = bfhi(q[e]); }
            float y[8]; float ss = 0.f;
#pragma unroll
            for (int e = 0; e < 8; ++e) { y[e] = siluf_(x[0][e] * w[0][e] + x[1][e] * w[1][e] + x[2][e] * w[2][e] + x[3][e] * w[3][e]); ss += y[e] * y[e]; }
            ss += __shfl_xor(ss, 1); ss += __shfl_xor(ss, 2); ss += __shfl_xor(ss, 4); ss += __shfl_xor(ss, 8);
            const float rn = nrm ? rsqrtf(ss + 1e-6f) : 1.0f;
            *(u32x4*)(dst + (size_t)r * DNQKV) = (u32x4){cvt_pk(y[0] * rn, y[1] * rn), cvt_pk(y[2] * rn, y[3] * rn), cvt_pk(y[4] * rn, y[5] * rn), cvt_pk(y[6] * rn, y[7] * rn)};
            const int t = t0 + r;
            if (t >= LP - 3) { float* d = p.out + O_PDC + (size_t)(b * 3 + (t - (LP - 3))) * DNQKV + c0;
                *(float4*)d = make_float4(x[3][0], x[3][1], x[3][2], x[3][3]); *(float4*)(d + 4) = make_float4(x[3][4], x[3][5], x[3][6], x[3][7]); }
#pragma unroll
            for (int e = 0; e < 8; ++e) { x[0][e] = x[1][e]; x[1][e] = x[2][e]; x[2][e] = x[3][e]; }
        }
    }
    for (int it = gt; it < NS * NCG; it += nth) {
        const int s = it / NCG, cg = it - s * NCG, c0 = cg * 8; const size_t row = (size_t)NTOK + s;
        float x[4][8];
        { const u32x4 q = *(const u32x4*)(p.PROJ + row * DNPROJP + c0);
#pragma unroll
          for (int e = 0; e < 4; ++e) { x[3][2 * e] = bflo(q[e]); x[3][2 * e + 1] = bfhi(q[e]); } }
#pragma unroll
        for (int j = 0; j < 3; ++j) { const float* bsrc = sbuf + (size_t)(s * 3 + j) * DNQKV + c0; const float4 a = *(const float4*)bsrc, bq = *(const float4*)(bsrc + 4);
            x[j][0] = a.x; x[j][1] = a.y; x[j][2] = a.z; x[j][3] = a.w; x[j][4] = bq.x; x[j][5] = bq.y; x[j][6] = bq.z; x[j][7] = bq.w; }
#pragma unroll
        for (int j = 0; j < 3; ++j) { float* d = p.out + O_SDC + (size_t)(s * 3 + j) * DNQKV + c0;
            *(float4*)d = make_float4(x[j + 1][0], x[j + 1][1], x[j + 1][2], x[j + 1][3]); *(float4*)(d + 4) = make_float4(x[j + 1][4], x[j + 1][5], x[j + 1][6], x[j + 1][7]); }
        float y[8]; float ss = 0.f;
#pragma unroll
        for (int e = 0; e < 8; ++e) { float a = 0.f;
#pragma unroll
            for (int j = 0; j < 4; ++j) a += x[j][e] * cw[j * DNQKV + c0 + e];
            y[e] = siluf_(a); ss += y[e] * y[e]; }
        ss += __shfl_xor(ss, 1); ss += __shfl_xor(ss, 2); ss += __shfl_xor(ss, 4); ss += __shfl_xor(ss, 8);
        const float rn = (c0 < 2048) ? rsqrtf(ss + 1e-6f) : 1.0f;
        *(u32x4*)(p.QKVN + row * DNQKV + c0) = (u32x4){cvt_pk(y[0] * rn, y[1] * rn), cvt_pk(y[2] * rn, y[3] * rn), cvt_pk(y[4] * rn, y[5] * rn), cvt_pk(y[6] * rn, y[7] * rn)};
    }
    for (int it = gt; it < (NTOK + NS) * 8; it += nth) {
        const int row = it >> 3, hh = it & 7;
        const float bb = p.BA[(size_t)row * 16 + hh], aa = p.BA[(size_t)row * 16 + 8 + hh];
        p.BG[(size_t)row * 16 + hh] = sigmoidf_(bb);
        p.BG[(size_t)row * 16 + 8 + hh] = -__expf(p.in[24][hh]) * softplusf_(aa + p.in[25][hh]);
    }
}

typedef float f32x2 __attribute__((ext_vector_type(2)));
template <int J>
__device__ __forceinline__ void solve_step(f32x2 (&s2)[32], const LAS float* Am) {
    const float sj = (J & 1) ? s2[J >> 1].y : s2[J >> 1].x;
    if constexpr ((J & 1) == 0) s2[J >> 1].y -= Am[J * 64 + J + 1] * sj;
    const f32x2 sjj = {sj, sj};
#pragma unroll
    for (int q = (J >> 1) + 1; q < 32; ++q) s2[q] -= *(const LAS f32x2*)(Am + J * 64 + 2 * q) * sjj;
    if constexpr ((J & 3) == 3) asm volatile("" ::: "memory");
    if constexpr (J + 1 < 63) solve_step<J + 1>(s2, Am);
}
__device__ __forceinline__ void ph_dn_chunk(const P& p, LAS char* smem) {
    constexpr int TP = 136;
    LAS float* Gs = (LAS float*)smem; LAS float* Bsh = Gs + 64; LAS float* gS = Bsh + 64;
    LAS float* Am = gS + 64;
    LAS bf16_t* Qs = (LAS bf16_t*)(Am + 4096); LAS bf16_t* Ks = Qs + 64 * TP; LAS bf16_t* Vs = Ks + 64 * TP;
    LAS bf16_t* SolS = Vs + 64 * TP;
    constexpr int NU3 = NB * NCHUNK * 8;
    u32x4 pre[6]; float pre_g = 0.f, pre_b = 0.f;
    auto prefetch = [&](int un) {
        int tl = threadIdx.x; asm volatile("" : "+v"(tl));
        const int b = un / (NCHUNK * 8), rem = un - b * (NCHUNK * 8), c = rem >> 3, h = rem & 7;
        const int tbase = (c == 0) ? 0 : 16 + 64 * (c - 1), nvalid = (c == 0) ? 16 : 64;
        const size_t grow0 = (size_t)b * LP + tbase;
#pragma unroll
        for (int i = 0; i < 6; ++i) { const int cidx = tl + NTHREADS * i, which = cidx >> 10, r = (cidx >> 4) & 63, part = cidx & 15;
            pre[i] = (u32x4){0u, 0u, 0u, 0u};
            if (r < nvalid) pre[i] = *(const u32x4*)(p.QKVN + (grow0 + r) * DNQKV + which * 1024 + h * 128 + part * 8); }
        if (tl < 64) { const bool v = tl < nvalid; pre_g = v ? p.BG[(grow0 + tl) * 16 + 8 + h] : 0.f; pre_b = v ? p.BG[(grow0 + tl) * 16 + h] : 0.f; } };
    if ((int)blockIdx.x < NU3) prefetch(blockIdx.x);
    for (int u = blockIdx.x; u < NU3; u += gridDim.x) {
        int tid = threadIdx.x; asm volatile("" : "+v"(tid));
        const int lane = tid & 63, wid = tid >> 6, li = lane & 15, lg = lane >> 4;
        {
#pragma unroll
            for (int i = 0; i < 6; ++i) { const int cidx = tid + NTHREADS * i, which = cidx >> 10, r = (cidx >> 4) & 63, part = cidx & 15;
                *(LAS u32x4*)(Qs + which * 64 * TP + r * TP + part * 8) = pre[i]; }
            if (tid < 64) { gS[tid] = pre_g; Bsh[tid] = pre_b; }
            __syncthreads();
            if (tid < 64) {
                float a = gS[tid];
#pragma unroll
                for (int o = 1; o < 64; o <<= 1) { const float t = __shfl_up(a, o); if (tid >= o) a += t; }
                Gs[tid] = a; }
            __syncthreads();
            {
#pragma unroll
                for (int tt = 0; tt < 4; ++tt) { const int tl = wid * 4 + tt, isQ = tl >> 4, it = (tl >> 2) & 3, jt = tl & 3;
                    const LAS bf16_t* Ap = (isQ ? Qs : Ks) + (16 * it + li) * TP + lg * 8; const LAS bf16_t* Bp = Ks + (16 * jt + li) * TP + lg * 8;
                    f32x4 acc = {0.f, 0.f, 0.f, 0.f};
#pragma unroll
                    for (int ks = 0; ks < 4; ++ks) acc = mfma16(*(const LAS bf16x8*)(Ap + ks * 32), *(const LAS bf16x8*)(Bp + ks * 32), acc);
                    const int j = 16 * jt + li; const float Gj = Gs[j];
#pragma unroll
                    for (int r = 0; r < 4; ++r) { const int i = 16 * it + 4 * lg + r; const float dec = __expf(Gs[i] - Gj);
                        if (isQ) p.DATT[(size_t)u * 4096 + i * 64 + j] = (bf16_t)(cvt_pk((j <= i) ? acc[r] * 0.08838834764831845f * dec : 0.f, 0.f) & 0xffffu);
                        else Am[j * 64 + i] = (j < i) ? Bsh[i] * acc[r] * dec : 0.f; } }
            }
            __syncthreads();
            if (u + (int)gridDim.x < NU3) prefetch(u + gridDim.x);
            if (tid < 256) {
                const int cidx = tid; f32x2 s2[32];
#pragma unroll
                for (int q = 0; q < 32; ++q) {
                    const int i0 = 2 * q, i1 = 2 * q + 1;
                    s2[q].x = (cidx < 128) ? bf2f(Vs[i0 * TP + cidx]) * Bsh[i0] : bf2f(Ks[i0 * TP + cidx - 128]) * Bsh[i0] * __expf(Gs[i0]);
                    s2[q].y = (cidx < 128) ? bf2f(Vs[i1 * TP + cidx]) * Bsh[i1] : bf2f(Ks[i1 * TP + cidx - 128]) * Bsh[i1] * __expf(Gs[i1]); }
                solve_step<0>(s2, Am);
#pragma unroll
                for (int q = 0; q < 32; ++q) { SolS[(2 * q) * 256 + cidx] = (bf16_t)(cvt_pk(s2[q].x, 0.f) & 0xffffu); SolS[(2 * q + 1) * 256 + cidx] = (bf16_t)(cvt_pk(s2[q].y, 0.f) & 0xffffu); }
            } else {
                const int t2 = tid - 256;
                {
                    const int part = t2 & 15, i0 = t2 >> 4;
#pragma unroll
                    for (int k = 0; k < 4; ++k) { const int i = i0 + 16 * k; const float sc = 0.08838834764831845f * __expf(Gs[i]); const u32x4 w = *(const LAS u32x4*)(Qs + i * TP + part * 8); u32x4 o;
#pragma unroll
                        for (int e = 0; e < 4; ++e) o[e] = cvt_pk(bflo(w[e]) * sc, bfhi(w[e]) * sc);
                        *(u32x4*)(p.DQD + (size_t)u * 8192 + i * 128 + part * 8) = o; }
                }
                {
                    const int dk = t2 & 127, half = t2 >> 7; const float Gl = Gs[63]; bf16_t* d = p.DKDt + (size_t)u * 8192 + dk * 64 + half * 32;
#pragma unroll
                    for (int q = 0; q < 4; ++q) { float v[8];
#pragma unroll
                        for (int e = 0; e < 8; ++e) { const int rr = half * 32 + q * 8 + e; v[e] = bf2f(Ks[rr * TP + dk]) * __expf(Gl - Gs[rr]); }
                        u32x4 w; w.x = cvt_pk(v[0], v[1]); w.y = cvt_pk(v[2], v[3]); w.z = cvt_pk(v[4], v[5]); w.w = cvt_pk(v[6], v[7]); *(u32x4*)(d + q * 8) = w; }
                }
                if (t2 == 0) p.DGL[u] = Gs[63];
            }
            __syncthreads();
            {
                const int dv = tid & 127, q = tid >> 7; unsigned w[8];
#pragma unroll
                for (int e = 0; e < 8; ++e) w[e] = (unsigned)SolS[(16 * q + 2 * e) * 256 + dv] | ((unsigned)SolS[(16 * q + 2 * e + 1) * 256 + dv] << 16);
                bf16_t* d = p.DUt + (size_t)u * 8192 + dv * 64 + 16 * q;
                *(u32x4*)d = (u32x4){w[0], w[1], w[2], w[3]}; *(u32x4*)(d + 8) = (u32x4){w[4], w[5], w[6], w[7]};
#pragma unroll
                for (int k = 0; k < 2; ++k) { const int c = tid + NTHREADS * k, row = c >> 4, part = c & 15;
                    *(u32x4*)(p.DW + (size_t)u * 8192 + row * 128 + part * 8) = *(const LAS u32x4*)(SolS + row * 256 + 128 + part * 8); }
            }
            __syncthreads();
        }
    }
    for (int v = ((int)blockIdx.x - NU3 % (int)gridDim.x + (int)gridDim.x) % (int)gridDim.x; v < NS * 8; v += gridDim.x) {
        const int tid = ltid();
        {
            const int s = v >> 3, h = v & 7; const size_t row = (size_t)NTOK + s;
            LAS float* qv = (LAS float*)smem; LAS float* kv = qv + 128; LAS float* red = kv + 128;
            LAS float* dl = red + 1024;
            if (tid < 128) { qv[tid] = bf2f(p.QKVN[row * DNQKV + h * 128 + tid]) * 0.08838834764831845f; kv[tid] = bf2f(p.QKVN[row * DNQKV + 1024 + h * 128 + tid]); }
            __syncthreads();
            const int dv = tid & 127, qd = tid >> 7;
            const float* S0 = p.in[4] + ((size_t)(s * 8 + h) * 128) * 128;
            float sreg[32]; float ks_ = 0.f, qs_ = 0.f;
#pragma unroll
            for (int k = 0; k < 32; ++k) { const int dk = qd * 32 + k; sreg[k] = S0[(size_t)dk * 128 + dv]; ks_ += kv[dk] * sreg[k]; qs_ += qv[dk] * sreg[k]; }
            red[(qd * 128 + dv) * 2] = ks_; red[(qd * 128 + dv) * 2 + 1] = qs_;
            __syncthreads();
            const float beta = p.BG[row * 16 + h], eg = __expf(p.BG[row * 16 + 8 + h]);
            if (tid < 128) {
                float kS = 0.f, qS = 0.f, qk = 0.f;
#pragma unroll
                for (int q = 0; q < 4; ++q) { kS += red[(q * 128 + dv) * 2]; qS += red[(q * 128 + dv) * 2 + 1]; }
                for (int k = 0; k < 128; ++k) qk += qv[k] * kv[k];
                const float vv = bf2f(p.QKVN[row * DNQKV + 2048 + h * 128 + dv]);
                const float delta = beta * (vv - eg * kS);
                p.ORAW[row * 1024 + h * 128 + dv] = eg * qS + qk * delta;
                dl[dv] = delta;
            }
            __syncthreads();
            const float delta = dl[dv];
            float* Sout = p.out + O_SDS + ((size_t)(s * 8 + h) * 128) * 128;
#pragma unroll
            for (int k = 0; k < 32; ++k) { const int dk = qd * 32 + k; Sout[(size_t)dk * 128 + dv] = sreg[k] * eg + kv[dk] * delta; }
            __syncthreads();
        }
    }
}

__device__ __forceinline__ void ph_dn_seq(const P& p, LAS char* smem) {
    constexpr int SP = 136, DP = 72;
    LAS bf16_t* St = (LAS bf16_t*)smem;
    LAS bf16_t* Dt = St + 32 * SP;
    const int tid = ltid(), lane = tid & 63, wid = tid >> 6, li = lane & 15, lg = lane >> 4;
    const int rt = wid >> 1, dt = wid & 1;
    for (int u0 = blockIdx.x; u0 < NB * 8 * 4; u0 += gridDim.x) {
        const int u = (gridDim.x == 256) ? (((u0 & 7) * 8 + (u0 >> 5)) * 4 + ((u0 >> 3) & 3)) : u0;
        const int b = u >> 5, h = (u >> 2) & 7, ds = u & 3;
        f32x4 sacc[2] = {{0.f, 0.f, 0.f, 0.f}, {0.f, 0.f, 0.f, 0.f}};
#pragma unroll
        for (int kk = 0; kk < 2; ++kk) { const int kt = 2 * rt + kk; *(LAS u32x2*)(St + (16 * dt + li) * SP + 16 * kt + 4 * lg) = (u32x2){0u, 0u}; }
        __syncthreads();
        struct Ops { bf16x8 wf[4], qf[4], af[2], kf[2][2]; u32x2 uu; float gl; };
        Ops R0, R1;
        auto fetch = [&](int c, Ops& o) {
            const size_t u3 = (size_t)(b * NCHUNK + c) * 8 + h;
            const bf16_t* Wp = p.DW + u3 * 8192 + (16 * rt + li) * 128 + 8 * lg;
            const bf16_t* Qp = p.DQD + u3 * 8192 + (16 * rt + li) * 128 + 8 * lg;
            const bf16_t* Ap = p.DATT + u3 * 4096 + (16 * rt + li) * 64 + 8 * lg;
            const bf16_t* Kp = p.DKDt + u3 * 8192 + (16 * (2 * rt) + li) * 64 + 8 * lg;
#pragma unroll
            for (int ks = 0; ks < 4; ++ks) { o.wf[ks] = *(const bf16x8*)(Wp + 32 * ks); o.qf[ks] = *(const bf16x8*)(Qp + 32 * ks); }
#pragma unroll
            for (int s2 = 0; s2 < 2; ++s2) { o.af[s2] = *(const bf16x8*)(Ap + 32 * s2); o.kf[0][s2] = *(const bf16x8*)(Kp + 32 * s2); o.kf[1][s2] = *(const bf16x8*)(Kp + 16 * 64 + 32 * s2); }
            o.uu = *(const u32x2*)(p.DUt + u3 * 8192 + (32 * ds + 16 * dt + li) * 64 + 16 * rt + 4 * lg);
            o.gl = p.DGL[u3];
        };
        auto step = [&](int c, const Ops& o) {
            const float eg = __expf(o.gl);
            f32x4 dacc = {0.f, 0.f, 0.f, 0.f}, oacc = {0.f, 0.f, 0.f, 0.f};
#pragma unroll
            for (int ks = 0; ks < 4; ++ks) { const bf16x8 sf = *(const LAS bf16x8*)(St + (16 * dt + li) * SP + 32 * ks + 8 * lg); dacc = mfma16(o.wf[ks], sf, dacc); oacc = mfma16(o.qf[ks], sf, oacc); }
            const float d0 = bflo(o.uu.x) - dacc[0], d1 = bfhi(o.uu.x) - dacc[1], d2 = bflo(o.uu.y) - dacc[2], d3 = bfhi(o.uu.y) - dacc[3];
            *(LAS u32x2*)(Dt + (16 * dt + li) * DP + 16 * rt + 4 * lg) = (u32x2){cvt_pk(d0, d1), cvt_pk(d2, d3)};
            __syncthreads();
            bf16x8 df[2];
#pragma unroll
            for (int s2 = 0; s2 < 2; ++s2) df[s2] = *(const LAS bf16x8*)(Dt + (16 * dt + li) * DP + 32 * s2 + 8 * lg);
#pragma unroll
            for (int s2 = 0; s2 < 2; ++s2) oacc = mfma16(o.af[s2], df[s2], oacc);
#pragma unroll
            for (int kk = 0; kk < 2; ++kk) { sacc[kk] *= eg;
#pragma unroll
                for (int s2 = 0; s2 < 2; ++s2) sacc[kk] = mfma16(o.kf[kk][s2], df[s2], sacc[kk]); }
            {
                const int nvalid = (c == 0) ? 16 : 64, tbase = (c == 0) ? 0 : 16 + 64 * (c - 1);
#pragma unroll
                for (int r = 0; r < 4; ++r) { const int i = 16 * rt + 4 * lg + r; if (i < nvalid) p.ORAW[((size_t)b * LP + tbase + i) * 1024 + h * 128 + 32 * ds + 16 * dt + li] = oacc[r]; }
            }
#pragma unroll
            for (int kk = 0; kk < 2; ++kk) { const int kt = 2 * rt + kk; *(LAS u32x2*)(St + (16 * dt + li) * SP + 16 * kt + 4 * lg) = (u32x2){cvt_pk(sacc[kk][0], sacc[kk][1]), cvt_pk(sacc[kk][2], sacc[kk][3])}; }
            __syncthreads();
        };
        static_assert(NCHUNK % 2 == 1, "dn_seq ring");
        fetch(0, R0); fetch(1, R1);
#pragma unroll 1
        for (int c = 0; c + 1 < NCHUNK; c += 2) {
            step(c, R0);     fetch(c + 2, R0);
            step(c + 1, R1); if (c + 3 < NCHUNK) fetch(c + 3, R1);
        }
        step(NCHUNK - 1, R0);
        float* So = p.out + O_PDS + ((size_t)(b * 8 + h) * 128) * 128;
#pragma unroll
        for (int kk = 0; kk < 2; ++kk)
#pragma unroll
            for (int r = 0; r < 4; ++r) So[(size_t)(16 * (2 * rt + kk) + 4 * lg + r) * 128 + 32 * ds + 16 * dt + li] = sacc[kk][r];
    }
}

__device__ __forceinline__ void ph_dn_onorm(const P& p) {
    const int tid = ltid(), lane = tid & 63, wid = tid >> 6; const float* ng = p.in[26];
    for (int row = blockIdx.x * 8 + wid; row < NTOK + NS; row += gridDim.x * 8) {
#pragma unroll
        for (int it = 0; it < 2; ++it) {
            const int c0 = it * 512 + lane * 8, dv0 = c0 & 127;
            const float4 a = *(const float4*)(p.ORAW + (size_t)row * 1024 + c0), bq = *(const float4*)(p.ORAW + (size_t)row * 1024 + c0 + 4);
            float o[8] = {a.x, a.y, a.z, a.w, bq.x, bq.y, bq.z, bq.w}; float ss = 0.f;
#pragma unroll
            for (int e = 0; e < 8; ++e) ss += o[e] * o[e];
            ss += __shfl_xor(ss, 1); ss += __shfl_xor(ss, 2); ss += __shfl_xor(ss, 4); ss += __shfl_xor(ss, 8);
            const float r = rsqrtf(ss * (1.0f / 128.0f) + RMS_EPS);
            const u32x4 zw = *(const u32x4*)(p.PROJ + (size_t)row * DNPROJP + DNQKV + c0);
            float y[8];
#pragma unroll
            for (int e = 0; e < 4; ++e) { y[2 * e] = o[2 * e] * r * ng[dv0 + 2 * e] * siluf_(bflo(zw[e])); y[2 * e + 1] = o[2 * e + 1] * r * ng[dv0 + 2 * e + 1] * siluf_(bfhi(zw[e])); }
            u32x4 w; w.x = cvt_pk(y[0], y[1]); w.y = cvt_pk(y[2], y[3]); w.z = cvt_pk(y[4], y[5]); w.w = cvt_pk(y[6], y[7]);
            *(u32x4*)(p.ON + (size_t)row * 1024 + c0) = w;
        }
    }
}

__device__ __forceinline__ float rope_freq(int i) { return powf(10000.0f, -(float)i * (1.0f / 32.0f)); }
__device__ __forceinline__ void ph_mla_rows(const P& p) {
    const int tid = ltid(), lane = tid & 63, wid = tid >> 6; const float* qn = p.in[29]; const float* kn = p.in[32];
    for (int row = blockIdx.x * 8 + wid; row < MP; row += gridDim.x * 8) {
        if (row >= NTOK + NS) {
            const u32x4 z = {0u, 0u, 0u, 0u};
            *(u32x4*)(p.CQ + (size_t)row * 512 + lane * 8) = z; if (lane < 32) *(u32x4*)(p.CKVb + (size_t)row * 256 + lane * 8) = z; if (lane < 8) *(u32x4*)(p.KPEb + (size_t)row * 64 + lane * 8) = z;
            continue;
        }
        const float* src = p.DQKV + (size_t)row * 1024;
        {
            const float4 a = *(const float4*)(src + 4 * lane), bq = *(const float4*)(src + 256 + 4 * lane);
            float ss = a.x * a.x + a.y * a.y + a.z * a.z + a.w * a.w + bq.x * bq.x + bq.y * bq.y + bq.z * bq.z + bq.w * bq.w;
            ss = wave_sum(ss); const float r = rsqrtf(ss * (1.0f / 512.0f) + RMS_EPS);
            const float4 g0 = *(const float4*)(qn + 4 * lane), g1 = *(const float4*)(qn + 256 + 4 * lane);
            *(u32x2*)(p.CQ + (size_t)row * 512 + 4 * lane) = (u32x2){cvt_pk(a.x * r * g0.x, a.y * r * g0.y), cvt_pk(a.z * r * g0.z, a.w * r * g0.w)};
            *(u32x2*)(p.CQ + (size_t)row * 512 + 256 + 4 * lane) = (u32x2){cvt_pk(bq.x * r * g1.x, bq.y * r * g1.y), cvt_pk(bq.z * r * g1.z, bq.w * r * g1.w)};
        }
        const bool prompt = row < NTOK; const int b = prompt ? row / LP : 0, t = prompt ? row - b * LP : 0;
        {
            const float4 a = *(const float4*)(src + 512 + 4 * lane);
            float ss = a.x * a.x + a.y * a.y + a.z * a.z + a.w * a.w; ss = wave_sum(ss); const float r = rsqrtf(ss * (1.0f / 256.0f) + RMS_EPS);
            const float4 g0 = *(const float4*)(kn + 4 * lane); const float4 o = make_float4(a.x * r * g0.x, a.y * r * g0.y, a.z * r * g0.z, a.w * r * g0.w);
            float* dst = prompt ? p.out + O_PCKV + (size_t)row * 256 : p.out + O_SCKV + (size_t)(row - NTOK) * 256;
            *(float4*)(dst + 4 * lane) = o;
            *(u32x2*)(p.CKVb + (size_t)row * 256 + 4 * lane) = (u32x2){cvt_pk(o.x, o.y), cvt_pk(o.z, o.w)};
        }
        if (lane < 32) {
            const float x1 = src[768 + lane], x2 = src[800 + lane]; const float pos = prompt ? (float)t : 16384.0f;
            float sn, cs; sincosf(pos * rope_freq(lane), &sn, &cs);
            const float o1 = x1 * cs - x2 * sn, o2 = x1 * sn + x2 * cs;
            float* dst = prompt ? p.out + O_PKPE + (size_t)row * 64 : p.out + O_SKPE + (size_t)(row - NTOK) * 64;
            dst[lane] = o1; dst[32 + lane] = o2;
            p.KPEb[(size_t)row * 64 + lane] = (bf16_t)(cvt_pk(o1, 0.f) & 0xffffu); p.KPEb[(size_t)row * 64 + 32 + lane] = (bf16_t)(cvt_pk(o2, 0.f) & 0xffffu);
        }
    }
}

__device__ __forceinline__ void ph_mla_qlat(const P& p, LAS char* smem) {
    LAS float* Qn = (LAS float*)smem;
    const int tid = ltid(); const float* wuk = p.in[33];
    for (int u = blockIdx.x; u < 32; u += gridDim.x) {
        const int h = u >> 2, cq = u & 3;
        for (int i = tid; i < 32 * 128; i += NTHREADS) { const int s = i >> 7, n = i & 127; Qn[i] = bf2f(p.Q[((size_t)NTOK + s) * 1536 + h * 192 + n]); }
        __syncthreads();
        const int c = cq * 64 + (tid & 63), bg = tid >> 6; float acc[4] = {0.f, 0.f, 0.f, 0.f};
        const float* wr = wuk + (size_t)c * 1024 + h * 128;
#pragma unroll 8
        for (int n4 = 0; n4 < 32; ++n4) { const float4 w = *(const float4*)(wr + 4 * n4);
#pragma unroll
            for (int r = 0; r < 4; ++r) { const LAS float* qr = Qn + (bg * 4 + r) * 128 + 4 * n4; acc[r] += w.x * qr[0] + w.y * qr[1] + w.z * qr[2] + w.w * qr[3]; } }
#pragma unroll
        for (int r = 0; r < 4; ++r) p.QLAT[(size_t)(bg * 4 + r) * 2048 + h * 256 + c] = acc[r];
        if (cq == 0) {
            for (int i = tid; i < 32 * 32; i += NTHREADS) { const int s = i >> 5, d = i & 31; const bf16_t* q = p.Q + ((size_t)NTOK + s) * 1536 + h * 192 + 128;
                const float x1 = bf2f(q[d]), x2 = bf2f(q[32 + d]); float sn, cs; sincosf(16384.0f * rope_freq(d), &sn, &cs);
                p.QPE[(size_t)s * 512 + h * 64 + d] = x1 * cs - x2 * sn; p.QPE[(size_t)s * 512 + h * 64 + 32 + d] = x1 * sn + x2 * cs; }
        }
        __syncthreads();
    }
}

template <int N>
__device__ __forceinline__ void tr_step(float (&v)[32], int lane, int mask) {
    const bool up = (lane & mask) != 0;
#pragma unroll
    for (int i = 0; i < N; ++i) { const float send = up ? v[i] : v[i + N]; const float keep = up ? v[i + N] : v[i]; v[i] = keep + __shfl_xor(send, mask); }
}
__device__ __forceinline__ float readlane_f(float v, int l) { return __int_as_float(__builtin_amdgcn_readlane(__float_as_int(v), l)); }
__device__ __forceinline__ void ph_mla_decode(const P& p, LAS char* smem) {
    LAS float* Om = (LAS float*)smem;
    LAS float* MLs = Om + 8 * 8 * 256;
    const int tid = ltid(), lane = tid & 63, wid = tid >> 6;
    const int* pt = (const int*)p.in[8]; const float* pool_c = p.in[6]; const float* pool_k = p.in[7];
    const float sc = MLA_SCALE * LOG2E;
    for (int u = blockIdx.x; u < NS * 8; u += gridDim.x) {
        const int bq = u >> 3, sp = u & 7;
        f32x2 qlp[4][4], qpp[4];
#pragma unroll
        for (int hp = 0; hp < 4; ++hp) { const float4 a = *(const float4*)(p.QLAT + (size_t)bq * 2048 + (2 * hp) * 256 + 4 * lane), b4 = *(const float4*)(p.QLAT + (size_t)bq * 2048 + (2 * hp + 1) * 256 + 4 * lane);
            qlp[hp][0] = (f32x2){a.x, b4.x}; qlp[hp][1] = (f32x2){a.y, b4.y}; qlp[hp][2] = (f32x2){a.z, b4.z}; qlp[hp][3] = (f32x2){a.w, b4.w};
            qpp[hp] = (f32x2){p.QPE[(size_t)bq * 512 + (2 * hp) * 64 + lane], p.QPE[(size_t)bq * 512 + (2 * hp + 1) * 64 + lane]}; }
        f32x2 O2[8][2];
#pragma unroll
        for (int h = 0; h < 8; ++h) { O2[h][0] = (f32x2){0.f, 0.f}; O2[h][1] = (f32x2){0.f, 0.f}; }
        float m_run = -INFINITY, l_run = 0.f;
        const int pg0 = pt[bq * 128 + sp * 16 + 2 * wid], pg1 = pt[bq * 128 + sp * 16 + 2 * wid + 1];
        float4 cn[4]; float en[4];
        {   const float* cb = pool_c + (size_t)pg0 * 128 * 256; const float* kb = pool_k + (size_t)pg0 * 128 * 64;
#pragma unroll
            for (int k = 0; k < 4; ++k) { cn[k] = *(const float4*)(cb + k * 256 + 4 * lane); en[k] = kb[k * 64 + lane]; } }
        for (int it = 0; it < 64; ++it) {
            float4 c[4]; float e[4];
#pragma unroll
            for (int k = 0; k < 4; ++k) { c[k] = cn[k]; e[k] = en[k]; }
            if (it + 1 < 64) { const int nit = it + 1, pg = (nit < 32) ? pg0 : pg1, kb4 = (nit & 31) * 4;
                const float* cb = pool_c + ((size_t)pg * 128 + kb4) * 256; const float* kb = pool_k + ((size_t)pg * 128 + kb4) * 64;
#pragma unroll
                for (int k = 0; k < 4; ++k) { cn[k] = *(const float4*)(cb + k * 256 + 4 * lane); en[k] = kb[k * 64 + lane]; } }
            float part[32];
#pragma unroll
            for (int k = 0; k < 4; ++k)
#pragma unroll
                for (int hp = 0; hp < 4; ++hp) { const f32x2 t2 = qlp[hp][0] * c[k].x + qlp[hp][1] * c[k].y + qlp[hp][2] * c[k].z + qlp[hp][3] * c[k].w + qpp[hp] * e[k];
                    part[k * 8 + 2 * hp] = t2.x; part[k * 8 + 2 * hp + 1] = t2.y; }
#pragma unroll
            for (int i = 0; i < 16; ++i) { swap32(part[i], part[i + 16]); part[i] += part[i + 16]; }
#pragma unroll
            for (int i = 0; i < 8; ++i) { swap16(part[i], part[i + 8]); part[i] += part[i + 8]; }
            tr_step<4>(part, lane, 8); tr_step<2>(part, lane, 4); tr_step<1>(part, lane, 2);
            float s = (part[0] + __shfl_xor(part[0], 1)) * sc;
            float m4 = max_x32(max_x16(s));
            const float m_new = fmaxf(m_run, m4), alpha = __builtin_amdgcn_exp2f(m_run - m_new), pr = __builtin_amdgcn_exp2f(s - m_new);
            const float ps = sum_x32(sum_x16(pr));
            l_run = l_run * alpha + ps; m_run = m_new;
#pragma unroll
            for (int h = 0; h < 8; ++h) {
                const float al = readlane_f(alpha, 2 * h);
                f32x2 o0 = O2[h][0] * al, o1 = O2[h][1] * al;
#pragma unroll
                for (int k = 0; k < 4; ++k) { const float pk = readlane_f(pr, 16 * k + 2 * h); o0 += (f32x2){c[k].x, c[k].y} * pk; o1 += (f32x2){c[k].z, c[k].w} * pk; }
                O2[h][0] = o0; O2[h][1] = o1;
            }
        }
#pragma unroll
        for (int h = 0; h < 8; ++h) *(LAS f32x4*)(Om + (wid * 8 + h) * 256 + 4 * lane) = (f32x4){O2[h][0].x, O2[h][0].y, O2[h][1].x, O2[h][1].y};
        if (lane < 16 && (lane & 1) == 0) { MLs[(wid * 8 + (lane >> 1)) * 2] = m_run; MLs[(wid * 8 + (lane >> 1)) * 2 + 1] = l_run; }
        __syncthreads();
#pragma unroll
        for (int i = 0; i < 4; ++i) { const int idx = tid + NTHREADS * i, h = idx >> 8, c = idx & 255;
            float M = -INFINITY;
#pragma unroll
            for (int w = 0; w < 8; ++w) M = fmaxf(M, MLs[(w * 8 + h) * 2]);
            float val = 0.f, L = 0.f;
#pragma unroll
            for (int w = 0; w < 8; ++w) { const float f = __builtin_amdgcn_exp2f(MLs[(w * 8 + h) * 2] - M); val += f * Om[(w * 8 + h) * 256 + c]; L += f * MLs[(w * 8 + h) * 2 + 1]; }
            p.PART[((size_t)(bq * 8 + sp) * 8 + h) * 256 + c] = val;
            if (c == 0) { p.ML[((size_t)(bq * 8 + sp) * 8 + h) * 2] = M; p.ML[((size_t)(bq * 8 + sp) * 8 + h) * 2 + 1] = L; }
        }
        __syncthreads();
    }
}

__device__ __forceinline__ void ph_mla_combine(const P& p, LAS char* smem) {
    LAS float* OL = (LAS float*)smem;
    const int tid = ltid(), lane = tid & 63, wid = tid >> 6; const float sc = MLA_SCALE * LOG2E;
    for (int bq = blockIdx.x; bq < NS; bq += gridDim.x) {
        const int h = wid;
        const float4 cnew = *(const float4*)(p.out + O_SCKV + (size_t)bq * 256 + 4 * lane); const float knew = p.out[O_SKPE + (size_t)bq * 64 + lane];
        const float4 ql = *(const float4*)(p.QLAT + (size_t)bq * 2048 + h * 256 + 4 * lane); const float qp = p.QPE[(size_t)bq * 512 + h * 64 + lane];
        float ss = cnew.x * ql.x + cnew.y * ql.y + cnew.z * ql.z + cnew.w * ql.w + knew * qp; ss = wave_sum(ss) * sc;
        float M = ss;
#pragma unroll
        for (int s = 0; s < 8; ++s) M = fmaxf(M, p.ML[((size_t)(bq * 8 + s) * 8 + h) * 2]);
        const float fs = __builtin_amdgcn_exp2f(ss - M); float L = fs; float4 o = make_float4(fs * cnew.x, fs * cnew.y, fs * cnew.z, fs * cnew.w);
#pragma unroll
        for (int s = 0; s < 8; ++s) { const float f = __builtin_amdgcn_exp2f(p.ML[((size_t)(bq * 8 + s) * 8 + h) * 2] - M); L += f * p.ML[((size_t)(bq * 8 + s) * 8 + h) * 2 + 1];
            const float4 pv = *(const float4*)(p.PART + ((size_t)(bq * 8 + s) * 8 + h) * 256 + 4 * lane); o.x += f * pv.x; o.y += f * pv.y; o.z += f * pv.z; o.w += f * pv.w; }
        const float inv = 1.0f / L;
        *(LAS f32x4*)(OL + h * 256 + 4 * lane) = (f32x4){o.x * inv, o.y * inv, o.z * inv, o.w * inv};
        __syncthreads();
        const float* wuv = p.in[34];
#pragma unroll
        for (int i = 0; i < 2; ++i) { const int idx = tid + NTHREADS * i, hh = idx >> 7, v = idx & 127; float acc = 0.f;
#pragma unroll 16
            for (int c = 0; c < 256; ++c) acc += OL[hh * 256 + c] * wuv[(size_t)c * 1024 + hh * 128 + v];
            p.AO[((size_t)NTOK + bq) * 1024 + hh * 128 + v] = (bf16_t)(cvt_pk(acc, 0.f) & 0xffffu); }
        __syncthreads();
    }
}

__device__ __forceinline__ void ph_mla_attn(const P& p, LAS char* smem) {
    constexpr int KP = 200, VP = 144;
    constexpr int KT_BYTES = 64 * KP * 2, VT_BYTES = 64 * VP * 2, STG = KT_BYTES + VT_BYTES;
    const int tid = ltid(), lane = tid & 63, wid = tid >> 6, li = lane & 15, lg = lane >> 4;
    const int G = gridDim.x; const float sc = MLA_SCALE * LOG2E;
    constexpr int NQB = 9, NUNITS = NB * 8 * NQB;
    for (int j = 0;; ++j) {
        const int idx = j * G + ((j & 1) ? (G - 1 - (int)blockIdx.x) : (int)blockIdx.x);
        if (j * G >= NUNITS) break;
        if (idx >= NUNITS) continue;
        const int qb = (NQB - 1) - idx / 64, bh = idx & 63, b = bh >> 3, h = bh & 7;
        const int t0 = qb * 256, nq = (LP - t0) < 256 ? (LP - t0) : 256, kend = t0 + nq, nkt = (kend + 63) >> 6;
        const int tq0 = t0 + 32 * wid + li;
        bf16x8 qf[2][6];
#pragma unroll
        for (int rt = 0; rt < 2; ++rt) { const int tq = tq0 + 16 * rt, tqc = tq < LP ? tq : LP - 1;
            const bf16_t* qsrc = p.Q + ((size_t)b * LP + tqc) * 1536 + h * 192 + 8 * lg;
#pragma unroll
            for (int ks = 0; ks < 6; ++ks) qf[rt][ks] = *(const bf16x8*)(qsrc + 32 * ks);
#pragma unroll
            for (int e = 0; e < 8; ++e) { const float x1 = bf2f((unsigned short)qf[rt][4][e]), x2 = bf2f((unsigned short)qf[rt][5][e]);
                const float ang_ = (float)tqc * __builtin_amdgcn_exp2f(-0.41524101186092033f * (float)(8 * lg + e)); const float sn = __sinf(ang_), cs = __cosf(ang_);
                qf[rt][4][e] = (short)(cvt_pk(x1 * cs - x2 * sn, 0.f) & 0xffffu); qf[rt][5][e] = (short)(cvt_pk(x1 * sn + x2 * cs, 0.f) & 0xffffu); } }
        f32x4 oacc[2][8];
#pragma unroll
        for (int rt = 0; rt < 2; ++rt)
#pragma unroll
            for (int ct = 0; ct < 8; ++ct) oacc[rt][ct] = (f32x4){0.f, 0.f, 0.f, 0.f};
        float m_run[2] = {-INFINITY, -INFINITY}, l_run[2] = {0.f, 0.f};
        u32x4 rgA[5];
        auto gload = [&](int kt, u32x4 (&rg)[5]) {
            int tl = tid; asm volatile("" : "+v"(tl));
#pragma unroll
            for (int i = 0; i < 5; ++i) { const int c = tl + NTHREADS * i; int key, part; const bf16_t* src;
                if (c < 1024) { key = c >> 4; part = c & 15; } else if (c < 1536) { key = (c - 1024) >> 3; part = (c - 1024) & 7; } else { key = (c - 1536) >> 4; part = (c - 1536) & 15; }
                int kr = kt * 64 + key; kr = kr < LP ? kr : LP - 1; const size_t grow = (size_t)b * LP + kr;
                if (c < 1024) src = p.KV + grow * 2048 + h * 128 + part * 8; else if (c < 1536) src = p.KPEb + grow * 64 + part * 8; else src = p.KV + grow * 2048 + 1024 + h * 128 + part * 8;
                rg[i] = *(const u32x4*)src; } };
        auto sstore = [&](int st, const u32x4 (&rg)[5]) {
            LAS bf16_t* Kt = (LAS bf16_t*)(smem + st * STG); LAS bf16_t* Vt = (LAS bf16_t*)(smem + st * STG + KT_BYTES);
            int tl = tid; asm volatile("" : "+v"(tl));
#pragma unroll
            for (int i = 0; i < 5; ++i) { const int c = tl + NTHREADS * i;
                if (c < 1024) *(LAS u32x4*)(Kt + (c >> 4) * KP + (c & 15) * 8) = rg[i];
                else if (c < 1536) *(LAS u32x4*)(Kt + ((c - 1024) >> 3) * KP + 128 + ((c - 1024) & 7) * 8) = rg[i];
                else *(LAS u32x4*)(Vt + ((c - 1536) >> 4) * VP + ((c - 1536) & 15) * 8) = rg[i]; } };
        auto compute = [&](int kt, int st) {
            if (kt * 64 > t0 + 32 * wid + 31) return;
            const LAS bf16_t* Kt = (const LAS bf16_t*)(smem + st * STG); const LAS bf16_t* Vt = (const LAS bf16_t*)(smem + st * STG + KT_BYTES);
            f32x4 sacc[2][4];
#pragma unroll
            for (int rt = 0; rt < 2; ++rt)
#pragma unroll
                for (int k4 = 0; k4 < 4; ++k4) sacc[rt][k4] = (f32x4){0.f, 0.f, 0.f, 0.f};
#pragma unroll
            for (int ks = 0; ks < 6; ++ks)
#pragma unroll
                for (int k4 = 0; k4 < 4; ++k4) { const bf16x8 kf = *(const LAS bf16x8*)(Kt + (16 * k4 + li) * KP + 32 * ks + 8 * lg);
                    sacc[0][k4] = mfma16(kf, qf[0][ks], sacc[0][k4]); sacc[1][k4] = mfma16(kf, qf[1][ks], sacc[1][k4]);
                    if (k4 == 3 && (ks & 1)) asm volatile("" ::: "memory"); }
            bf16x8 pf[2][2];
#pragma unroll
            for (int rt = 0; rt < 2; ++rt) {
                const int tq = tq0 + 16 * rt;
                const bool diag = kt * 64 + 63 > t0 + 32 * wid + 16 * rt;
                float mx = -INFINITY;
                if (diag) {
#pragma unroll
                    for (int k4 = 0; k4 < 4; ++k4)
#pragma unroll
                        for (int r = 0; r < 4; ++r) { const int key = kt * 64 + 16 * k4 + 4 * lg + r; const float sv = (key <= tq) ? sacc[rt][k4][r] * sc : -INFINITY; sacc[rt][k4][r] = sv; mx = fmaxf(mx, sv); }
                } else {
#pragma unroll
                    for (int k4 = 0; k4 < 4; ++k4) { sacc[rt][k4] *= sc; mx = fmaxf(fmaxf(mx, fmaxf(sacc[rt][k4][0], sacc[rt][k4][1])), fmaxf(sacc[rt][k4][2], sacc[rt][k4][3])); }
                }
                mx = max_x32(max_x16(mx));
                const float m_new = fmaxf(m_run[rt], mx), alpha = __builtin_amdgcn_exp2f(m_run[rt] - m_new); float rs = 0.f;
#pragma unroll
                for (int k4 = 0; k4 < 4; ++k4)
#pragma unroll
                    for (int r = 0; r < 4; ++r) { const float pv = __builtin_amdgcn_exp2f(sacc[rt][k4][r] - m_new); sacc[rt][k4][r] = pv; rs += pv; }
                rs = sum_x32(sum_x16(rs));
                l_run[rt] = l_run[rt] * alpha + rs; m_run[rt] = m_new;
                if (__any(alpha != 1.0f)) {
#pragma unroll
                    for (int ct = 0; ct < 8; ++ct) oacc[rt][ct] *= alpha; }
#pragma unroll
                for (int s2 = 0; s2 < 2; ++s2) { const u32x4 w = {cvt_pk(sacc[rt][2 * s2][0], sacc[rt][2 * s2][1]), cvt_pk(sacc[rt][2 * s2][2], sacc[rt][2 * s2][3]), cvt_pk(sacc[rt][2 * s2 + 1][0], sacc[rt][2 * s2 + 1][1]), cvt_pk(sacc[rt][2 * s2 + 1][2], sacc[rt][2 * s2 + 1][3])};
                    pf[rt][s2] = __builtin_bit_cast(bf16x8, w); }
            }
#pragma unroll
            for (int ct = 0; ct < 8; ++ct)
#pragma unroll
                for (int s2 = 0; s2 < 2; ++s2) {
                    const s16x4 lo = __builtin_amdgcn_ds_read_tr16_b64_v4i16((LAS s16x4*)(Vt + (32 * s2 + 4 * lg + (li >> 2)) * VP + 16 * ct + 4 * (li & 3)));
                    const s16x4 hi = __builtin_amdgcn_ds_read_tr16_b64_v4i16((LAS s16x4*)(Vt + (32 * s2 + 16 + 4 * lg + (li >> 2)) * VP + 16 * ct + 4 * (li & 3)));
                    const bf16x8 vf = {lo[0], lo[1], lo[2], lo[3], hi[0], hi[1], hi[2], hi[3]};
                    oacc[0][ct] = mfma16(vf, pf[0][s2], oacc[0][ct]); oacc[1][ct] = mfma16(vf, pf[1][s2], oacc[1][ct]);
                    if (s2 == 1 && (ct & 1)) asm volatile("" ::: "memory");
                }
        };
        gload(0, rgA); sstore(0, rgA);
        __syncthreads();
#pragma unroll 1
        for (int kt = 0; kt < nkt; ++kt) {
            const int st = kt & 1;
            if (kt + 1 < nkt) gload(kt + 1, rgA);
            compute(kt, st);
            if (kt + 1 < nkt) sstore(st ^ 1, rgA);
            __syncthreads();
        }
#pragma unroll
        for (int rt = 0; rt < 2; ++rt) { const int tq = tq0 + 16 * rt;
            if (tq < LP) { const float inv = 1.0f / l_run[rt]; bf16_t* dst = p.AO + ((size_t)b * LP + tq) * 1024 + h * 128 + 4 * lg;
#pragma unroll
                for (int ct = 0; ct < 8; ++ct) *(u32x2*)(dst + 16 * ct) = (u32x2){cvt_pk(oacc[rt][ct][0] * inv, oacc[rt][ct][1] * inv), cvt_pk(oacc[rt][ct][2] * inv, oacc[rt][ct][3] * inv)}; } }
    }
}

constexpr int NPHASES = 43;
template <int PH>
__device__ __forceinline__ void run_phase(const LAS PG* pl, LAS char* smem) {
    const P p = glob(pl);
    if constexpr (PH == 0) { ph_init(p, smem); return; }
    if constexpr (PH == 42) {
        ph_final_norm(p);
        return; }
    constexpr int layer = PH <= 10 ? 0 : PH <= 20 ? 1 : PH <= 31 ? 2 : 3;
    constexpr int base = layer == 0 ? 1 : layer == 1 ? 11 : layer == 2 ? 21 : 32;
    constexpr int sub = PH - base;
    constexpr int nmix = layer == 2 ? 8 : 7;
    if constexpr (sub == 0 || sub == nmix) return;
    if constexpr (sub == nmix + 1) { norm_gemm(p, p.Wgu + (size_t)layer * 5632 * 1024, 5632, 2 * layer + 1, EpiGU{uni(p.HF)}, smem); return; }
    if constexpr (sub == nmix + 2) { resid_gemm(p, p.HF, p.Wdown + (size_t)layer * 1024 * DFF, DFF, layer < 3 ? 2 * layer + 2 : -1, smem); return; }
    if constexpr (layer == 0 || layer == 3) {
        constexpr int J = layer == 0 ? 0 : 1;
        if constexpr (sub == 1) { norm_gemm(p, p.Wlru_in + (size_t)J * 2048 * 1024, 2048, 2 * layer, EpiLruIn{uni(p.G1)}, smem); }
        if constexpr (sub == 2) ph_lru_conv<J>(p);
        if constexpr (sub == 3) {
            const bf16_t* A = uni((const bf16_t*)p.XC); const bf16_t* Bt = uni((const bf16_t*)(p.Wlru_gate + (size_t)J * 2048 * 256));
            const EpiGate e{uni(p.RI), uni((const float*)p.BCAT) + J * 2048};
            pg8::Gemm g{A, Bt, 4 * MP, 2048, 256}; GateOrder S{(int)gridDim.x, (int)blockIdx.x};
            PgEpiGate pe{e};
            pg8::gemm_phase<PgEpiGate, GateOrder, true, true>((LAS unsigned char*)smem, g, S, pe);
            __syncthreads();
            gemm_small<false>(A, 256, Bt, 256, 2048, MMAIN, 3, 1, e, smem, nullptr, 512); }
        if constexpr (sub == 4) ph_scan1<J>(p);
        if constexpr (sub == 5) ph_scan2<J>(p);
        if constexpr (sub == 6) { resid_gemm(p, p.HG, p.Wlru_out + (size_t)J * 1048576, 1024, 2 * layer + 1, smem); }
    }
    if constexpr (layer == 1) {
        if constexpr (sub == 1) { norm_gemm(p, p.Wdn_in, DNPROJP, 2 * layer, EpiDnIn{uni(p.PROJ), uni(p.BA)}, smem); }
        if constexpr (sub == 2) ph_dn_conv(p);
        if constexpr (sub == 3) ph_dn_chunk(p, smem);
        if constexpr (sub == 4) ph_dn_seq(p, smem);
        if constexpr (sub == 5) ph_dn_onorm(p);
        if constexpr (sub == 6) { resid_gemm(p, p.ON, p.Wdn_out, 1024, 2 * layer + 1, smem); }
    }
    if constexpr (layer == 2) {
        if constexpr (sub == 1) { norm_gemm(p, p.Wmla_d, 1024, 2 * layer, EpiF32{uni(p.DQKV), 1024}, smem); }
        if constexpr (sub == 2) ph_mla_rows(p);
        if constexpr (sub == 3) { big_gemm(p.CQ, p.Wmla_uq, 1536, 512, EpiBf16{uni(p.Q), 1536}, smem); __syncthreads();
                                  big_gemm(p.CKVb, p.Wmla_kvup, 2048, 256, EpiBf16{uni(p.KV), 2048}, smem); }
        if constexpr (sub == 4) ph_mla_qlat(p, smem);
        if constexpr (sub == 5) { ph_mla_decode(p, smem);
            ph_mla_attn(p, smem); }
        if constexpr (sub == 6) ph_mla_combine(p, smem);
        if constexpr (sub == 7) { resid_gemm(p, p.AO, p.Wmla_o, 1024, 2 * layer + 1, smem); }
    }
}

extern __shared__ __attribute__((aligned(16))) char smem_raw[];

constexpr bool phase_active(int ph) {
    if (ph == 0 || ph == 42) return true;
    const int layer = ph <= 10 ? 0 : ph <= 20 ? 1 : ph <= 31 ? 2 : 3, base = layer == 0 ? 1 : layer == 1 ? 11 : layer == 2 ? 21 : 32, sub = ph - base, nmix = layer == 2 ? 8 : 7;
    return !(sub == 0 || sub == nmix);
}
template <int PH>
__device__ __forceinline__ void run_all(const LAS PG* p, LAS char* smem, const XcdBarrier& bar) {
    if constexpr (phase_active(PH)) { run_phase<PH>(p, smem); if constexpr (PH + 1 < NPHASES) xcd_barrier(bar); }
    if constexpr (PH + 1 < NPHASES) run_all<PH + 1>(p, smem, bar);
}
__global__ void __launch_bounds__(NTHREADS, 2) k_mega(P p) {
    LAS char* smem = (LAS char*)smem_raw;
    LAS unsigned long long* lp = (LAS unsigned long long*)(smem + LDS_BYTES - 2048);
    { const unsigned long long* src = (const unsigned long long*)&p; for (int i = threadIdx.x; i < (int)(sizeof(P) / 8); i += NTHREADS) lp[i] = src[i]; }
    LAS unsigned* xbw = (LAS unsigned*)(smem + LDS_BYTES - 16);
    if (threadIdx.x == 0) { xbw[0] = 0u; xbw[1] = 0u; xbw[2] = 0u; xbw[3] = 0u; }
    __syncthreads();
    const LAS PG* q = (const LAS PG*)lp;
    XcdBarrier bar = xcd_barrier_post((unsigned*)q->bar, (volatile LAS unsigned*)xbw);
    run_all<0>(q, smem, bar);
}

extern "C" void kernel_launch(void* const* d_in, const int* in_sizes, int n_in, void* d_out, int out_size, void* d_ws, size_t ws_size, hipStream_t stream) {
    (void)in_sizes; (void)n_in; (void)out_size;
    P p{};
    for (int i = 0; i < 38; ++i) p.in[i] = (const float*)d_in[i];
    p.out = (float*)d_out;
    char* w = (char*)d_ws; size_t off = 0;
    auto take = [&](size_t bytes) { void* r = w + off; off += (bytes + 255) & ~(size_t)255; return r; };
    p.bar = (unsigned*)take(XCD_BAR_WORDS * 4);
    p.X = (float*)take((size_t)MP * D * 4); p.H = (bf16_t*)take((size_t)MP * D * 2); p.SS = (float*)take((size_t)8 * MP * 16 * 4);
    p.G1 = (bf16_t*)take((size_t)MP * 2048 * 2); p.XC = (bf16_t*)take((size_t)MP * 1024 * 2); p.RI = (bf16_t*)take((size_t)MP * 2048 * 2); p.HG = (bf16_t*)take((size_t)MP * 1024 * 2);
    p.CP = (float*)take((size_t)NB * SCH * 1024 * 4); p.CH = (float*)take((size_t)NB * SCH * 1024 * 4); p.BCAT = (float*)take((size_t)2 * 2048 * 4);
    p.PROJ = (bf16_t*)take((size_t)MP * DNPROJP * 2); p.BA = (float*)take((size_t)MP * 16 * 4); p.BG = (float*)take((size_t)MP * 16 * 4); p.QKVN = (bf16_t*)take((size_t)MP * DNQKV * 2);
    const size_t nu3 = (size_t)NB * NCHUNK * 8;
    p.DW = (bf16_t*)take(nu3 * 8192 * 2); p.DUt = (bf16_t*)take(nu3 * 8192 * 2); p.DQD = (bf16_t*)take(nu3 * 8192 * 2); p.DKDt = (bf16_t*)take(nu3 * 8192 * 2); p.DATT = (bf16_t*)take(nu3 * 4096 * 2);
    p.DGL = (float*)take(nu3 * 4); p.ORAW = (float*)take((size_t)MP * 1024 * 4); p.ON = (bf16_t*)take((size_t)MP * 1024 * 2);
    p.DQKV = (float*)take((size_t)MP * 1024 * 4); p.CQ = (bf16_t*)take((size_t)MP * 512 * 2); p.CKVb = (bf16_t*)take((size_t)MP * 256 * 2); p.KPEb = (bf16_t*)take((size_t)MP * 64 * 2);
    p.Q = (bf16_t*)take((size_t)MP * 1536 * 2); p.KV = (bf16_t*)take((size_t)MP * 2048 * 2); p.AO = (bf16_t*)take((size_t)MP * 1024 * 2);
    p.QLAT = (float*)take((size_t)NS * 2048 * 4); p.QPE = (float*)take((size_t)NS * 512 * 4); p.PART = (float*)take((size_t)NS * 8 * 8 * 256 * 4); p.ML = (float*)take((size_t)NS * 8 * 8 * 2 * 4);
    p.HF = (bf16_t*)take((size_t)MP * DFF * 2);
    p.Wlru_in = (bf16_t*)take((size_t)2 * 2048 * 1024 * 2); p.Wlru_gate = (bf16_t*)take((size_t)2 * 2048 * 256 * 2); p.Wlru_out = (bf16_t*)take((size_t)2 * 1048576 * 2);
    p.Wdn_in = (bf16_t*)take((size_t)DNPROJP * 1024 * 2); p.Wdn_out = (bf16_t*)take((size_t)1048576 * 2);
    p.Wmla_d = (bf16_t*)take((size_t)1024 * 1024 * 2); p.Wmla_uq = (bf16_t*)take((size_t)1536 * 512 * 2); p.Wmla_kvup = (bf16_t*)take((size_t)2048 * 256 * 2); p.Wmla_o = (bf16_t*)take((size_t)1048576 * 2);
    p.Wgu = (bf16_t*)take((size_t)4 * 5632 * 1024 * 2); p.Wdown = (bf16_t*)take((size_t)4 * 1024 * DFF * 2);
    if (off > ws_size) return;
    static int grid = 0;
    if (!grid) { int dev = 0, cus = 0; (void)hipGetDevice(&dev); (void)hipDeviceGetAttribute(&cus, hipDeviceAttributeMultiprocessorCount, dev); grid = (cus > 0 && cus < 256) ? cus : 256; }
    static bool attr_done = false;
    if (!attr_done) { (void)hipFuncSetAttribute((const void*)k_mega, hipFuncAttributeMaxDynamicSharedMemorySize, LDS_BYTES); attr_done = true; }
    (void)hipMemsetAsync(p.bar, 0, XCD_BAR_WORDS * 4, stream);
    hipLaunchKernelGGL(k_mega, dim3(grid), dim3(NTHREADS), LDS_BYTES, stream, p);
}
```
